# Optimizing an MI355X kernel written in HIP

```python
import math
import jax, jax.numpy as jnp
from jax import lax
import numpy as np

D_MODEL = 1024
BATCH = 16
SEQ = 2048
DEPTH = 4

HEAD_DIM = 64
RMS_EPS = 1e-6
RWKV_HEADS = 4
RWKV_WIDTH = RWKV_HEADS * HEAD_DIM
RWKV_DECAY_RANK = 64
RWKV_ICLR_RANK = 64
RWKV_GATE_RANK = 128
RWKV_GN_EPS = 64e-5
GDN_HEADS = 4
GDN_WIDTH = GDN_HEADS * HEAD_DIM
GDN_CONV = 4
GDN_CHUNK = 64
ATTN_Q_HEADS = 8
ATTN_KV_HEADS = 2
ATTN_WIDTH = ATTN_Q_HEADS * HEAD_DIM
ATTN_KV_WIDTH = ATTN_KV_HEADS * HEAD_DIM
WINDOW = 128
ATTN_BLOCK = 128
NUM_BUCKETS = 32
MAX_DISTANCE = 128
D_MIX = RWKV_WIDTH + GDN_WIDTH + ATTN_WIDTH
D_FF = 4 * D_MODEL
RWKV_IN = 3 * RWKV_WIDTH + RWKV_DECAY_RANK + RWKV_ICLR_RANK + RWKV_GATE_RANK
GDN_IN = 4 * GDN_WIDTH + 2 * GDN_HEADS
ATTN_IN = ATTN_WIDTH + 2 * ATTN_KV_WIDTH
D_IN = RWKV_IN + GDN_IN + ATTN_IN

kernel_name = "hymba_style_rwkv7_gdn_swa_hybrid"


def split_cols(z, sizes):
    offs = [int(o) for o in np.cumsum(sizes)[:-1]]
    return jnp.split(z, offs, axis=-1)


def rms_norm(x, w, eps=RMS_EPS):
    xf = x.astype(jnp.float32)
    y = xf * lax.rsqrt(jnp.mean(xf * xf, axis=-1, keepdims=True) + eps)
    return (y * w).astype(x.dtype)


def l2_normalize(x, eps=1e-6):
    return x * lax.rsqrt(jnp.sum(x * x, axis=-1, keepdims=True) + eps)


def token_shift(z):
    return jnp.pad(z, ((0, 0), (1, 0), (0, 0)))[:, :-1]


def causal_depthwise_conv(x, w):
    K, C = w.shape
    return lax.conv_general_dilated(x, w.astype(x.dtype)[:, None, :], window_strides=(1,),
                                    padding=[(K - 1, 0)], dimension_numbers=('NWC', 'WIO', 'NWC'),
                                    feature_group_count=C)


def rwkv7_recurrence(r, w, k, v, a, b):
    Bsz, S, H, N = r.shape

    def step(state, inp):
        r_t, w_t, k_t, v_t, a_t, b_t = inp
        sa = jnp.einsum('bhij,bhj->bhi', state, a_t)
        state = (state * w_t[:, :, None, :] + sa[..., None] * b_t[:, :, None, :]
                 + v_t[..., None] * k_t[:, :, None, :])
        return state, jnp.einsum('bhij,bhj->bhi', state, r_t)

    xs = tuple(jnp.moveaxis(t, 1, 0) for t in (r, w, k, v, a, b))
    state0 = jnp.zeros((Bsz, H, N, N), jnp.float32)
    _, y = lax.scan(step, state0, xs)
    return jnp.moveaxis(y, 0, 1)


def rwkv7_mixer(z, mu, w0, w_up, a0, a_up, g_up, k_k, k_a, r_k, lnx_w, lnx_b):
    Bsz, S, _ = z.shape
    H, N = RWKV_HEADS, HEAD_DIM
    z = z + (token_shift(z) - z) * mu
    r, k, v, dw, da, dg = split_cols(z, (RWKV_WIDTH, RWKV_WIDTH, RWKV_WIDTH,
                                         RWKV_DECAY_RANK, RWKV_ICLR_RANK, RWKV_GATE_RANK))
    log_w = -jax.nn.softplus(-(w0 + jnp.tanh(dw) @ w_up)) - 0.5
    decay = jnp.exp(-jnp.exp(log_w))
    iclr = jax.nn.sigmoid(a0 + da @ a_up)
    gate = jax.nn.sigmoid(dg) @ g_up
    heads = lambda t: t.reshape(Bsz, S, H, N)
    kk = l2_normalize(heads(k * k_k))
    k = k * (1.0 + (iclr - 1.0) * k_a)
    r_h, k_h, v_h = heads(r), heads(k), heads(v)
    y = rwkv7_recurrence(r_h, heads(decay), k_h, v_h, -kk, kk * heads(iclr))
    mean = jnp.mean(y, axis=-1, keepdims=True)
    var = jnp.mean(jnp.square(y - mean), axis=-1, keepdims=True)
    y = ((y - mean) * lax.rsqrt(var + RWKV_GN_EPS)).reshape(Bsz, S, RWKV_WIDTH) * lnx_w + lnx_b
    bonus = jnp.sum(r_h * k_h * r_k, axis=-1, keepdims=True) * v_h
    return (y + bonus.reshape(Bsz, S, RWKV_WIDTH)) * gate


def gated_delta_rule_chunked(q, k, v, g, beta):
    Bsz, S, H, Dk = q.shape
    Dv = v.shape[-1]
    C = GDN_CHUNK
    N = S // C
    to_chunks = lambda t: jnp.moveaxis(t.reshape(Bsz, N, C, H, -1), 3, 1)
    q = to_chunks(q) * (Dk ** -0.5)
    k = to_chunks(k)
    v = to_chunks(v)
    g = jnp.cumsum(to_chunks(g[..., None])[..., 0], axis=-1)
    beta = to_chunks(beta[..., None])
    causal = jnp.tril(jnp.ones((C, C), dtype=bool))
    decay = jnp.exp(jnp.where(causal, g[..., :, None] - g[..., None, :], -jnp.inf))
    eye = jnp.eye(C, dtype=q.dtype)
    k_beta = k * beta
    strict = jnp.einsum('bhncd,bhnsd->bhncs', k_beta, k) * decay * (1.0 - eye)
    T = lax.linalg.triangular_solve(eye + strict, jnp.broadcast_to(eye, strict.shape),
                                    left_side=True, lower=True)
    u = T @ (v * beta)
    w = T @ (k_beta * jnp.exp(g)[..., None])
    intra = jnp.einsum('bhncd,bhnsd->bhncs', q, k) * decay
    q_dec = q * jnp.exp(g)[..., None]
    g_last = g[..., -1]
    k_dec = k * jnp.exp(g_last[..., None] - g)[..., None]

    def step(state, inp):
        q_i, k_i, u_i, w_i, a_i, gl_i = inp
        v_new = u_i - w_i @ state
        o = q_i @ state + a_i @ v_new
        state = state * jnp.exp(gl_i)[..., None, None] + jnp.swapaxes(k_i, -1, -2) @ v_new
        return state, o

    xs = tuple(jnp.moveaxis(t, 2, 0) for t in (q_dec, k_dec, u, w, intra, g_last))
    state0 = jnp.zeros((Bsz, H, Dk, Dv), jnp.float32)
    _, o = lax.scan(step, state0, xs)
    return jnp.transpose(o, (1, 0, 3, 2, 4)).reshape(Bsz, S, H, Dv)


def gdn_mixer(z, conv_w, a_log, dt_bias, norm_w):
    Bsz, S, _ = z.shape
    H, D = GDN_HEADS, HEAD_DIM
    qkv, gate, b, a = split_cols(z, (3 * GDN_WIDTH, GDN_WIDTH, H, H))
    qkv = jax.nn.silu(causal_depthwise_conv(qkv, conv_w))
    q, k, v = (t.reshape(Bsz, S, H, D) for t in jnp.split(qkv, 3, axis=-1))
    beta = jax.nn.sigmoid(b)
    g = -jnp.exp(a_log) * jax.nn.softplus(a + dt_bias)
    o = gated_delta_rule_chunked(l2_normalize(q), l2_normalize(k), v, g, beta)
    o = rms_norm(o, norm_w) * jax.nn.silu(gate.reshape(Bsz, S, H, D))
    return o.reshape(Bsz, S, GDN_WIDTH)


def t5_bucket(dist):
    max_exact = NUM_BUCKETS // 2
    nf = jnp.maximum(dist, max_exact).astype(jnp.float32)
    large = max_exact + (jnp.log(nf / max_exact) / math.log(MAX_DISTANCE / max_exact)
                         * (NUM_BUCKETS - max_exact)).astype(jnp.int32)
    large = jnp.minimum(large, NUM_BUCKETS - 1)
    return jnp.where(dist < max_exact, dist, large)


def band_offsets():
    L = ATTN_BLOCK
    i = jnp.arange(L)[:, None]
    j = jnp.arange(2 * L)[None, :]
    return i + L - j


def t5_band_bias(rel_bias):
    dist = jnp.maximum(band_offsets(), 0)
    return jnp.transpose(rel_bias[t5_bucket(dist)], (2, 0, 1))


def band_mask(nb):
    dist = band_offsets()
    in_window = (dist >= 0) & (dist < WINDOW)
    key_exists = (jnp.arange(nb)[:, None, None] > 0) | (jnp.arange(2 * ATTN_BLOCK)[None, None, :] >= ATTN_BLOCK)
    return in_window & key_exists


def swa_mixer(z, q_norm_w, k_norm_w, sinks, bias_band):
    Bsz, S, _ = z.shape
    Hq, Hkv, D, L = ATTN_Q_HEADS, ATTN_KV_HEADS, HEAD_DIM, ATTN_BLOCK
    G = Hq // Hkv
    nb = S // L
    q, k, v = split_cols(z, (ATTN_WIDTH, ATTN_KV_WIDTH, ATTN_KV_WIDTH))
    q = rms_norm(q.reshape(Bsz, S, Hq, D), q_norm_w).reshape(Bsz, nb, L, Hkv, G, D)
    k = rms_norm(k.reshape(Bsz, S, Hkv, D), k_norm_w)
    v = v.reshape(Bsz, S, Hkv, D)

    def band(t):
        tb = jnp.pad(t, ((0, 0), (L, 0), (0, 0), (0, 0))).reshape(Bsz, nb + 1, L, Hkv, D)
        return jnp.concatenate([tb[:, :-1], tb[:, 1:]], axis=2)

    scores = (jnp.einsum('bnqhgd,bnkhd->bhgnqk', q, band(k)) * (D ** -0.5)
              + bias_band.reshape(Hkv, G, 1, L, 2 * L).astype(jnp.float32))
    scores = jnp.where(band_mask(nb), scores, -jnp.inf)
    sink = jnp.broadcast_to(sinks.astype(jnp.float32).reshape(1, Hkv, G, 1, 1, 1), scores.shape[:-1] + (1,))
    probs = jax.nn.softmax(jnp.concatenate([scores, sink], axis=-1), axis=-1)[..., :-1]
    out = jnp.einsum('bhgnqk,bnkhd->bnqhgd', probs, band(v))
    return out.reshape(Bsz, S, ATTN_WIDTH)


def setup_inputs(seed: int = 0) -> dict:
    key = jax.random.key(seed)
    ks = iter(jax.random.split(key, 32))
    nrm = lambda shape, scale: scale * jax.random.normal(next(ks), shape, jnp.float32)
    L = DEPTH
    dt = jnp.exp(jax.random.uniform(next(ks), (L, GDN_HEADS), jnp.float32,
                                    minval=math.log(1e-3), maxval=math.log(1e-1)))
    return {
        "x": nrm((BATCH, SEQ, D_MODEL), 1.0),
        "ln1_w": 1.0 + nrm((L, D_MODEL), 0.1),
        "w_in": nrm((L, D_MODEL, D_IN), D_MODEL ** -0.5),
        "rwkv_mu": jax.random.uniform(next(ks), (L, RWKV_IN), jnp.float32),
        "rwkv_w0": jax.random.uniform(next(ks), (L, RWKV_WIDTH), jnp.float32, minval=-6.0, maxval=-1.0),
        "rwkv_w_up": nrm((L, RWKV_DECAY_RANK, RWKV_WIDTH), 0.1),
        "rwkv_a0": nrm((L, RWKV_WIDTH), 0.1),
        "rwkv_a_up": nrm((L, RWKV_ICLR_RANK, RWKV_WIDTH), RWKV_ICLR_RANK ** -0.5),
        "rwkv_g_up": nrm((L, RWKV_GATE_RANK, RWKV_WIDTH), RWKV_GATE_RANK ** -0.5),
        "rwkv_k_k": 0.85 + nrm((L, RWKV_WIDTH), 0.05),
        "rwkv_k_a": 1.0 + nrm((L, RWKV_WIDTH), 0.05),
        "rwkv_r_k": nrm((L, RWKV_HEADS, HEAD_DIM), 0.1),
        "rwkv_lnx_w": 1.0 + nrm((L, RWKV_WIDTH), 0.1),
        "rwkv_lnx_b": nrm((L, RWKV_WIDTH), 0.02),
        "gdn_conv_w": nrm((L, GDN_CONV, 3 * GDN_WIDTH), GDN_CONV ** -0.5),
        "gdn_a_log": jnp.log(jax.random.uniform(next(ks), (L, GDN_HEADS), jnp.float32, minval=1.0, maxval=16.0)),
        "gdn_dt_bias": dt + jnp.log(-jnp.expm1(-dt)),
        "gdn_norm_w": 1.0 + nrm((L, HEAD_DIM), 0.1),
        "attn_q_norm_w": 1.0 + nrm((L, HEAD_DIM), 0.1),
        "attn_k_norm_w": 1.0 + nrm((L, HEAD_DIM), 0.1),
        "attn_sinks": nrm((L, ATTN_Q_HEADS), 1.0),
        "rel_bias": nrm((NUM_BUCKETS, ATTN_Q_HEADS), 0.5),
        "w_out": nrm((L, D_MIX, D_MODEL), D_MIX ** -0.5),
        "ln2_w": 1.0 + nrm((L, D_MODEL), 0.1),
        "w_ff1": nrm((L, D_MODEL, D_FF), D_MODEL ** -0.5),
        "w_ff2": nrm((L, D_FF, D_MODEL), 0.5 * D_FF ** -0.5),
    }


def reference(x, ln1_w, w_in, rwkv_mu, rwkv_w0, rwkv_w_up, rwkv_a0, rwkv_a_up, rwkv_g_up,
              rwkv_k_k, rwkv_k_a, rwkv_r_k, rwkv_lnx_w, rwkv_lnx_b, gdn_conv_w, gdn_a_log,
              gdn_dt_bias, gdn_norm_w, attn_q_norm_w, attn_k_norm_w, attn_sinks, rel_bias,
              w_out, ln2_w, w_ff1, w_ff2):
    bias_band = t5_band_bias(rel_bias)
    for l in range(DEPTH):
        h = rms_norm(x, ln1_w[l])
        z = (h @ w_in[l]).astype(jnp.float32)
        z_a, z_b, z_c = split_cols(z, (RWKV_IN, GDN_IN, ATTN_IN))
        y_a = rwkv7_mixer(z_a, rwkv_mu[l], rwkv_w0[l], rwkv_w_up[l], rwkv_a0[l], rwkv_a_up[l],
                          rwkv_g_up[l], rwkv_k_k[l], rwkv_k_a[l], rwkv_r_k[l], rwkv_lnx_w[l], rwkv_lnx_b[l])
        y_b = gdn_mixer(z_b, gdn_conv_w[l], gdn_a_log[l], gdn_dt_bias[l], gdn_norm_w[l])
        y_c = swa_mixer(z_c, attn_q_norm_w[l], attn_k_norm_w[l], attn_sinks[l], bias_band)
        y = jnp.concatenate([y_a, y_b, y_c], axis=-1).astype(x.dtype)
        x = x + y @ w_out[l]
        h = rms_norm(x, ln2_w[l])
        x = x + jnp.square(jax.nn.relu(h @ w_ff1[l])) @ w_ff2[l]
    return x
```

```cpp
#include <hip/hip_runtime.h>
#include <cstdio>
#include <cstdint>
#include <cmath>
__device__ __forceinline__ int hwl_() { int t; asm volatile("v_mbcnt_lo_u32_b32 %0, -1, 0\n\tv_mbcnt_hi_u32_b32 %0, -1, %0" : "=v"(t)); return t; }
__device__ __forceinline__ float xor16f(float v) { return __builtin_bit_cast(float, __builtin_amdgcn_ds_swizzle(__builtin_bit_cast(int, v), 0x401F)); }
__device__ __forceinline__ float xor32f(float v) { return __builtin_bit_cast(float, __builtin_amdgcn_ds_bpermute((hwl_() ^ 32) << 2, __builtin_bit_cast(int, v))); }
namespace pg8 {
#define PG8_LAS __attribute__((address_space(3)))
typedef unsigned short bf16_t;
typedef short bf16x8 __attribute__((ext_vector_type(8)));
typedef float f32x4 __attribute__((ext_vector_type(4)));
typedef unsigned u32x4 __attribute__((ext_vector_type(4)));
constexpr int BM = 256, BK = 64, HALF = 128, HTB = HALF * BK * 2  , STAGE_BYTES = 8 * HTB, NXCD = 8, WGM = 8;

__host__ __device__ __forceinline__ int lds_byte(int r, int c) { const int st = (r >> 4) * 2 + (c >> 5), rr = r & 15, cc = c & 31, ob = rr * 64 + cc * 2; return st * 1024 + (ob ^ (((ob >> 9) & 1) << 5)); }
__host__ __device__ __forceinline__ void stage_rc(int b, int& R, int& C) { const int st = b / 1024, sb = b % 1024, swz = sb ^ (((sb >> 9) & 1) << 5); R = (st >> 1) * 16 + swz / 64; C = (st & 1) * 32 + (swz % 64) / 2; }
__host__ __device__ __forceinline__ int perm32(int rho) { const int n = rho >> 4, i = rho & 15; return 8 * (i >> 2) + 4 * n + (i & 3); }

struct Unit { int pm, pn; };
struct Gemm { const bf16_t* A; const bf16_t* Bt; int M, N, K; };

struct StaticOrder {
    int nM, nN, nwg, G, c;
    __host__ __device__ void init(int M, int N, int G_, int c_) { nM = M / BM; nN = N / BM; nwg = nM * nN; G = G_; c = c_; }
    __host__ __device__ bool next(int i, Unit& u) const {
        const long L = (long)i * G + c; if (L >= nwg) return false;
        int wgid = (int)L; { const int q = nwg / NXCD, r = nwg % NXCD, xcd = wgid % NXCD, off = wgid / NXCD; wgid = (xcd < r ? xcd * (q + 1) : r * (q + 1) + (xcd - r) * q) + off; }
        const int nig = WGM * nN, gid = wgid / nig, fm = gid * WGM, gsz = (nM - fm) < WGM ? (nM - fm) : WGM;
        u.pm = fm + ((wgid % nig) % gsz); u.pn = (wgid % nig) / gsz; return true;
    }
    __device__ __forceinline__ void a_ready(const Unit&) const {}
    __device__ __forceinline__ void done(const Unit&) const {}
};

__device__ __forceinline__ unsigned cvt_pk_bf16(float lo, float hi) { unsigned r; asm volatile("v_cvt_pk_bf16_f32 %0, %1, %2" : "=v"(r) : "v"(lo), "v"(hi)); return r; }
template <int ACT  > struct EpiBf16 {
    static constexpr bool PERM = true, AFTER_DRAIN = false;
    bf16_t* O; int ldc; const float* rss;
    __device__ __forceinline__ void operator()(const f32x4 (&acc)[2][2][4][2], const Unit& u, int wr, int wc, int fr, int fq) const {
        const int row0 = u.pm * BM + wr * 64 + fr, col0 = u.pn * BM + wc * 32 + 8 * fq;
#pragma unroll
        for (int ai = 0; ai < 2; ++ai)
#pragma unroll
            for (int m = 0; m < 4; ++m) { const int row = row0 + ai * HALF + m * 16; bf16_t* rowp = O + (size_t)row * ldc + col0;
                f32x4 pr = *(const f32x4*)(rss + (size_t)row * 16 + 4 * fq); float ssum = (pr[0] + pr[1]) + (pr[2] + pr[3]);
                ssum += ::xor16f(ssum); ssum += ::xor32f(ssum);
                const float rs = __builtin_amdgcn_rsqf(ssum * (1.f / 1024.f) + 1e-6f);
#pragma unroll
                for (int bj = 0; bj < 2; ++bj) { f32x4 v0 = acc[ai][bj][m][0] * rs, v1 = acc[ai][bj][m][1] * rs;
                    if (ACT == 2) {
#pragma unroll
                        for (int e = 0; e < 4; ++e) { const float a = v0[e] > 0.f ? v0[e] : 0.f, b = v1[e] > 0.f ? v1[e] : 0.f; v0[e] = a * a; v1[e] = b * b; } }
                    u32x4 w; w.x = cvt_pk_bf16(v0[0], v0[1]); w.y = cvt_pk_bf16(v0[2], v0[3]); w.z = cvt_pk_bf16(v1[0], v1[1]); w.w = cvt_pk_bf16(v1[2], v1[3]);
                    *(u32x4*)(rowp + bj * HALF) = w; } }
    }
};
struct EpiResF32 {
    static constexpr bool PERM = true, AFTER_DRAIN = false;
    const float* base; float* out; int ldc; bf16_t* xn; float* rss;
    __device__ __forceinline__ void operator()(const f32x4 (&acc)[2][2][4][2], const Unit& u, int wr, int wc, int fr, int fq) const {
        const int row0 = u.pm * BM + wr * 64 + fr, col0 = u.pn * BM + wc * 32 + 8 * fq;
#pragma unroll
        for (int ai = 0; ai < 2; ++ai)
#pragma unroll
            for (int m = 0; m < 4; ++m) { const int row = row0 + ai * HALF + m * 16; const size_t off = (size_t)row * ldc + col0; float ss = 0.f;
#pragma unroll
                for (int bj = 0; bj < 2; ++bj) {
                    const f32x4 b0 = *(const f32x4*)(base + off + bj * HALF), b1 = *(const f32x4*)(base + off + bj * HALF + 4);
                    const f32x4 o0 = b0 + acc[ai][bj][m][0], o1 = b1 + acc[ai][bj][m][1];
                    *(f32x4*)(out + off + bj * HALF) = o0; *(f32x4*)(out + off + bj * HALF + 4) = o1;
                    if (xn) { u32x4 w; w.x = cvt_pk_bf16(o0[0], o0[1]); w.y = cvt_pk_bf16(o0[2], o0[3]); w.z = cvt_pk_bf16(o1[0], o1[1]); w.w = cvt_pk_bf16(o1[2], o1[3]); *(u32x4*)(xn + off + bj * HALF) = w;
                        ss += ((o0[0] * o0[0] + o0[1] * o0[1]) + (o0[2] * o0[2] + o0[3] * o0[3])) + ((o1[0] * o1[0] + o1[1] * o1[1]) + (o1[2] * o1[2] + o1[3] * o1[3])); } }
                if (xn) { ss += ::xor16f(ss); ss += ::xor32f(ss); if (fq == 0) rss[(size_t)row * 16 + 4 * u.pn + wc] = ss; } }
    }
};

template <class Epi, class Sched, bool ALIGN_EPI = false, bool SP2 = false>
__device__ __forceinline__ void gemm_phase(PG8_LAS unsigned char* lds, const Gemm g, const Sched& S, const Epi& E, const int wave_id  ) {
    int tid_l = wave_id * 64 + ::hwl_();
    const int tid = tid_l, wid = __builtin_amdgcn_readfirstlane(tid >> 6), lane = tid & 63, wr = wid >> 2, wc = wid & 3, fr = lane & 15, fq = lane >> 4;
    const int K = g.K, nt = K / BK;
    unsigned voffA[2], voffB[2];
#pragma unroll
    for (int i = 0; i < 2; ++i) { int R, C; stage_rc(tid * 16 + i * 8192, R, C); const int Rb = Epi::PERM ? ((R & ~31) + perm32(R & 31)) : R;
        voffA[i] = (unsigned)(R * K + C) * 2u; voffB[i] = (unsigned)(Rb * K + C) * 2u; }
    const size_t kstep = (size_t)(BK * 2);
    const size_t hstep = (size_t)HALF * K * 2;
    const size_t tstep = 2 * hstep;
    const unsigned ldsw = (unsigned)wid * 1024u;
    const int aoff = lds_byte(wr * 64 + fr, fq * 8), boff = lds_byte(wc * 32 + fr, fq * 8);
#define PG8_SA(b, h) (((b) * 2 + (h)) * HTB)
#define PG8_SB(b, h) ((4 + (b) * 2 + (h)) * HTB)
#define PG8_STAGE(bufoff, gbase, voff) do { _Pragma("unroll") for (int _i = 0; _i < 2; ++_i) \
        __builtin_amdgcn_global_load_lds((const unsigned*)((const char*)(gbase) + (voff)[_i]), (PG8_LAS unsigned*)(lds + (bufoff) + ldsw + _i * 8192), 16, 0, 0); } while (0)
#define PG8_LDA(dst, b, h) do { _Pragma("unroll") for (int m = 0; m < 4; ++m) _Pragma("unroll") for (int k = 0; k < 2; ++k) dst[m][k] = *(const PG8_LAS bf16x8*)(lds + PG8_SA(b, h) + aoff + m * 2048 + k * 1024); } while (0)
#define PG8_LDB(dst, b, h) do { _Pragma("unroll") for (int n = 0; n < 2; ++n) _Pragma("unroll") for (int k = 0; k < 2; ++k) dst[n][k] = *(const PG8_LAS bf16x8*)(lds + PG8_SB(b, h) + boff + n * 2048 + k * 1024); } while (0)
#define PG8_MMA(ai, bj, At, Bt) do { __builtin_amdgcn_s_setprio(1); _Pragma("unroll") for (int m = 0; m < 4; ++m) _Pragma("unroll") for (int n = 0; n < 2; ++n) _Pragma("unroll") for (int k = 0; k < 2; ++k) \
        acc[ai][bj][m][n] = __builtin_amdgcn_mfma_f32_16x16x32_bf16(Bt[n][k], At[m][k], acc[ai][bj][m][n], 0, 0, 0); __builtin_amdgcn_s_setprio(0); } while (0)
#define PG8_WAIT_V(n) asm volatile("s_waitcnt vmcnt(" #n ")" ::: "memory")
#define PG8_WAIT_L(n) asm volatile("s_waitcnt lgkmcnt(" #n ")" ::: "memory")
#define PG8_BAR __builtin_amdgcn_s_barrier()
#define PG8_SCHED __builtin_amdgcn_sched_barrier(0)
    Unit cur, nxt; int ui = 0;
    if (!S.next(0, cur)) return;
    f32x4 acc[2][2][4][2];
#pragma unroll
    for (int a = 0; a < 2; ++a)
#pragma unroll
        for (int b = 0; b < 2; ++b)
#pragma unroll
            for (int m = 0; m < 4; ++m)
#pragma unroll
                for (int n = 0; n < 2; ++n) acc[a][b][m][n] = (f32x4){0.f, 0.f, 0.f, 0.f};
    bf16x8 At[4][2], B0[2][2], B1[2][2];
    const char* cA = (const char*)g.A + (size_t)cur.pm * tstep; const char* cB = (const char*)g.Bt + (size_t)cur.pn * tstep;
    S.a_ready(cur);
    if constexpr (SP2) {
        PG8_STAGE(PG8_SB(0, 0), cB, voffB); PG8_STAGE(PG8_SB(0, 1), cB + hstep, voffB); PG8_STAGE(PG8_SA(0, 0), cA, voffA); PG8_STAGE(PG8_SA(0, 1), cA + hstep, voffA);
        if (wr == 1) PG8_BAR;
        PG8_WAIT_V(2); PG8_BAR;
        PG8_STAGE(PG8_SB(1, 0), cB + kstep, voffB); PG8_STAGE(PG8_SA(1, 0), cA + kstep, voffA); PG8_STAGE(PG8_SB(1, 1), cB + hstep + kstep, voffB);
        PG8_WAIT_V(6); PG8_BAR;
    } else {
        PG8_STAGE(PG8_SB(0, 0), cB, voffB); PG8_STAGE(PG8_SA(0, 0), cA, voffA); PG8_STAGE(PG8_SB(0, 1), cB + hstep, voffB); PG8_STAGE(PG8_SA(0, 1), cA + hstep, voffA);
        if (wr == 1) PG8_BAR;
        PG8_WAIT_V(4); PG8_BAR;
        PG8_STAGE(PG8_SB(1, 0), cB + kstep, voffB); PG8_STAGE(PG8_SA(1, 0), cA + kstep, voffA); PG8_STAGE(PG8_SB(1, 1), cB + hstep + kstep, voffB);
        PG8_WAIT_V(6); PG8_BAR;
    }
    for (;;) {
        const bool has_next = S.next(ui + 1, nxt);
        const char* nA = has_next ? (const char*)g.A + (size_t)nxt.pm * tstep : cA; const char* nB = has_next ? (const char*)g.Bt + (size_t)nxt.pn * tstep : cB;
        for (int t = 0; t < nt; t += 2) {
            const bool last = (t == nt - 2);
            const char* a1 = cA + (size_t)(t + 1) * kstep;
            const char* a2 = last ? nA : cA + (size_t)(t + 2) * kstep; const char* b2 = last ? nB : cB + (size_t)(t + 2) * kstep;
            const char* a3 = a2 + kstep; const char* b3 = b2 + kstep;
            if (last && has_next) S.a_ready(nxt);
            if constexpr (SP2) {
            PG8_LDB(B0, 0, 0); PG8_LDB(B1, 0, 1); PG8_SCHED; PG8_LDA(At, 0, 0); PG8_STAGE(PG8_SA(1, 1), a1 + hstep, voffA);
            PG8_WAIT_V(8); PG8_WAIT_L(0); PG8_BAR; PG8_MMA(0, 0, At, B0); PG8_MMA(0, 1, At, B1); PG8_BAR; PG8_SCHED;
            PG8_LDA(At, 0, 1); PG8_STAGE(PG8_SB(0, 0), b2, voffB); PG8_STAGE(PG8_SB(0, 1), b2 + hstep, voffB); PG8_STAGE(PG8_SA(0, 0), a2, voffA);
            PG8_WAIT_V(8); PG8_WAIT_L(0); PG8_BAR; PG8_MMA(1, 0, At, B0); PG8_MMA(1, 1, At, B1); PG8_BAR; PG8_SCHED;
            PG8_LDB(B0, 1, 0); PG8_LDB(B1, 1, 1); PG8_SCHED; PG8_LDA(At, 1, 0); PG8_STAGE(PG8_SA(0, 1), a2 + hstep, voffA);
            PG8_WAIT_V(8); PG8_WAIT_L(0); PG8_BAR; PG8_MMA(0, 0, At, B0); PG8_MMA(0, 1, At, B1); PG8_BAR; PG8_SCHED;
            PG8_LDA(At, 1, 1); PG8_STAGE(PG8_SB(1, 0), b3, voffB); PG8_STAGE(PG8_SB(1, 1), b3 + hstep, voffB); PG8_STAGE(PG8_SA(1, 0), a3, voffA);
            PG8_WAIT_V(8); PG8_WAIT_L(0); PG8_BAR; PG8_MMA(1, 0, At, B0); PG8_MMA(1, 1, At, B1); PG8_BAR; PG8_SCHED;
            } else {
            PG8_LDB(B0, 0, 0); PG8_SCHED; PG8_LDA(At, 0, 0); PG8_STAGE(PG8_SA(1, 1), a1 + hstep, voffA);
            PG8_WAIT_L(8); PG8_BAR; PG8_WAIT_L(0); PG8_MMA(0, 0, At, B0); PG8_BAR; PG8_SCHED;
            PG8_LDB(B1, 0, 1); PG8_STAGE(PG8_SB(0, 0), b2, voffB);
            PG8_BAR; PG8_WAIT_L(0); PG8_MMA(0, 1, At, B1); PG8_BAR;
            PG8_LDA(At, 0, 1); PG8_STAGE(PG8_SA(0, 0), a2, voffA);
            PG8_BAR; PG8_WAIT_L(0); PG8_MMA(1, 0, At, B0); PG8_BAR; PG8_SCHED;
            PG8_STAGE(PG8_SB(0, 1), b2 + hstep, voffB);
            PG8_WAIT_V(6); PG8_BAR; PG8_MMA(1, 1, At, B1); PG8_BAR;
            PG8_LDB(B0, 1, 0); PG8_SCHED; PG8_LDA(At, 1, 0); PG8_STAGE(PG8_SA(0, 1), a2 + hstep, voffA);
            PG8_WAIT_L(8); PG8_BAR; PG8_WAIT_L(0); PG8_MMA(0, 0, At, B0); PG8_BAR; PG8_SCHED;
            PG8_LDB(B1, 1, 1); PG8_STAGE(PG8_SB(1, 0), b3, voffB);
            PG8_BAR; PG8_WAIT_L(0); PG8_MMA(0, 1, At, B1); PG8_BAR;
            PG8_LDA(At, 1, 1); PG8_STAGE(PG8_SA(1, 0), a3, voffA);
            PG8_BAR; PG8_WAIT_L(0); PG8_MMA(1, 0, At, B0); PG8_BAR; PG8_SCHED;
            PG8_STAGE(PG8_SB(1, 1), b3 + hstep, voffB);
            PG8_WAIT_V(6); PG8_BAR; PG8_MMA(1, 1, At, B1); PG8_BAR;
            }
        }
        if constexpr (ALIGN_EPI) { if (wr == 0) PG8_BAR; }
        if constexpr (!Epi::AFTER_DRAIN) { E(acc, cur, wr, wc, fr, fq); S.done(cur); }
        if (!has_next) break;
#pragma unroll
        for (int a = 0; a < 2; ++a)
#pragma unroll
            for (int b = 0; b < 2; ++b)
#pragma unroll
                for (int m = 0; m < 4; ++m)
#pragma unroll
                    for (int n = 0; n < 2; ++n) acc[a][b][m][n] = (f32x4){0.f, 0.f, 0.f, 0.f};
        cur = nxt; cA = nA; cB = nB; ++ui;
        if constexpr (ALIGN_EPI) { if (wr == 1) PG8_BAR; }
    }
    PG8_WAIT_V(0);
    if constexpr (!ALIGN_EPI) { if (wr == 0) PG8_BAR; }
    PG8_BAR;
    if constexpr (Epi::AFTER_DRAIN) { E.fused(acc, cur, wr, wc, fr, fq, lds, wid, lane); S.done(cur); }
#undef PG8_SA
#undef PG8_SB
#undef PG8_STAGE
#undef PG8_LDA
#undef PG8_LDB
#undef PG8_MMA
#undef PG8_WAIT_V
#undef PG8_WAIT_L
#undef PG8_BAR
#undef PG8_SCHED
}
}
constexpr int NWAVES = 8;
constexpr int BATCH = 16, SEQ = 2048, DM = 1024, DEPTH = 4, DFF = 4096;
constexpr int M = BATCH * SEQ;
constexpr int DIN = 2824;
constexpr int ZP = 3072;
constexpr int ZC_RW_R = 0, ZC_RW_K = 256, ZC_RW_V = 512, ZC_RW_DW = 768;
constexpr int ZC_GD_Q = 1024, ZC_GD_K = 1280, ZC_GD_V = 1536, ZC_GD_G = 1792;
constexpr int ZC_AT_Q = 2048, ZC_AT_K = 2560, ZC_AT_V = 2688;
constexpr int ZC_GD_B = 2816, ZC_GD_A = 2820;
__host__ __device__ __forceinline__ int win_src_col(int n) {
    if (n < 2048) return n;
    if (n < 2816) return n + 8;
    if (n < 2824) return n - 2816 + 2048;
    return -1;
}
constexpr size_t MiB = 1u << 20;
constexpr size_t WS_CTL = 0, CTL_ZERO_BYTES = 1 * MiB;
constexpr size_t WS_WIN = 1 * MiB;
constexpr size_t WS_WOUT = WS_WIN + (size_t)DEPTH * ZP * DM * 2;
constexpr size_t WS_W1 = WS_WOUT + (size_t)DEPTH * DM * DM * 2;
constexpr size_t WS_W2 = WS_W1 + (size_t)DEPTH * DFF * DM * 2;
constexpr size_t WS_XN = WS_W2 + (size_t)DEPTH * DM * DFF * 2;
constexpr size_t WS_Z = WS_XN + (size_t)M * DM * 2;
constexpr size_t WS_Y = WS_Z + (size_t)M * ZP * 2;
constexpr size_t WS_H = WS_Z;
constexpr size_t WS_HB = WS_Y + (size_t)M * DM * 2;
constexpr size_t WS_RSS = WS_HB + (size_t)256 * 8 * 24576;
constexpr size_t WS_XS = WS_RSS + (size_t)2 * DEPTH * M * 16 * 4;
constexpr size_t WS_END = WS_XS + (size_t)128 * 16384;
static_assert(WS_H + (size_t)M * DFF * 2 <= WS_HB, "H overlay");
static_assert(WS_END <= 512 * MiB, "d_ws map");
constexpr int CW_TMO = 8192, CW_SEQ = 16384;
constexpr int CW_BAR = 4096;
constexpr int RING_OFF = 0, RING_BYTES = 131072;
constexpr int LDSCTL_OFF = 158720, MISC_OFF = LDSCTL_OFF + 320;
constexpr int BIAS_OFF = LDSCTL_OFF + 1024;
constexpr int LDS_BYTES = 163840;
static_assert(BIAS_OFF + 4096 <= LDS_BYTES, "LDS map");

#define GAS __attribute__((address_space(1)))
#define LAS __attribute__((address_space(3)))
typedef unsigned short bf16;
typedef unsigned v4u __attribute__((ext_vector_type(4)));
typedef unsigned v2u __attribute__((ext_vector_type(2)));
typedef float f32x4 __attribute__((ext_vector_type(4)));
typedef GAS unsigned gu32;
#define RLX_AGENT __ATOMIC_RELAXED, __HIP_MEMORY_SCOPE_AGENT
#define LDS_WAIT() asm volatile("s_waitcnt lgkmcnt(0)" ::: "memory")
#define VM_WAIT() asm volatile("s_waitcnt vmcnt(0)" ::: "memory")
__device__ __forceinline__ int hw_lane() { return hwl_(); }
__device__ __forceinline__ unsigned f2bf(float f) { unsigned u = __builtin_bit_cast(unsigned, f); return (u + 0x7fffu + ((u >> 16) & 1u)) >> 16; }
__device__ __forceinline__ unsigned pk2(float lo, float hi) { return f2bf(lo) | (f2bf(hi) << 16); }
__device__ __forceinline__ float bf2f(unsigned short h) { return __builtin_bit_cast(float, (unsigned)h << 16); }
__device__ __forceinline__ float bflo(unsigned u) { return __builtin_bit_cast(float, u << 16); }
__device__ __forceinline__ float bfhi(unsigned u) { return __builtin_bit_cast(float, u & 0xffff0000u); }
__device__ __forceinline__ float sigmoidf_(float x) { return 1.f / (1.f + __expf(-x)); }
__device__ __forceinline__ float softplusf_(float x) { return fmaxf(x, 0.f) + log1pf(__expf(-fabsf(x))); }
__device__ __forceinline__ float dppf(float v, const int ctrl_sel) {
    int r;
    const int s = __builtin_bit_cast(int, v);
    if (ctrl_sel == 0) r = __builtin_amdgcn_update_dpp(0, s, 0xB1, 0xF, 0xF, true);
    else if (ctrl_sel == 1) r = __builtin_amdgcn_update_dpp(0, s, 0x4E, 0xF, 0xF, true);
    else if (ctrl_sel == 2) r = __builtin_amdgcn_update_dpp(0, s, 0x141, 0xF, 0xF, true);
    else r = __builtin_amdgcn_update_dpp(0, s, 0x140, 0xF, 0xF, true);
    return __builtin_bit_cast(float, r);
}
__device__ __forceinline__ float wave_allsum(float v) {
    v += dppf(v, 0); v += dppf(v, 1); v += dppf(v, 2); v += dppf(v, 3);
    const float a = __builtin_bit_cast(float, __builtin_amdgcn_readlane(__builtin_bit_cast(int, v), 0));
    const float b = __builtin_bit_cast(float, __builtin_amdgcn_readlane(__builtin_bit_cast(int, v), 16));
    const float c = __builtin_bit_cast(float, __builtin_amdgcn_readlane(__builtin_bit_cast(int, v), 32));
    const float d = __builtin_bit_cast(float, __builtin_amdgcn_readlane(__builtin_bit_cast(int, v), 48));
    return (a + b) + (c + d);
}
#define XB_TMO      128
#define XB_XCNT(j)  (256  + 64 * (j))
#define XB_XSUB(j)  (1280 + 64 * (j))
#define XB_XGEN(j)  (2304 + 64 * (j))
#define XB_TOP      3328
#define XB_TOPGEN   3392
#define XCD_BAR_WORDS 3456
#define XB_SPIN_CAP (1u << 18)

__device__ __forceinline__ unsigned xb_ld(unsigned* p)              { return __hip_atomic_load(p, __ATOMIC_RELAXED, __HIP_MEMORY_SCOPE_AGENT); }
__device__ __forceinline__ unsigned xb_add(unsigned* p, unsigned v) { return __hip_atomic_fetch_add(p, v, __ATOMIC_RELAXED, __HIP_MEMORY_SCOPE_AGENT); }
__device__ __forceinline__ unsigned xb_xcc_id() { return (unsigned)__builtin_amdgcn_s_getreg((3 << 11) | 20) & 0xFu; }
#define XB_SPIN(cond, bar) do { unsigned _sp = 0; while (cond) { __builtin_amdgcn_s_sleep(1); \
    if ((++_sp & 255u) == 0u) { if (xb_ld(&(bar)[XB_TMO])) break; if (_sp > XB_SPIN_CAP) { atomicAdd(&(bar)[XB_TMO], 1u); break; } } } } while (0)

struct XcdBarrier {
    unsigned* bar; unsigned x;
    volatile LAS unsigned* st;
};

__device__ __forceinline__ XcdBarrier xcd_barrier_post(unsigned* bar, volatile LAS unsigned* st, const bool t0  ) {
    XcdBarrier b; b.bar = bar; b.x = xb_xcc_id(); b.st = st;
    if (t0) (void)xb_add(&bar[XB_XCNT(b.x)], 1u);
    return b;
}
__device__ __forceinline__ void xcd_barrier_complete(unsigned* bar, unsigned x, unsigned& nloc, unsigned& nx) {
    const unsigned G = gridDim.x * gridDim.y * gridDim.z;
    unsigned sum, cnt, mine, sp = 0u;
    for (;;) {
        sum = 0u; cnt = 0u; mine = 0u;
#pragma unroll
        for (unsigned j = 0; j < 16; ++j) { const unsigned c = xb_ld(&bar[XB_XCNT(j)]); sum += c; cnt += (c > 0u) ? 1u : 0u; mine = (j == x) ? c : mine; }
        if (sum == G) break;
        __builtin_amdgcn_s_sleep(1);
        if ((++sp & 255u) == 0u) { if (xb_ld(&bar[XB_TMO])) break; if (sp > XB_SPIN_CAP) { atomicAdd(&bar[XB_TMO], 1u); break; } }
    }
    nloc = mine > 0u ? mine : 1u; nx = cnt > 0u ? cnt : 1u;
}

__device__ __forceinline__ void xcd_barrier(const XcdBarrier& b, const bool t0  ) {
    asm volatile("s_waitcnt vmcnt(0)" ::: "memory");
    __syncthreads();
    if (t0) {
        unsigned* bar = b.bar;
        __builtin_amdgcn_s_waitcnt(0);
        unsigned nloc = b.st[0], nx = b.st[1];
        if (nloc == 0u) { xcd_barrier_complete(bar, b.x, nloc, nx); b.st[0] = nloc; b.st[1] = nx; }
        const unsigned old = xb_add(&bar[XB_XSUB(b.x)], 1u);
        const unsigned gen = old / nloc;
        if (old + 1u == (gen + 1u) * nloc) {
            __builtin_amdgcn_fence(__ATOMIC_RELEASE, "agent");
            asm volatile("s_waitcnt vmcnt(0)" ::: "memory");
            const unsigned og = xb_add(&bar[XB_TOP], 1u);
            const unsigned tg = og / nx;
            if (og + 1u == (tg + 1u) * nx) xb_add(&bar[XB_TOPGEN], 1u);
            else XB_SPIN(xb_ld(&bar[XB_TOPGEN]) == tg, bar);
            __builtin_amdgcn_fence(__ATOMIC_ACQUIRE, "agent");
            xb_add(&bar[XB_XGEN(b.x)], 1u);
            asm volatile("s_waitcnt vmcnt(0)" ::: "memory");
        } else {
            XB_SPIN(xb_ld(&bar[XB_XGEN(b.x)]) == gen, bar);
            __builtin_amdgcn_fence(__ATOMIC_ACQUIRE, "agent");
            asm volatile("s_waitcnt vmcnt(0)" ::: "memory");
        }
    }
    __syncthreads();
}
struct Frame {
    LAS unsigned char* lds;
    int wave;
    int vcu, G;
    unsigned char* ws;
    float* out;
};
typedef const float* cfp;
typedef const __attribute__((address_space(4))) cfp* karg_tab;
__device__ __forceinline__ karg_tab ktab() { karg_tab t = (karg_tab)__builtin_amdgcn_kernarg_segment_ptr(); asm volatile("" : "+s"(t)); return t; }
#define INP(i) (ktab()[i])
__device__ __forceinline__ int ltid() { return hw_lane(); }
__device__ __forceinline__ unsigned char* lnd(unsigned char* p) { asm volatile("" : "+s"(p)); return p; }
#define WSP(off) (lnd(F.ws) + (off))
#define FZ ((bf16*)WSP(WS_Z))
#define FY ((bf16*)WSP(WS_Y))
#define FXN ((bf16*)WSP(WS_XN))
#define FH ((bf16*)WSP(WS_H))
enum { I_X = 0, I_LN1 = 1, I_WIN = 2, I_MU = 3, I_W0 = 4, I_WUP = 5, I_A0 = 6, I_AUP = 7, I_GUP = 8, I_KK = 9, I_KA = 10, I_RK = 11, I_LNXW = 12, I_LNXB = 13,
       I_CONV = 14, I_ALOG = 15, I_DTB = 16, I_GNW = 17, I_QNW = 18, I_KNW = 19, I_SINK = 20, I_RELB = 21, I_WOUT = 22, I_LN2 = 23, I_WFF1 = 24, I_WFF2 = 25 };

template <bool MAP>
__device__ __forceinline__ void p0_transpose_item(const float* W, int K, int Nsrc, int Ndst, bf16* WT, LAS float* scr, int item, int lane, const float* kscale = nullptr) {
    const int nblk = Ndst / 64, kb = item / nblk, nb = item % nblk, k0 = 64 * kb, n0 = 64 * nb;
    const int c4 = lane & 15, r = lane >> 4;
    const int nn = n0 + 4 * c4; const int src = MAP ? win_src_col(nn) : nn;
#pragma unroll 8
    for (int i = 0; i < 16; ++i) { const int kk = 4 * i + r;
        f32x4 v = {0.f, 0.f, 0.f, 0.f}; if (src >= 0) v = *(const GAS f32x4*)(W + (size_t)(k0 + kk) * Nsrc + src);
        const float sc = kscale ? kscale[k0 + kk] : 1.f;
        LAS float* d = scr + kk * 65 + 4 * c4; d[0] = v.x * sc; d[1] = v.y * sc; d[2] = v.z * sc; d[3] = v.w * sc; }
    LDS_WAIT(); asm volatile("" ::: "memory");
    const int c = lane & 7;
#pragma unroll
    for (int j = 0; j < 8; ++j) { const int n = (lane >> 3) + 8 * j; const LAS float* s = scr + (8 * c) * 65 + n;
        v4u o; o.x = pk2(s[0 * 65], s[1 * 65]); o.y = pk2(s[2 * 65], s[3 * 65]); o.z = pk2(s[4 * 65], s[5 * 65]); o.w = pk2(s[6 * 65], s[7 * 65]);
        *(GAS v4u*)(WT + (size_t)(n0 + n) * K + k0 + 8 * c) = o; }
    LDS_WAIT(); asm volatile("" ::: "memory");
}
__device__ __forceinline__ void cast_rows(Frame& F, const float* x, bf16* xn, float* rss) {
    const int lane = ltid() & 63;
    const int gw = F.vcu * NWAVES + F.wave, NGW = F.G * NWAVES;
    for (int m = gw; m < M; m += NGW) {
        const GAS f32x4* xr = (const GAS f32x4*)(x + (size_t)m * DM) + lane;
        f32x4 v[4]; float s = 0.f;
#pragma unroll
        for (int j = 0; j < 4; ++j) { v[j] = xr[64 * j]; s += (v[j].x * v[j].x + v[j].y * v[j].y) + (v[j].z * v[j].z + v[j].w * v[j].w); }
        s = wave_allsum(s);
        if (lane < 16) rss[(size_t)m * 16 + lane] = (lane == 0) ? s : 0.f;
        GAS unsigned long long* o8 = (GAS unsigned long long*)(xn + (size_t)m * DM) + lane;
#pragma unroll
        for (int j = 0; j < 4; ++j) o8[64 * j] = (unsigned long long)pk2(v[j].x, v[j].y) | ((unsigned long long)pk2(v[j].z, v[j].w) << 32);
    }
}
__device__ __forceinline__ void p0_prologue(Frame& F) {
    const int lane_ = ltid() & 63;
    LAS float* scr = (LAS float*)(F.lds + RING_OFF + F.wave * 16640);
    const int gw = F.vcu * NWAVES + F.wave, NGW = F.G * NWAVES;
    constexpr int I_IN = (DM / 64) * (ZP / 64), I_O = (DM / 64) * (DM / 64), I_1 = (DM / 64) * (DFF / 64), I_2 = (DFF / 64) * (DM / 64);
    constexpr int PER_L = I_IN + I_O + I_1 + I_2, NITEMS = DEPTH * PER_L;
    for (int it = gw; it < NITEMS; it += NGW) {
        const int l = it / PER_L; int r = it % PER_L;
        if (r < I_IN) { p0_transpose_item<true>(INP(I_WIN) + (size_t)l * DM * DIN, DM, DIN, ZP, ((bf16*)WSP(WS_WIN)) + (size_t)l * ZP * DM, scr, r, lane_, INP(I_LN1) + (size_t)l * DM); continue; } r -= I_IN;
        if (r < I_O) { p0_transpose_item<false>(INP(I_WOUT) + (size_t)l * DM * DM, DM, DM, DM, ((bf16*)WSP(WS_WOUT)) + (size_t)l * DM * DM, scr, r, lane_); continue; } r -= I_O;
        if (r < I_1) { p0_transpose_item<false>(INP(I_WFF1) + (size_t)l * DM * DFF, DM, DFF, DFF, ((bf16*)WSP(WS_W1)) + (size_t)l * DFF * DM, scr, r, lane_, INP(I_LN2) + (size_t)l * DM); continue; } r -= I_1;
        p0_transpose_item<false>(INP(I_WFF2) + (size_t)l * DFF * DM, DFF, DM, DM, ((bf16*)WSP(WS_W2)) + (size_t)l * DM * DFF, scr, r, lane_);
    }
    cast_rows(F, INP(I_X), FXN, (float*)WSP(WS_RSS));
}

#define MX_DEV __device__ __forceinline__
#define MX_G __attribute__((address_space(1)))
#define MX_L __attribute__((address_space(3)))
#define MX_EXP(x) __expf(x)
#define MX_LOG1P(x) log1pf(x)
#define MXIN(i) ((const MX_G float*)INP(i))
#define MX_VMWAIT() asm volatile("s_waitcnt vmcnt(0)" ::: "memory")
#define MX_LDSWAIT() asm volatile("s_waitcnt lgkmcnt(0)" ::: "memory")
#define MX_SCHED() __builtin_amdgcn_sched_barrier(0)
#define MX_LAUNDER_S(p) asm volatile("" : "+s"(p))
#define MX_LAUNDER_V(p) asm volatile("" : "+v"(p))
#define MX_CONSUME(x) asm volatile("" :: "v"(x))
#define MX_FMAC(acc, a, b) asm("v_fmac_f32_e32 %0, %1, %2" : "+v"(acc) : "v"(a), "v"(b))
#define MX_RCP(x) __builtin_amdgcn_rcpf(x)
#define MX_RSQ(x) __builtin_amdgcn_rsqf(x)
#define MX_LOG(x) __logf(x)
typedef __bf16 mx_bf2_t __attribute__((ext_vector_type(2)));
typedef float mx_f2_t __attribute__((ext_vector_type(2)));
__device__ __forceinline__ unsigned mx_hwpk2(float lo, float hi) { mx_f2_t v = {lo, hi}; return __builtin_bit_cast(unsigned, __builtin_convertvector(v, mx_bf2_t)); }
#define MX_PK2(lo, hi) mx_hwpk2(lo, hi)
#define MX_UNIFORM(x) __builtin_amdgcn_readfirstlane(x)
#define MX_ROW_SHR(v, d) __builtin_bit_cast(float, __builtin_amdgcn_update_dpp(0, __builtin_bit_cast(int, (v)), 0x110 + (d), 0xF, 0xF, true))
#define MX_ROW_SHRU(v, d) ((unsigned)__builtin_amdgcn_update_dpp(0, (int)(v), 0x110 + (d), 0xF, 0xF, true))
#define MX_ROW_RORU(v, d) ((unsigned)__builtin_amdgcn_update_dpp(0, (int)(v), 0x120 + (d), 0xF, 0xF, true))
#define MX_ROW_LAST(v) __builtin_bit_cast(float, __builtin_amdgcn_update_dpp(0, __builtin_bit_cast(int, (v)), 0x15F, 0xF, 0xF, true))
#define MX_ROW_SHR(v, d) __builtin_bit_cast(float, __builtin_amdgcn_update_dpp(0, __builtin_bit_cast(int, (v)), 0x110 + (d), 0xF, 0xF, true))
#define MX_ROW_LAST(v) __builtin_bit_cast(float, __builtin_amdgcn_update_dpp(0, __builtin_bit_cast(int, (v)), 0x15F, 0xF, 0xF, true))
typedef unsigned mx_u2_t __attribute__((ext_vector_type(2)));
__device__ __forceinline__ float mx_hw_rowsum4(float v) {
    const mx_u2_t a = __builtin_amdgcn_permlane16_swap(__builtin_bit_cast(unsigned, v), __builtin_bit_cast(unsigned, v), false, false);
    const float s = __builtin_bit_cast(float, a.x) + __builtin_bit_cast(float, a.y);
    const mx_u2_t b = __builtin_amdgcn_permlane32_swap(__builtin_bit_cast(unsigned, s), __builtin_bit_cast(unsigned, s), false, false);
    return __builtin_bit_cast(float, b.x) + __builtin_bit_cast(float, b.y);
}
#define MX_ROWSUM4(v) mx_hw_rowsum4(v)
#define MX_FLAG_LOAD(p) __hip_atomic_load((p), __ATOMIC_RELAXED, __HIP_MEMORY_SCOPE_AGENT)
#define MX_FLAG_STORE(p, v) __hip_atomic_store((p), (v), __ATOMIC_RELAXED, __HIP_MEMORY_SCOPE_AGENT)
#define MX_FLAG_ADD(p, v) __hip_atomic_fetch_add((p), (v), __ATOMIC_RELAXED, __HIP_MEMORY_SCOPE_AGENT)
#define MX_SLEEP() __builtin_amdgcn_s_sleep(2)
#define MX_SC1_LOAD64(p) __hip_atomic_load((p), __ATOMIC_RELAXED, __HIP_MEMORY_SCOPE_AGENT)
#define MX_SC1_STORE64(p, v) __hip_atomic_store((p), (v), __ATOMIC_RELAXED, __HIP_MEMORY_SCOPE_AGENT)
__device__ __forceinline__ int mx_lane() { return ltid() & 63; }
__device__ __forceinline__ void mx_wgsync() { __syncthreads(); }
__device__ __forceinline__ float mx_shfl_xor(float v, int m) { return m == 16 ? xor16f(v) : xor32f(v); }
__device__ __forceinline__ float mx_shfl16l(float v, int src, int lane) { return __builtin_bit_cast(float, __builtin_amdgcn_ds_bpermute(((lane & 48) | src) << 2, __builtin_bit_cast(int, v))); }
typedef short mx_bf16x8_t __attribute__((ext_vector_type(8)));
typedef float mx_f32x4_t __attribute__((ext_vector_type(4)));
__device__ __forceinline__ mx_f32x4_t mx_mfma(mx_bf16x8_t a, mx_bf16x8_t b, mx_f32x4_t c) { return __builtin_amdgcn_mfma_f32_16x16x32_bf16(a, b, c, 0, 0, 0); }
typedef short mx_s16x4_t __attribute__((ext_vector_type(4)));
#define MX_MFMA16(a, b, c) __builtin_amdgcn_mfma_f32_16x16x16bf16_1k(__builtin_bit_cast(mx_s16x4_t, a), __builtin_bit_cast(mx_s16x4_t, b), c, 0, 0, 0)
typedef short mx_bf16x8 __attribute__((ext_vector_type(8)));
typedef float mx_f32x4 __attribute__((ext_vector_type(4)));
typedef unsigned mx_u32x4 __attribute__((ext_vector_type(4)));
typedef unsigned mx_u32x2 __attribute__((ext_vector_type(2)));

MX_DEV unsigned mx_bf(float f) { unsigned u = __builtin_bit_cast(unsigned, f); return (u + 0x7fffu + ((u >> 16) & 1u)) >> 16; }
MX_DEV unsigned mx_pk2(float lo, float hi) { return MX_PK2(lo, hi); }
MX_DEV float mx_lo(unsigned u) { return __builtin_bit_cast(float, u << 16); }
MX_DEV float mx_hi(unsigned u) { return __builtin_bit_cast(float, u & 0xffff0000u); }
MX_DEV mx_bf16x8 mx_frag8(const float* a, const float* b) {
    mx_u32x4 w; w.x = mx_pk2(a[0], a[1]); w.y = mx_pk2(a[2], a[3]); w.z = mx_pk2(b[0], b[1]); w.w = mx_pk2(b[2], b[3]); return __builtin_bit_cast(mx_bf16x8, w); }
MX_DEV mx_bf16x8 mx_frag8v(mx_f32x4 a, mx_f32x4 b) {
    mx_u32x4 w; w.x = mx_pk2(a.x, a.y); w.y = mx_pk2(a.z, a.w); w.z = mx_pk2(b.x, b.y); w.w = mx_pk2(b.z, b.w); return __builtin_bit_cast(mx_bf16x8, w); }
MX_DEV mx_u32x2 mx_frag4(mx_f32x4 a) { mx_u32x2 w; w.x = mx_pk2(a.x, a.y); w.y = mx_pk2(a.z, a.w); return w; }
MX_DEV mx_f32x4 mx_mfma(mx_u32x2 a, mx_u32x2 b, mx_f32x4 c) { return MX_MFMA16(a, b, c); }
typedef unsigned long long mx_u64x2 __attribute__((ext_vector_type(2)));
MX_DEV mx_u32x2 mx_frag4p(mx_u32x2 p) { return p; }
MX_DEV mx_u32x2 mx_pack4(mx_f32x4 a) { mx_u32x2 p; p.x = mx_pk2(a.x, a.y); p.y = mx_pk2(a.z, a.w); return p; }
MX_DEV mx_f32x4 mx_zero4() { mx_f32x4 z = {0.f, 0.f, 0.f, 0.f}; return z; }
MX_DEV float mx_sigmoid(float x) { return MX_RCP(1.f + MX_EXP(-x)); }
MX_DEV float mx_softplus(float x) { return fmaxf(x, 0.f) + MX_LOG(1.f + MX_EXP(-fabsf(x))); }
MX_DEV float mx_rowsum4(float v) { v += mx_shfl_xor(v, 16); v += mx_shfl_xor(v, 32); return v; }

constexpr int MX_HB_WA = 0, MX_HB_RT = 2048, MX_HB_ARB = 4096, MX_HB_ARK = 4608, MX_HB_BH = 5120, MX_HB_KH = 7168, MX_HB_VC = 9216, MX_HB_U0 = 11264, MX_HB_GAM = 13312, MX_HB_SLOT = 13568;
constexpr int MX_GB_GT = 0, MX_GB_EE = 2048, MX_GB_SLOT = 4096;
constexpr int MX_LDS_HB = 0, MX_LDS_WW = 108544, MX_LDS_WA = 117760, MX_LDS_WG = 126976, MX_LDS_PAR = 144384, MX_LDS_ST = 148480, MX_LDS_GAM = 152576  , MX_LDS_END = 156672, MX_RS64 = 144, MX_RS128 = 272;
constexpr int MX_P_MUR = 256, MX_P_MUK = 320, MX_P_MUV = 384, MX_P_W0 = 448, MX_P_A0 = 512, MX_P_KK = 576, MX_P_KA = 640, MX_P_RK = 704, MX_P_LNW = 768, MX_P_LNB = 832, MX_P_GNW = 768;

MX_DEV void mx_prep_back(float (&lw)[16], float (&a)[16], float (&b)[16], float (&k2)[16], float (&r)[16], float (&v)[16], MX_L unsigned char* slot, MX_L unsigned char* gamp  , bool midbar, int lane) {
    const int tk = lane & 15, g = lane >> 4;
    float G[16];
#pragma unroll
    for (int i = 0; i < 16; ++i) G[i] = lw[i];
#pragma unroll
    for (int i = 0; i < 16; ++i) { G[i] += MX_ROW_SHR(G[i], 1); G[i] += MX_ROW_SHR(G[i], 2); G[i] += MX_ROW_SHR(G[i], 4); G[i] += MX_ROW_SHR(G[i], 8); }
    MX_SCHED();
    mx_bf16x8 AtF[2], BtF[2], KtF[2], RtF[2], BhF[2], KhF[2], VF[2];
    {
        float x[16];
#pragma unroll
        for (int i = 0; i < 16; ++i) { x[i] = a[i] * MX_EXP(G[i] - lw[i]); }
        AtF[0] = mx_frag8(x, x + 4); AtF[1] = mx_frag8(x + 8, x + 12);
    }
    MX_SCHED();
    {
        float x[16];
#pragma unroll
        for (int i = 0; i < 16; ++i) { x[i] = r[i] * MX_EXP(G[i]); }
        RtF[0] = mx_frag8(x, x + 4); RtF[1] = mx_frag8(x + 8, x + 12);
        VF[0] = mx_frag8(v, v + 4); VF[1] = mx_frag8(v + 8, v + 12);
    }
    MX_SCHED();
    {
        float x[16], y[16];
#pragma unroll
        for (int i = 0; i < 16; ++i) { const float e = MX_EXP(-G[i]); x[i] = b[i] * e; y[i] = k2[i] * e; }
        BtF[0] = mx_frag8(x, x + 4); BtF[1] = mx_frag8(x + 8, x + 12); KtF[0] = mx_frag8(y, y + 4); KtF[1] = mx_frag8(y + 8, y + 12);
    }
    MX_SCHED();
    {
        float x[16], y[16], gam[16];
#pragma unroll
        for (int i = 0; i < 16; ++i) { const float gc = MX_ROW_LAST(G[i]); const float e = MX_EXP(gc - G[i]); x[i] = b[i] * e; y[i] = k2[i] * e; gam[i] = MX_EXP(gc); }
        BhF[0] = mx_frag8(x, x + 4); BhF[1] = mx_frag8(x + 8, x + 12); KhF[0] = mx_frag8(y, y + 4); KhF[1] = mx_frag8(y + 8, y + 12);
        if (tk == 0) {
#pragma unroll
            for (int ct = 0; ct < 4; ++ct) { mx_f32x4 q = {gam[4 * ct], gam[4 * ct + 1], gam[4 * ct + 2], gam[4 * ct + 3]}; *(MX_L mx_f32x4*)(gamp + (unsigned)((16 * ct + 4 * g) * 4)) = q; } }
    }
    MX_SCHED();
    const mx_f32x4 z4 = mx_zero4();
    mx_f32x4 L = mx_mfma(BtF[1], AtF[1], mx_mfma(BtF[0], AtF[0], z4));
    mx_f32x4 LT = mx_mfma(AtF[1], BtF[1], mx_mfma(AtF[0], BtF[0], z4));
    mx_f32x4 Lak = mx_mfma(KtF[1], AtF[1], mx_mfma(KtF[0], AtF[0], z4));
    mx_f32x4 Arb = mx_mfma(BtF[1], RtF[1], mx_mfma(BtF[0], RtF[0], z4));
    mx_f32x4 Ark = mx_mfma(KtF[1], RtF[1], mx_mfma(KtF[0], RtF[0], z4));
#pragma unroll
    for (int e = 0; e < 4; ++e) { const int s = 4 * g + e;
        L[e] = (s < tk) ? L[e] : 0.f; LT[e] = (s > tk) ? LT[e] : 0.f; Lak[e] = (s < tk) ? Lak[e] : 0.f; Arb[e] = (s <= tk) ? Arb[e] : 0.f; Ark[e] = (s <= tk) ? Ark[e] : 0.f; }
    if (midbar) { MX_LDSWAIT(); mx_wgsync(); }
    *(MX_L mx_bf16x8*)(slot + (unsigned)(MX_HB_RT + lane * 16)) = RtF[0]; *(MX_L mx_bf16x8*)(slot + (unsigned)(MX_HB_RT + 1024 + lane * 16)) = RtF[1];
    *(MX_L mx_u32x2*)(slot + (unsigned)(MX_HB_ARB + lane * 8)) = mx_pack4(Arb); *(MX_L mx_u32x2*)(slot + (unsigned)(MX_HB_ARK + lane * 8)) = mx_pack4(Ark);
    mx_f32x4 T = L;
#pragma unroll
    for (int e = 0; e < 4; ++e) T[e] += (4 * g + e == tk) ? 1.f : 0.f;
    {
        const mx_u32x2 fL = mx_frag4(L), fLT = mx_frag4(LT);
        const mx_f32x4 L2 = mx_mfma(fLT, fL, z4), L2T = mx_mfma(fL, fLT, z4);
        const mx_u32x2 fL2 = mx_frag4(L2), fL2T = mx_frag4(L2T);
        T = mx_mfma(fL2T, mx_frag4(T), T);
        const mx_f32x4 L4 = mx_mfma(fL2T, fL2, z4), L4T = mx_mfma(fL2, fL2T, z4);
        const mx_u32x2 fL4 = mx_frag4(L4), fL4T = mx_frag4(L4T);
        T = mx_mfma(fL4T, mx_frag4(T), T);
        const mx_f32x4 L8T = mx_mfma(fL4, fL4T, z4);
        T = mx_mfma(mx_frag4(L8T), mx_frag4(T), T);
    }
    const mx_u32x2 fT = mx_frag4(T), fLak = mx_frag4(Lak);
    mx_bf16x8 Sel[2];
#pragma unroll
    for (int p = 0; p < 2; ++p) { mx_u32x4 w = {0u, 0u, 0u, 0u};
        if ((tk >> 2) == g) { const unsigned one = (tk & 1) ? 0x3F800000u : 0x00003F80u; const int q = 2 * p + ((tk & 3) >> 1); w.x = (q == 0) ? one : 0u; w.y = (q == 1) ? one : 0u; w.z = (q == 2) ? one : 0u; w.w = (q == 3) ? one : 0u; }
        Sel[p] = __builtin_bit_cast(mx_bf16x8, w); }
#pragma unroll
    for (int ks = 0; ks < 2; ++ks) {
        mx_f32x4 w0 = mx_mfma(mx_frag4(mx_mfma(AtF[ks], Sel[0], z4)), fT, z4);
        mx_f32x4 w1 = mx_mfma(mx_frag4(mx_mfma(AtF[ks], Sel[1], z4)), fT, z4);
        *(MX_L mx_bf16x8*)(slot + (unsigned)(MX_HB_WA + ks * 1024 + lane * 16)) = mx_frag8v(w0, w1);
    }
#pragma unroll
    for (int ct = 0; ct < 4; ++ct) {
        const mx_f32x4 vc = mx_mfma(VF[ct >> 1], Sel[ct & 1], z4);
        const mx_u32x2 vp = mx_pack4(vc);
        *(MX_L mx_u32x2*)(slot + (unsigned)(MX_HB_VC + ct * 512 + lane * 8)) = vp;
        const mx_f32x4 X = mx_mfma(fLak, mx_frag4p(vp), z4);
        const mx_f32x4 U0 = mx_mfma(fT, mx_frag4(X), z4);
        *(MX_L mx_u32x2*)(slot + (unsigned)(MX_HB_U0 + ct * 512 + lane * 8)) = mx_pack4(U0);
        *(MX_L mx_u32x2*)(slot + (unsigned)(MX_HB_BH + ct * 512 + lane * 8)) = mx_pack4(mx_mfma(BhF[ct >> 1], Sel[ct & 1], z4));
        *(MX_L mx_u32x2*)(slot + (unsigned)(MX_HB_KH + ct * 512 + lane * 8)) = mx_pack4(mx_mfma(KhF[ct >> 1], Sel[ct & 1], z4));
    }
}
MX_DEV void mx_load_t16(const MX_G unsigned short* p, bool ok, int g, float (&x)[16]) {
#pragma unroll
    for (int ct = 0; ct < 4; ++ct) { mx_u32x2 w = {0u, 0u}; if (ok) w = *(const MX_G mx_u32x2*)(p + 16 * ct + 4 * g);
        x[4 * ct] = mx_lo(w.x); x[4 * ct + 1] = mx_hi(w.x); x[4 * ct + 2] = mx_lo(w.y); x[4 * ct + 3] = mx_hi(w.y); }
}
MX_DEV void mx_load_par(const MX_G float* p, int g, float (&x)[16]) {
#pragma unroll
    for (int ct = 0; ct < 4; ++ct) { const mx_f32x4 w = *(const MX_G mx_f32x4*)(p + 16 * ct + 4 * g); x[4 * ct] = w.x; x[4 * ct + 1] = w.y; x[4 * ct + 2] = w.z; x[4 * ct + 3] = w.w; }
}
MX_DEV void mx_store_t16(MX_G unsigned char* p, int lane, const float (&x)[16]) {
#pragma unroll
    for (int ct = 0; ct < 4; ++ct) { mx_u32x2 w; w.x = mx_pk2(x[4 * ct], x[4 * ct + 1]); w.y = mx_pk2(x[4 * ct + 2], x[4 * ct + 3]); *(MX_G mx_u32x2*)(p + ct * 512 + lane * 8) = w; }
}

MX_DEV void mx_load_parL(const MX_L float* p, int g, float (&x)[16]) {
#pragma unroll
    for (int ct = 0; ct < 4; ++ct) { const mx_f32x4 w = *(const MX_L mx_f32x4*)(p + 16 * ct + 4 * g); x[4 * ct] = w.x; x[4 * ct + 1] = w.y; x[4 * ct + 2] = w.z; x[4 * ct + 3] = w.w; }
}
struct MxRaw16 { mx_u32x2 w[4]; };
MX_DEV MxRaw16 mx_raw_t16(const MX_G unsigned short* p, bool ok, int g) { MxRaw16 r;
#pragma unroll
    for (int ct = 0; ct < 4; ++ct) { mx_u32x2 w = {0u, 0u}; if (ok) w = *(const MX_G mx_u32x2*)(p + 16 * ct + 4 * g); r.w[ct] = w; }
    return r; }
MX_DEV void mx_unpack16(const MxRaw16& r, float (&x)[16]) {
#pragma unroll
    for (int ct = 0; ct < 4; ++ct) { x[4 * ct] = mx_lo(r.w[ct].x); x[4 * ct + 1] = mx_hi(r.w[ct].x); x[4 * ct + 2] = mx_lo(r.w[ct].y); x[4 * ct + 3] = mx_hi(r.w[ct].y); }
}
MX_DEV unsigned mx_shr_u(unsigned v, int d) { return d == 1 ? MX_ROW_SHRU(v, 1) : (d == 2 ? MX_ROW_SHRU(v, 2) : MX_ROW_SHRU(v, 3)); }
MX_DEV unsigned mx_ror_u(unsigned v, int d) { return d == 1 ? MX_ROW_RORU(v, 1) : (d == 2 ? MX_ROW_RORU(v, 2) : MX_ROW_RORU(v, 3)); }
MX_DEV MxRaw16 mx_raw_tail(const MX_G unsigned short* p  , int t0, int tk, int g) { MxRaw16 r;
#pragma unroll
    for (int ct = 0; ct < 4; ++ct) { mx_u32x2 w = {0u, 0u}; if (tk >= 13 && t0 - 16 + tk >= 0) w = *(const MX_G mx_u32x2*)(p + 16 * ct + 4 * g); r.w[ct] = w; }
    return r; }
MX_DEV MxRaw16 mx_raw_prev(const MxRaw16& cur, const MxRaw16& tail, int tk, int d) {
    MxRaw16 r;
#pragma unroll
    for (int ct = 0; ct < 4; ++ct) {
        const unsigned sx = mx_shr_u(cur.w[ct].x, d), sy = mx_shr_u(cur.w[ct].y, d), tx = mx_ror_u(tail.w[ct].x, d), ty = mx_ror_u(tail.w[ct].y, d);
        r.w[ct].x = (tk >= d) ? sx : tx; r.w[ct].y = (tk >= d) ? sy : ty; }
    return r;
}
MX_DEV void mx_prep_rwkv(int l, int h, const MX_G unsigned short* zseq  , int chunk, MX_L unsigned char* slot, MX_G unsigned char* gslot, MX_L unsigned char* gamp, bool midbar, const MX_L unsigned char* lds, int lane) {
    const int tk = lane & 15, g = lane >> 4, t = 16 * chunk + tk;
    const MX_G unsigned short* zrow = zseq + (size_t)t * ZP; const MX_G unsigned short* zprev = zrow - ZP; const bool hp = t > 0;
    const MX_L float* par = (const MX_L float*)(lds + MX_LDS_PAR);
    const mx_f32x4 z4 = mx_zero4();
    mx_u32x4 cwv[8], pwv[8];
#pragma unroll
    for (int ks = 0; ks < 8; ++ks) { const int col = ZC_RW_DW + 32 * ks + 8 * g; cwv[ks] = *(const MX_G mx_u32x4*)(zrow + col); mx_u32x4 pw = {0u, 0u, 0u, 0u}; if (tk == 15 && chunk > 0) pw = *(const MX_G mx_u32x4*)(zrow - (size_t)16 * ZP + col); pwv[ks] = pw; }
    const MxRaw16 kc = mx_raw_t16(zrow + ZC_RW_K + 64 * h, true, g), rc = mx_raw_t16(zrow + ZC_RW_R + 64 * h, true, g), vc_ = mx_raw_t16(zrow + ZC_RW_V + 64 * h, true, g);
    const MX_G unsigned short* ztail = zrow - (size_t)16 * ZP;
    const MxRaw16 kt_ = mx_raw_tail(ztail + ZC_RW_K + 64 * h, 16 * chunk, tk, g), rt_ = mx_raw_tail(ztail + ZC_RW_R + 64 * h, 16 * chunk, tk, g), vt_ = mx_raw_tail(ztail + ZC_RW_V + 64 * h, 16 * chunk, tk, g);
    MX_SCHED();
    mx_f32x4 accw[4], acca[4], accg[4];
#pragma unroll
    for (int ct = 0; ct < 4; ++ct) { accw[ct] = z4; acca[ct] = z4; accg[ct] = z4; }
#pragma unroll
    for (int ks = 0; ks < 8; ++ks) {
        const mx_u32x4 cw = cwv[ks]; mx_u32x4 pw = pwv[ks];
        { const unsigned sx = MX_ROW_SHRU(cw.x, 1), sy = MX_ROW_SHRU(cw.y, 1), sz = MX_ROW_SHRU(cw.z, 1), sw = MX_ROW_SHRU(cw.w, 1), tx = MX_ROW_RORU(pw.x, 1), ty = MX_ROW_RORU(pw.y, 1), tz = MX_ROW_RORU(pw.z, 1), tw = MX_ROW_RORU(pw.w, 1);
          pw.x = tk ? sx : tx; pw.y = tk ? sy : ty; pw.z = tk ? sz : tz; pw.w = tk ? sw : tw; }
        const mx_f32x4 m0 = *(const MX_L mx_f32x4*)(par + 32 * ks + 8 * g), m1 = *(const MX_L mx_f32x4*)(par + 32 * ks + 8 * g + 4);
        float x[8];
        x[0] = mx_lo(cw.x) + (mx_lo(pw.x) - mx_lo(cw.x)) * m0.x; x[1] = mx_hi(cw.x) + (mx_hi(pw.x) - mx_hi(cw.x)) * m0.y; x[2] = mx_lo(cw.y) + (mx_lo(pw.y) - mx_lo(cw.y)) * m0.z; x[3] = mx_hi(cw.y) + (mx_hi(pw.y) - mx_hi(cw.y)) * m0.w;
        x[4] = mx_lo(cw.z) + (mx_lo(pw.z) - mx_lo(cw.z)) * m1.x; x[5] = mx_hi(cw.z) + (mx_hi(pw.z) - mx_hi(cw.z)) * m1.y; x[6] = mx_lo(cw.w) + (mx_lo(pw.w) - mx_lo(cw.w)) * m1.z; x[7] = mx_hi(cw.w) + (mx_hi(pw.w) - mx_hi(cw.w)) * m1.w;
#pragma unroll
        for (int e = 0; e < 8; ++e) { if (ks < 2) x[e] = 2.f * MX_RCP(1.f + MX_EXP(-2.f * x[e])) - 1.f; else if (ks >= 4) x[e] = mx_sigmoid(x[e]); }
        const mx_bf16x8 bf = mx_frag8(x, x + 4);
#pragma unroll
        for (int ct = 0; ct < 4; ++ct) {
            if (ks < 2) accw[ct] = mx_mfma(*(const MX_L mx_bf16x8*)(lds + MX_LDS_WW + (16 * ct + tk) * MX_RS64 + (32 * ks + 8 * g) * 2), bf, accw[ct]);
            else if (ks < 4) acca[ct] = mx_mfma(*(const MX_L mx_bf16x8*)(lds + MX_LDS_WA + (16 * ct + tk) * MX_RS64 + (32 * (ks - 2) + 8 * g) * 2), bf, acca[ct]);
            else accg[ct] = mx_mfma(*(const MX_L mx_bf16x8*)(lds + MX_LDS_WG + (16 * ct + tk) * MX_RS128 + (32 * (ks - 4) + 8 * g) * 2), bf, accg[ct]);
        }
        MX_SCHED();
    }
    float lw[16], a[16], b[16], k2[16], r[16], v[16];
    {
        float zc[16], zp[16], pr[16];
        mx_load_parL(par + MX_P_A0, g, pr);
#pragma unroll
        for (int i = 0; i < 16; ++i) b[i] = mx_sigmoid(pr[i] + acca[i >> 2][i & 3]);
        mx_unpack16(kc, zc); mx_unpack16(mx_raw_prev(kc, kt_, tk, 1), zp); mx_load_parL(par + MX_P_MUK, g, pr);
#pragma unroll
        for (int i = 0; i < 16; ++i) k2[i] = zc[i] + (zp[i] - zc[i]) * pr[i];
        mx_load_parL(par + MX_P_KK, g, pr);
        float ss = 0.f;
#pragma unroll
        for (int i = 0; i < 16; ++i) { a[i] = k2[i] * pr[i]; ss += a[i] * a[i]; }
        ss = mx_rowsum4(ss);
        const float rn = MX_RSQ(ss + 1e-6f);
        mx_load_parL(par + MX_P_KA, g, pr);
#pragma unroll
        for (int i = 0; i < 16; ++i) { const float kk = a[i] * rn, ic = b[i]; b[i] = kk * ic; a[i] = -kk; k2[i] = k2[i] * (1.f + (ic - 1.f) * pr[i]); }
    }
    MX_SCHED();
    float bs = 0.f;
    {
        float zc[16], zp[16], pr[16];
        mx_unpack16(rc, zc); mx_unpack16(mx_raw_prev(rc, rt_, tk, 1), zp); mx_load_parL(par + MX_P_MUR, g, pr);
#pragma unroll
        for (int i = 0; i < 16; ++i) r[i] = zc[i] + (zp[i] - zc[i]) * pr[i];
        mx_load_parL(par + MX_P_RK, g, pr);
#pragma unroll
        for (int i = 0; i < 16; ++i) bs += r[i] * k2[i] * pr[i];
        bs = mx_rowsum4(bs);
    }
    MX_SCHED();
    {
        float zc[16], zp[16], pr[16];
        mx_unpack16(vc_, zc); mx_unpack16(mx_raw_prev(vc_, vt_, tk, 1), zp); mx_load_parL(par + MX_P_MUV, g, pr);
#pragma unroll
        for (int i = 0; i < 16; ++i) v[i] = zc[i] + (zp[i] - zc[i]) * pr[i];
        mx_load_parL(par + MX_P_LNW, g, pr);
#pragma unroll
        for (int i = 0; i < 16; ++i) zc[i] = accg[i >> 2][i & 3] * pr[i];
        mx_store_t16(gslot + MX_GB_GT, lane, zc);
        mx_load_parL(par + MX_P_LNB, g, pr);
#pragma unroll
        for (int i = 0; i < 16; ++i) zp[i] = (pr[i] + bs * v[i]) * accg[i >> 2][i & 3];
        mx_store_t16(gslot + MX_GB_EE, lane, zp);
    }
    MX_SCHED();
    {
        float pr[16];
        mx_load_parL(par + MX_P_W0, g, pr);
#pragma unroll
        for (int i = 0; i < 16; ++i) { const float u = pr[i] + accw[i >> 2][i & 3]; lw[i] = -0.60653065971263342f * mx_sigmoid(u); }
    }
    MX_SCHED();
    mx_prep_back(lw, a, b, k2, r, v, slot, gamp, midbar, lane);
}
MX_DEV void mx_prep_gdn(int l, int h, const MX_G unsigned short* zseq, int chunk, MX_L unsigned char* slot, MX_G unsigned char* gslot, MX_L unsigned char* gamp, bool midbar, const MX_L unsigned char* lds, int lane) {
    const int tk = lane & 15, g = lane >> 4, t = 16 * chunk + tk;
    const MX_G unsigned short* zrow = zseq + (size_t)t * ZP;
    const MX_L float* par = (const MX_L float*)(lds + MX_LDS_PAR);
    const MxRaw16 cq = mx_raw_t16(zrow + ZC_GD_Q + 64 * h, true, g), ck = mx_raw_t16(zrow + ZC_GD_K + 64 * h, true, g), cv = mx_raw_t16(zrow + ZC_GD_V + 64 * h, true, g);
    const MX_G unsigned short* ztail = zrow - (size_t)16 * ZP;
    const MxRaw16 tq = mx_raw_tail(ztail + ZC_GD_Q + 64 * h, 16 * chunk, tk, g), tk_ = mx_raw_tail(ztail + ZC_GD_K + 64 * h, 16 * chunk, tk, g), tv = mx_raw_tail(ztail + ZC_GD_V + 64 * h, 16 * chunk, tk, g);
    const MxRaw16 rg = mx_raw_t16(zrow + ZC_GD_G + 64 * h, true, g);
    const float bl = mx_lo((unsigned)zrow[ZC_GD_B + h]), al = mx_lo((unsigned)zrow[ZC_GD_A + h]);
    MX_SCHED();
    float q[16], k[16], v[16];
#pragma unroll
    for (int i = 0; i < 16; ++i) { q[i] = 0.f; k[i] = 0.f; v[i] = 0.f; }
#pragma unroll
    for (int d = 0; d < 4; ++d) {
        float x[16], w[16];
        if (d == 3) mx_unpack16(cq, x); else mx_unpack16(mx_raw_prev(cq, tq, tk, 3 - d), x);
        mx_load_parL(par + d * 192, g, w);
#pragma unroll
        for (int i = 0; i < 16; ++i) MX_FMAC(q[i], w[i], x[i]);
        if (d == 3) mx_unpack16(ck, x); else mx_unpack16(mx_raw_prev(ck, tk_, tk, 3 - d), x);
        mx_load_parL(par + d * 192 + 64, g, w);
#pragma unroll
        for (int i = 0; i < 16; ++i) MX_FMAC(k[i], w[i], x[i]);
        if (d == 3) mx_unpack16(cv, x); else mx_unpack16(mx_raw_prev(cv, tv, tk, 3 - d), x);
        mx_load_parL(par + d * 192 + 128, g, w);
#pragma unroll
        for (int i = 0; i < 16; ++i) MX_FMAC(v[i], w[i], x[i]);
        MX_SCHED();
    }
    float sq = 0.f, sk = 0.f;
#pragma unroll
    for (int i = 0; i < 16; ++i) { q[i] = q[i] * mx_sigmoid(q[i]); k[i] = k[i] * mx_sigmoid(k[i]); v[i] = v[i] * mx_sigmoid(v[i]); sq += q[i] * q[i]; sk += k[i] * k[i]; }
    sq = mx_rowsum4(sq); sk = mx_rowsum4(sk);
    const float rqn = 0.125f * MX_RSQ(sq + 1e-6f), rkn = MX_RSQ(sk + 1e-6f);
    const float beta = mx_sigmoid(bl);
    const float gl = -MX_EXP(MXIN(I_ALOG)[l * 4 + h]) * mx_softplus(al + MXIN(I_DTB)[l * 4 + h]);
    const float wb = -MX_EXP(gl) * beta;
    float lw[16], a[16], b[16];
#pragma unroll
    for (int i = 0; i < 16; ++i) { const float kn = k[i] * rkn; lw[i] = gl; a[i] = kn; b[i] = wb * kn; k[i] = kn; q[i] = q[i] * rqn; v[i] = beta * v[i]; }
    {
        float zg[16], pr[16], ee[16];
        mx_unpack16(rg, zg); mx_load_parL(par + MX_P_GNW, g, pr);
#pragma unroll
        for (int i = 0; i < 16; ++i) { zg[i] = pr[i] * (zg[i] * mx_sigmoid(zg[i])); ee[i] = 0.f; }
        mx_store_t16(gslot + MX_GB_GT, lane, zg); mx_store_t16(gslot + MX_GB_EE, lane, ee);
    }
    MX_SCHED();
    mx_prep_back(lw, a, b, k, q, v, slot, gamp, midbar, lane);
}
struct MxOps { mx_bf16x8 wa0, wa1, rt0, rt1; mx_u32x2 arb, ark, vc; mx_f32x4 u0; mx_f32x4 gm0, gm1, gm2, gm3; mx_u32x2 bh0, bh1, bh2, bh3, kh0, kh1, kh2, kh3; };
MX_DEV MxOps mx_scan_load(const MX_L unsigned char* slot, const MX_L unsigned char* gamp, int it, int lane) {
    const int g = lane >> 4;
    MxOps o;
    o.wa0 = *(const MX_L mx_bf16x8*)(slot + (unsigned)(MX_HB_WA + lane * 16)); o.wa1 = *(const MX_L mx_bf16x8*)(slot + (unsigned)(MX_HB_WA + 1024 + lane * 16));
    o.rt0 = *(const MX_L mx_bf16x8*)(slot + (unsigned)(MX_HB_RT + lane * 16)); o.rt1 = *(const MX_L mx_bf16x8*)(slot + (unsigned)(MX_HB_RT + 1024 + lane * 16));
    o.arb = *(const MX_L mx_u32x2*)(slot + (unsigned)(MX_HB_ARB + lane * 8)); o.ark = *(const MX_L mx_u32x2*)(slot + (unsigned)(MX_HB_ARK + lane * 8));
    o.vc = *(const MX_L mx_u32x2*)(slot + (unsigned)(MX_HB_VC + it * 512 + lane * 8));
    { const mx_u32x2 u = *(const MX_L mx_u32x2*)(slot + (unsigned)(MX_HB_U0 + it * 512 + lane * 8)); o.u0.x = mx_lo(u.x); o.u0.y = mx_hi(u.x); o.u0.z = mx_lo(u.y); o.u0.w = mx_hi(u.y); }
#define MX_LDJ(jt) do { o.gm##jt = *(const MX_L mx_f32x4*)(gamp + (unsigned)((16 * jt + 4 * g) * 4)); \
        o.bh##jt = *(const MX_L mx_u32x2*)(slot + (unsigned)(MX_HB_BH + jt * 512 + lane * 8)); o.kh##jt = *(const MX_L mx_u32x2*)(slot + (unsigned)(MX_HB_KH + jt * 512 + lane * 8)); } while (0)
    MX_LDJ(0); MX_LDJ(1); MX_LDJ(2); MX_LDJ(3);
#undef MX_LDJ
    return o;
}
MX_DEV mx_f32x4 mx_scan_compute(mx_f32x4 (&S)[4], const MxOps& o, int lane) {
    const int tk = lane & 15, g = lane >> 4;
    const mx_f32x4 z4 = mx_zero4();
    const mx_bf16x8 sb0 = mx_frag8v(S[0], S[1]), sb1 = mx_frag8v(S[2], S[3]);
    const mx_f32x4 U = mx_mfma(o.wa1, sb1, mx_mfma(o.wa0, sb0, o.u0));
    const mx_u32x2 ub = mx_frag4(U), vb = mx_frag4p(o.vc);
    mx_f32x4 Y = mx_mfma(o.rt1, sb1, mx_mfma(o.rt0, sb0, z4));
    Y = mx_mfma(mx_frag4p(o.ark), vb, mx_mfma(mx_frag4p(o.arb), ub, Y));
    S[0] = mx_mfma(mx_frag4p(o.kh0), vb, mx_mfma(mx_frag4p(o.bh0), ub, S[0] * o.gm0)); S[1] = mx_mfma(mx_frag4p(o.kh1), vb, mx_mfma(mx_frag4p(o.bh1), ub, S[1] * o.gm1));
    S[2] = mx_mfma(mx_frag4p(o.kh2), vb, mx_mfma(mx_frag4p(o.bh2), ub, S[2] * o.gm2)); S[3] = mx_mfma(mx_frag4p(o.kh3), vb, mx_mfma(mx_frag4p(o.bh3), ub, S[3] * o.gm3));
    mx_u32x2 selI = {0u, 0u};
    if ((tk >> 2) == g) { const unsigned one = (tk & 1) ? 0x3F800000u : 0x00003F80u; if ((tk & 3) >> 1) selI.y = one; else selI.x = one; }
    mx_f32x4 Yh, Yl;
#pragma unroll
    for (int e = 0; e < 4; ++e) { Yh[e] = __builtin_bit_cast(float, mx_bf(Y[e]) << 16); Yl[e] = Y[e] - Yh[e]; }
    return mx_mfma(mx_frag4(Yl), selI, mx_mfma(mx_frag4(Yh), selI, z4));
}
MX_DEV void mx_sequence(int l, int type, int h, const MX_G unsigned short* zseq, MX_G unsigned short* yseq  , int nchunks, MX_G unsigned char* gb  , MX_L unsigned char* lds, int wave,
                        int role, MX_G unsigned long long* xs, MX_G unsigned* flag, MX_G unsigned* tmo) {
    const int lane0 = mx_lane();
    {
        const int tid = wave * 64 + lane0;
        MX_L float* par = (MX_L float*)(lds + MX_LDS_PAR);
        if (type == 0) {
            const MX_G float* wup = MXIN(I_WUP) + l * 64 * 256 + 64 * h; const MX_G float* aup = MXIN(I_AUP) + l * 64 * 256 + 64 * h; const MX_G float* gup = MXIN(I_GUP) + l * 128 * 256 + 64 * h;
            for (int idx = tid; idx < 64 * 64; idx += 512) { const int ch = idx & 63, k = idx >> 6;
                *(MX_L unsigned short*)(lds + MX_LDS_WW + ch * MX_RS64 + k * 2) = (unsigned short)mx_bf(wup[k * 256 + ch]);
                *(MX_L unsigned short*)(lds + MX_LDS_WA + ch * MX_RS64 + k * 2) = (unsigned short)mx_bf(aup[k * 256 + ch]); }
            for (int idx = tid; idx < 64 * 128; idx += 512) { const int ch = idx & 63, k = idx >> 6;
                *(MX_L unsigned short*)(lds + MX_LDS_WG + ch * MX_RS128 + k * 2) = (unsigned short)mx_bf(gup[k * 256 + ch]); }
            const MX_G float* mu = MXIN(I_MU) + l * 1024;
            if (tid < 256) par[tid] = mu[ZC_RW_DW + tid];
            else if (tid < 448) { const int a = (tid - 256) >> 6, c = (tid - 256) & 63; par[tid] = mu[(a == 0 ? ZC_RW_R : (a == 1 ? ZC_RW_K : ZC_RW_V)) + 64 * h + c]; }
            if (tid < 448) { const int a = tid >> 6, c = tid & 63;
                const MX_G float* src = a == 0 ? MXIN(I_W0) : a == 1 ? MXIN(I_A0) : a == 2 ? MXIN(I_KK) : a == 3 ? MXIN(I_KA) : a == 4 ? MXIN(I_RK) : a == 5 ? MXIN(I_LNXW) : MXIN(I_LNXB);
                par[MX_P_W0 + tid] = src[l * 256 + 64 * h + c]; }
        } else {
            const MX_G float* cw = MXIN(I_CONV) + l * 4 * 768;
            for (int idx = tid; idx < 768; idx += 512) { const int d = idx / 192, a = (idx % 192) >> 6, c = idx & 63; par[idx] = cw[d * 768 + a * 256 + 64 * h + c]; }
            if (tid < 64) par[MX_P_GNW + tid] = MXIN(I_GNW)[l * 64 + tid];
        }
    }
    mx_wgsync();
    mx_f32x4 S[4];
#pragma unroll
    for (int jt = 0; jt < 4; ++jt) S[jt] = mx_zero4();
    MX_L float* st = (MX_L float*)(lds + MX_LDS_ST);
    typedef float mx_f32x2 __attribute__((ext_vector_type(2)));
    const int ngroups = nchunks / 8;
    for (int itr = role - 2; itr < ngroups; itr += 2) {
        int lane = lane0; MX_LAUNDER_V(lane);
        const int tk = lane & 15, g = lane >> 4;
        const bool scan_now = itr >= 0, more = itr + 2 < ngroups;
        const int par_c = (itr >> 1) & 1, par_n = ((itr + 2) >> 1) & 1;
        if (wave < 4 && scan_now) {
            MX_G unsigned char* gbp = gb + par_c * (8 * MX_GB_SLOT); MX_LAUNDER_S(gbp);
            const MX_L unsigned char* gamc = lds + MX_LDS_GAM + par_c * 2048;
            mx_f32x4 yk[8]; mx_u32x2 gtc[8], eec[8];
            if (itr > 0) {
                const unsigned want = 4u * (unsigned)itr;
                for (unsigned spins = 0;;) {
                    if ((unsigned)MX_UNIFORM(MX_FLAG_LOAD(flag)) >= want) break;
                    MX_SLEEP();
                    if (++spins > (1u << 20)) { if (lane == 0) MX_FLAG_STORE(tmo, 1u); break; }
                }
#pragma unroll
                for (int jt = 0; jt < 4; ++jt) { const MX_G unsigned long long* p = xs + (unsigned)(((wave * 4 + jt) * 64 + lane) * 2);
                    const unsigned long long a = MX_SC1_LOAD64(p), b = MX_SC1_LOAD64(p + 1);
                    mx_u32x4 w; w.x = (unsigned)a; w.y = (unsigned)(a >> 32); w.z = (unsigned)b; w.w = (unsigned)(b >> 32); S[jt] = __builtin_bit_cast(mx_f32x4, w); }
            }
#pragma unroll
            for (int c = 0; c < 8; ++c) {
                const MxOps o = mx_scan_load(lds + MX_LDS_HB + c * MX_HB_SLOT, gamc + c * 256, wave, lane);
                yk[c] = mx_scan_compute(S, o, lane);
                MX_SCHED();
            }
            if (itr + 1 < ngroups) {
#pragma unroll
                for (int jt = 0; jt < 4; ++jt) { MX_G unsigned long long* p = xs + (unsigned)(((wave * 4 + jt) * 64 + lane) * 2);
                    const mx_u32x4 w = __builtin_bit_cast(mx_u32x4, S[jt]);
                    MX_SC1_STORE64(p, (unsigned long long)w.x | ((unsigned long long)w.y << 32)); MX_SC1_STORE64(p + 1, (unsigned long long)w.z | ((unsigned long long)w.w << 32)); }
                MX_VMWAIT();
                if (lane == 0) MX_FLAG_ADD(flag, 1u);
            }
            unsigned pfw = 0u;
            if (more) {
                const MX_G unsigned short* zr = zseq + (size_t)(16 * (8 * (itr + 2) + 4 + wave) + tk) * ZP;
                if (type == 0) { pfw = *(const MX_G unsigned*)(zr + ZC_RW_DW + 64 * g); if (g < 3) pfw ^= *(const MX_G unsigned*)(zr + (g == 0 ? ZC_RW_R : (g == 1 ? ZC_RW_K : ZC_RW_V)) + 64 * h); }
                else { pfw = *(const MX_G unsigned*)(zr + (g == 0 ? ZC_GD_Q : (g == 1 ? ZC_GD_K : (g == 2 ? ZC_GD_V : ZC_GD_G))) + 64 * h); if (g == 0) pfw ^= *(const MX_G unsigned*)(zr + ZC_GD_B); }
            }
#pragma unroll
            for (int c = 0; c < 8; ++c) { const MX_G unsigned char* sl = gbp + c * MX_GB_SLOT;
                gtc[c] = *(const MX_G mx_u32x2*)(sl + (unsigned)(MX_GB_GT + wave * 512 + lane * 8)); eec[c] = *(const MX_G mx_u32x2*)(sl + (unsigned)(MX_GB_EE + wave * 512 + lane * 8)); }
#pragma unroll
            for (int c = 0; c < 8; ++c) {
                float s1 = (yk[c].x + yk[c].y) + (yk[c].z + yk[c].w), s2 = (yk[c].x * yk[c].x + yk[c].y * yk[c].y) + (yk[c].z * yk[c].z + yk[c].w * yk[c].w);
                s1 = mx_rowsum4(s1); s2 = mx_rowsum4(s2);
                if (g == 0) { mx_f32x2 p_; p_.x = s1; p_.y = s2; *(MX_L mx_f32x2*)(st + ((c * 4 + wave) * 16 + tk) * 2) = p_; }
            }
            MX_LDSWAIT(); mx_wgsync();
#pragma unroll
            for (int c = 0; c < 8; ++c) {
                float s1 = 0.f, s2 = 0.f;
#pragma unroll
                for (int w = 0; w < 4; ++w) { const mx_f32x2 p_ = *(const MX_L mx_f32x2*)(st + ((c * 4 + w) * 16 + tk) * 2); s1 += p_.x; s2 += p_.y; }
                float mean, rstd;
                if (type == 0) { mean = s1 * (1.f / 64.f); const float var = fmaxf(s2 * (1.f / 64.f) - mean * mean, 0.f); rstd = MX_RSQ(var + 64e-5f); }
                else { mean = 0.f; rstd = MX_RSQ(s2 * (1.f / 64.f) + 1e-6f); }
                const float o0 = (yk[c].x - mean) * rstd * mx_lo(gtc[c].x) + mx_lo(eec[c].x), o1 = (yk[c].y - mean) * rstd * mx_hi(gtc[c].x) + mx_hi(eec[c].x);
                const float o2 = (yk[c].z - mean) * rstd * mx_lo(gtc[c].y) + mx_lo(eec[c].y), o3 = (yk[c].w - mean) * rstd * mx_hi(gtc[c].y) + mx_hi(eec[c].y);
                mx_u32x2 o; o.x = mx_pk2(o0, o1); o.y = mx_pk2(o2, o3);
                *(MX_G mx_u32x2*)(yseq + (size_t)(16 * (8 * itr + c) + tk) * DM + 16 * wave + 4 * g) = o;
            }
            MX_CONSUME(pfw);
        } else if (wave < 4) { mx_wgsync(); }
        MX_SCHED();
        if (more) {
            const int c = (wave < 4) ? wave + 4 : wave - 4;
            MX_G unsigned char* gbn = gb + par_n * (8 * MX_GB_SLOT) + c * MX_GB_SLOT; MX_LAUNDER_S(gbn);
            MX_L unsigned char* slot = lds + MX_LDS_HB + c * MX_HB_SLOT; MX_L unsigned char* gamn = lds + MX_LDS_GAM + par_n * 2048 + c * 256;
            if (type == 0) mx_prep_rwkv(l, h, zseq, 8 * (itr + 2) + c, slot, gbn, gamn, wave >= 4, lds, lane); else mx_prep_gdn(l, h, zseq, 8 * (itr + 2) + c, slot, gbn, gamn, wave >= 4, lds, lane);
        } else if (wave >= 4) { mx_wgsync(); }
        MX_VMWAIT(); MX_LDSWAIT(); mx_wgsync();
    }
}

MX_DEV void mx_attn_unit4(int kvh, int q0, const MX_G unsigned short* zseq  , MX_G unsigned short* yatt  ,
                          const MX_L float* btab_all  , float Mb, const float (&esink)[4]  , const float (&qkw)[16], MX_L unsigned char* vts  , int lane) {
    const int tk = lane & 15, g = lane >> 4;
    const mx_f32x4 z4 = mx_zero4();
    const MX_G unsigned short* qrow = zseq + (size_t)(q0 + tk) * ZP + ZC_AT_Q + 256 * kvh;
    mx_u32x4 qa = *(const MX_G mx_u32x4*)(qrow + 8 * g), qb = *(const MX_G mx_u32x4*)(qrow + 32 + 8 * g);
    mx_u32x4 kA[9], kB[9], vA[9], vB[9];
#pragma unroll
    for (int kt = 0; kt < 9; ++kt) {
        const int key0 = q0 - 128 + 16 * kt;
        if (key0 >= 0) {
            const MX_G unsigned short* krow = zseq + (size_t)(key0 + tk) * ZP + ZC_AT_K + 64 * kvh; const MX_G unsigned short* vrow = zseq + (size_t)(key0 + tk) * ZP + ZC_AT_V + 64 * kvh;
            kA[kt] = *(const MX_G mx_u32x4*)(krow + 8 * g); kB[kt] = *(const MX_G mx_u32x4*)(krow + 32 + 8 * g);
            const mx_u32x2 a_ = *(const MX_G mx_u32x2*)(vrow + 4 * g), b_ = *(const MX_G mx_u32x2*)(vrow + 16 + 4 * g), c_ = *(const MX_G mx_u32x2*)(vrow + 32 + 4 * g), d_ = *(const MX_G mx_u32x2*)(vrow + 48 + 4 * g);
            vA[kt].x = a_.x; vA[kt].y = a_.y; vA[kt].z = b_.x; vA[kt].w = b_.y; vB[kt].x = c_.x; vB[kt].y = c_.y; vB[kt].z = d_.x; vB[kt].w = d_.y;
        } else { const mx_u32x4 z_ = {0u, 0u, 0u, 0u}; kA[kt] = z_; kB[kt] = z_; vA[kt] = z_; vB[kt] = z_; }
    }
    MX_SCHED();
    mx_bf16x8 Sel[2];
#pragma unroll
    for (int p = 0; p < 2; ++p) { mx_u32x4 w = {0u, 0u, 0u, 0u};
        if ((tk >> 2) == g) { const unsigned one = (tk & 1) ? 0x3F800000u : 0x00003F80u; const int q = 2 * p + ((tk & 3) >> 1); w.x = (q == 0) ? one : 0u; w.y = (q == 1) ? one : 0u; w.z = (q == 2) ? one : 0u; w.w = (q == 3) ? one : 0u; }
        Sel[p] = __builtin_bit_cast(mx_bf16x8, w); }
    float rk[9];
#pragma unroll
    for (int kt = 0; kt < 9; ++kt) {
        float ssk = 0.f;
        { const unsigned kk[8] = {kA[kt].x, kA[kt].y, kA[kt].z, kA[kt].w, kB[kt].x, kB[kt].y, kB[kt].z, kB[kt].w};
#pragma unroll
          for (int i = 0; i < 8; ++i) { const float a = mx_lo(kk[i]), b = mx_hi(kk[i]); ssk += a * a + b * b; } }
        rk[kt] = MX_RSQ(mx_rowsum4(ssk) * (1.f / 64.f) + 1e-6f);
#pragma unroll
        for (int dt = 0; dt < 4; ++dt) *(MX_L mx_u32x2*)(vts + (unsigned)(((kt * 4 + dt) * 64 + lane) * 8)) = mx_pack4(mx_mfma(__builtin_bit_cast(mx_bf16x8, (dt >> 1) ? vB[kt] : vA[kt]), Sel[dt & 1], z4));
    }
    MX_LDSWAIT(); MX_SCHED();
    for (int hh = 0; hh < 4; ++hh) {
        const int h = 4 * kvh + hh;
        const mx_u32x4 cqa = qa, cqb = qb;
        if (hh < 3) { qa = *(const MX_G mx_u32x4*)(qrow + 64 * (hh + 1) + 8 * g); qb = *(const MX_G mx_u32x4*)(qrow + 64 * (hh + 1) + 32 + 8 * g); }
        const MX_L float* btab = btab_all + 128 * h;
        mx_bf16x8 QF[2];
        {
            float q[16]; float ss = 0.f;
            q[0] = mx_lo(cqa.x); q[1] = mx_hi(cqa.x); q[2] = mx_lo(cqa.y); q[3] = mx_hi(cqa.y); q[4] = mx_lo(cqa.z); q[5] = mx_hi(cqa.z); q[6] = mx_lo(cqa.w); q[7] = mx_hi(cqa.w);
            q[8] = mx_lo(cqb.x); q[9] = mx_hi(cqb.x); q[10] = mx_lo(cqb.y); q[11] = mx_hi(cqb.y); q[12] = mx_lo(cqb.z); q[13] = mx_hi(cqb.z); q[14] = mx_lo(cqb.w); q[15] = mx_hi(cqb.w);
#pragma unroll
            for (int i = 0; i < 16; ++i) ss += q[i] * q[i];
            ss = mx_rowsum4(ss);
            const float rs = MX_RSQ(ss * (1.f / 64.f) + 1e-6f);
#pragma unroll
            for (int i = 0; i < 16; ++i) q[i] = q[i] * rs * qkw[i];
            QF[0] = mx_frag8(q, q + 4); QF[1] = mx_frag8(q + 8, q + 12);
        }
        mx_f32x4 O[4];
#pragma unroll
        for (int dt = 0; dt < 4; ++dt) O[dt] = z4;
        float lsum = 0.f;
#pragma unroll
        for (int kt = 0; kt < 9; ++kt) {
            const int key0 = q0 - 128 + 16 * kt;
            const mx_f32x4 S = mx_mfma(__builtin_bit_cast(mx_bf16x8, kB[kt]), QF[1], mx_mfma(__builtin_bit_cast(mx_bf16x8, kA[kt]), QF[0], z4));
            mx_f32x4 P;
#pragma unroll
            for (int e = 0; e < 4; ++e) {
                const float rke = mx_shfl16l(rk[kt], 4 * g + e, lane);
                const int dist = (q0 + tk) - (key0 + 4 * g + e); const bool valid = (dist >= 0) && (dist < 128) && (key0 >= 0);
                float ex = MX_EXP(S[e] * rke + btab[dist & 127] - Mb); MX_LAUNDER_V(ex);
                P[e] = valid ? ex : 0.f; lsum += P[e];
            }
            const mx_u32x2 pf = mx_frag4(P);
#pragma unroll
            for (int dt = 0; dt < 4; ++dt) O[dt] = mx_mfma(mx_frag4p(*(const MX_L mx_u32x2*)(vts + (unsigned)(((kt * 4 + dt) * 64 + lane) * 8))), pf, O[dt]);
        }
        lsum = mx_rowsum4(lsum);
        const float inv = MX_RCP(lsum + esink[hh]);
        MX_G unsigned short* yrow = yatt + (size_t)(q0 + tk) * DM + 64 * h;
#pragma unroll
        for (int dt = 0; dt < 4; ++dt) { mx_u32x2 o; o.x = mx_pk2(O[dt].x * inv, O[dt].y * inv); o.y = mx_pk2(O[dt].z * inv, O[dt].w * inv); *(MX_G mx_u32x2*)(yrow + 16 * dt + 4 * g) = o; }
    }
}

__device__ __forceinline__ float wave_allmax(float v) {
    v = fmaxf(v, dppf(v, 0)); v = fmaxf(v, dppf(v, 1)); v = fmaxf(v, dppf(v, 2)); v = fmaxf(v, dppf(v, 3));
    const float a = __builtin_bit_cast(float, __builtin_amdgcn_readlane(__builtin_bit_cast(int, v), 0)), b = __builtin_bit_cast(float, __builtin_amdgcn_readlane(__builtin_bit_cast(int, v), 16));
    const float c = __builtin_bit_cast(float, __builtin_amdgcn_readlane(__builtin_bit_cast(int, v), 32)), d = __builtin_bit_cast(float, __builtin_amdgcn_readlane(__builtin_bit_cast(int, v), 48));
    return fmaxf(fmaxf(a, b), fmaxf(c, d));
}
__device__ __forceinline__ void mixer_phase(Frame& F, int l) {
    const int blk = blockIdx.x;
    {
        const int lane = ltid() & 63;
        const LAS float* btab_all = (const LAS float*)(F.lds + BIAS_OFF);
        float mb = 0.f;
#pragma unroll
        for (int i = 0; i < 16; ++i) mb = fmaxf(mb, fabsf(btab_all[lane + 64 * i]));
        const float Mb = 8.f * wave_allmax(fabsf(MXIN(I_QNW)[l * 64 + lane])) * wave_allmax(fabsf(MXIN(I_KNW)[l * 64 + lane])) + wave_allmax(mb);
        const int pair = blk >> 3, seg = blk & 7, b = pair >> 1, kvh = pair & 1;
        float esink[4];
#pragma unroll
        for (int hh = 0; hh < 4; ++hh) esink[hh] = __expf(MXIN(I_SINK)[l * 8 + 4 * kvh + hh] - Mb);
        float qkw[16];
#pragma unroll
        for (int i = 0; i < 16; ++i) { const int d = 32 * (i >> 3) + 8 * (lane >> 4) + (i & 7); qkw[i] = 0.125f * MXIN(I_QNW)[l * 64 + d] * MXIN(I_KNW)[l * 64 + d]; }
        const MX_G unsigned short* zseq = (const MX_G unsigned short*)FZ + (size_t)b * SEQ * ZP;
        MX_G unsigned short* yatt = (MX_G unsigned short*)FY + (size_t)b * SEQ * DM + 512;
        for (int i = 0; i < 2; ++i) {
            const int qt = 16 * seg + F.wave + 8 * i;
            int ln = lane; MX_LAUNDER_V(ln);
            mx_attn_unit4(kvh, 16 * qt, zseq, yatt, btab_all, Mb, esink, qkw, F.lds + RING_OFF + F.wave * 18432, ln);
        }
    }
    __syncthreads();
    {
        const int seq = blk & 127, role = blk >> 7, type = seq >> 6, bh = seq & 63, b = bh >> 2, h = bh & 3;
        const MX_G unsigned short* zseq = (const MX_G unsigned short*)FZ + (size_t)b * SEQ * ZP;
        MX_G unsigned short* yseq = (MX_G unsigned short*)FY + (size_t)b * SEQ * DM + type * 256 + 64 * h;
        MX_G unsigned* ctlw = (MX_G unsigned*)WSP(WS_CTL);
        mx_sequence(l, type, h, zseq, yseq, SEQ / 16, (MX_G unsigned char*)WSP(WS_HB) + (size_t)blk * (2 * 8 * MX_GB_SLOT), F.lds + RING_OFF, F.wave,
                    role, (MX_G unsigned long long*)WSP(WS_XS) + (size_t)seq * 2048, ctlw + CW_SEQ + (l * 128 + seq) * 64, ctlw + CW_TMO);
    }
}
constexpr int PH_PER_L = 5, NPH = 1 + DEPTH * PH_PER_L;
struct Args { const float* in[26]; float* out; unsigned char* ws; int ph_lo, ph_hi; };
__global__ void __launch_bounds__(NWAVES * 64, 2) fwd(Args args) {
    extern __shared__ __attribute__((aligned(16))) unsigned char lds[];
    Frame F;
    F.lds = (LAS unsigned char*)lds;
    const int tid0 = threadIdx.x; F.wave = __builtin_amdgcn_readfirstlane(tid0 >> 6);
    F.G = gridDim.x; { const int bx = blockIdx.x; F.vcu = (F.G % 8 == 0) ? (bx % 8) * (F.G / 8) + bx / 8 : bx; }
    F.ws = args.ws; F.out = args.out;
    for (int u = tid0; u < (BIAS_OFF - LDSCTL_OFF) / 4; u += NWAVES * 64) ((LAS unsigned*)(F.lds + LDSCTL_OFF))[u] = 0u;
    for (int u = tid0; u < 8 * 128; u += NWAVES * 64) {
        const int h = u >> 7, d = u & 127;
        int bucket;
        if (d < 16) bucket = d;
        else { int lg = 16 + (int)(logf((float)d / 16.f) / logf(8.f) * 16.f); bucket = lg < 31 ? lg : 31; }
        ((LAS float*)(F.lds + BIAS_OFF))[u] = INP(I_RELB)[bucket * 8 + h];
    }
    __syncthreads();
    const int lo = args.ph_lo, hi = args.ph_hi;
    const bool one = (hi - lo) > 1;
    XcdBarrier bar; bar.bar = (unsigned*)(F.ws + WS_CTL) + CW_BAR; bar.x = 0; bar.st = nullptr;
    if (one) bar = xcd_barrier_post((unsigned*)(F.ws + WS_CTL) + CW_BAR, (volatile LAS unsigned*)(F.lds + MISC_OFF) + 8, tid0 == 0);
#define IN(k) (lo <= (k) && (k) < hi)
#define SEAM(k) do { if (IN(k) && IN((k) + 1)) { XcdBarrier b2_ = bar; asm volatile("" : "+s"(b2_.bar)); xcd_barrier(b2_, F.wave == 0 && hw_lane() == 0); } } while (0)

    #ifndef DIS_PRO
    if (IN(0)) { p0_prologue(F); SEAM(0); }
#endif
    for (int l = 0; l < DEPTH; ++l) {
        const int pb = 1 + PH_PER_L * l;
        if (IN(pb + 0)) {
            pg8::Gemm g{FXN, ((bf16*)WSP(WS_WIN)) + (size_t)l * ZP * DM, M, ZP, DM}; pg8::StaticOrder S; S.init(M, ZP, F.G, (int)blockIdx.x);
            pg8::EpiBf16<0> E{FZ, ZP, (const float*)WSP(WS_RSS) + (size_t)(2 * l) * M * 16};
            pg8::gemm_phase<pg8::EpiBf16<0>, pg8::StaticOrder, true, true>(F.lds + RING_OFF, g, S, E, F.wave);
            SEAM(pb + 0);
        }
        if (IN(pb + 1)) { mixer_phase(F, l); SEAM(pb + 1); }
        if (IN(pb + 2)) {
            pg8::Gemm g{FY, ((bf16*)WSP(WS_WOUT)) + (size_t)l * DM * DM, M, DM, DM}; pg8::StaticOrder S; S.init(M, DM, F.G, (int)blockIdx.x);
            pg8::EpiResF32 E{l == 0 ? INP(I_X) : F.out, F.out, DM, FXN, (float*)WSP(WS_RSS) + (size_t)(2 * l + 1) * M * 16};
            pg8::gemm_phase<pg8::EpiResF32, pg8::StaticOrder, true, true>(F.lds + RING_OFF, g, S, E, F.wave);
            SEAM(pb + 2);
        }
        if (IN(pb + 3)) {
            pg8::Gemm g{FXN, ((bf16*)WSP(WS_W1)) + (size_t)l * DFF * DM, M, DFF, DM}; pg8::StaticOrder S; S.init(M, DFF, F.G, (int)blockIdx.x);
            pg8::EpiBf16<2> E{FH, DFF, (const float*)WSP(WS_RSS) + (size_t)(2 * l + 1) * M * 16};
            pg8::gemm_phase<pg8::EpiBf16<2>, pg8::StaticOrder, true, true>(F.lds + RING_OFF, g, S, E, F.wave);
            SEAM(pb + 3);
        }
        if (IN(pb + 4)) {
            pg8::Gemm g{FH, ((bf16*)WSP(WS_W2)) + (size_t)l * DM * DFF, M, DM, DFF}; pg8::StaticOrder S; S.init(M, DM, F.G, (int)blockIdx.x);
            pg8::EpiResF32 E{F.out, F.out, DM, l + 1 < DEPTH ? FXN : (bf16*)nullptr, l + 1 < DEPTH ? (float*)WSP(WS_RSS) + (size_t)(2 * l + 2) * M * 16 : (float*)nullptr};
            pg8::gemm_phase<pg8::EpiResF32, pg8::StaticOrder, true, true>(F.lds + RING_OFF, g, S, E, F.wave);
            SEAM(pb + 4);
        }
    }
#undef IN
#undef SEAM
}

#ifndef MK_ONE_LAUNCH
#define MK_ONE_LAUNCH 1
#endif
extern "C" void kernel_launch(void* const* d_in, const int* in_sizes, int n_in, void* d_out, int out_size, void* d_ws, size_t ws_size, hipStream_t stream) {
    static int grid = 0;
    if (grid == 0) {
        if (n_in != 26 || in_sizes[0] != M * DM || out_size != M * DM || ws_size < WS_END) { fprintf(stderr, "kernel_launch: unexpected shapes (n_in %d, in0 %d, out %d, ws %zu, need %zu)\n", n_in, n_in > 0 ? in_sizes[0] : -1, out_size, ws_size, (size_t)WS_END); grid = -1; return; }
        int dev = 0, cus = 0, per_cu = 0;
        if (hipGetDevice(&dev) != hipSuccess || hipDeviceGetAttribute(&cus, hipDeviceAttributeMultiprocessorCount, dev) != hipSuccess) { grid = -1; return; }
        if (hipFuncSetAttribute((const void*)fwd, hipFuncAttributeMaxDynamicSharedMemorySize, LDS_BYTES) != hipSuccess) { fprintf(stderr, "kernel_launch: hipFuncSetAttribute failed\n"); grid = -1; return; }
        if (hipOccupancyMaxActiveBlocksPerMultiprocessor(&per_cu, (const void*)fwd, NWAVES * 64, LDS_BYTES) != hipSuccess || per_cu < 1) fprintf(stderr, "kernel_launch: occupancy query reports %d\n", per_cu);
        (void)hipGetLastError();
        grid = cus;
    }
    if (grid < 0) return;
    if (hipMemsetAsync((char*)d_ws + WS_CTL, 0, CTL_ZERO_BYTES, stream) != hipSuccess) return;
    Args a{};
    for (int i = 0; i < 26; ++i) a.in[i] = (const float*)d_in[i];
    a.out = (float*)d_out; a.ws = (unsigned char*)d_ws;
#if MK_ONE_LAUNCH
    a.ph_lo = 0; a.ph_hi = NPH;
    hipLaunchKernelGGL(fwd, dim3(grid), dim3(NWAVES * 64), LDS_BYTES, stream, a);
#else
    for (int ph = 0; ph < NPH; ++ph) {
        a.ph_lo = ph; a.ph_hi = ph + 1;
        hipLaunchKernelGGL(fwd, dim3(grid), dim3(NWAVES * 64), LDS_BYTES, stream, a);
    }
#endif
}
```

```cpp
#include <hip/hip_runtime.h>
#include <cstdio>
#include <cstdint>
#include <cmath>
__device__ __forceinline__ int hwl_() { int t; asm volatile("v_mbcnt_lo_u32_b32 %0, -1, 0\n\tv_mbcnt_hi_u32_b32 %0, -1, %0" : "=v"(t)); return t; }
__device__ __forceinline__ float xor16f(float v) { return __builtin_bit_cast(float, __builtin_amdgcn_ds_swizzle(__builtin_bit_cast(int, v), 0x401F)); }
__device__ __forceinline__ float xor32f(float v) { return __builtin_bit_cast(float, __builtin_amdgcn_ds_bpermute((hwl_() ^ 32) << 2, __builtin_bit_cast(int, v))); }
namespace pg8 {
#define PG8_LAS __attribute__((address_space(3)))
typedef unsigned short bf16_t;
typedef short bf16x8 __attribute__((ext_vector_type(8)));
typedef float f32x4 __attribute__((ext_vector_type(4)));
typedef unsigned u32x4 __attribute__((ext_vector_type(4)));
constexpr int BM = 256, BK = 64, HALF = 128, HTB = HALF * BK * 2  , STAGE_BYTES = 8 * HTB, NXCD = 8, WGM = 8;

__host__ __device__ __forceinline__ int lds_byte(int r, int c) { const int st = (r >> 4) * 2 + (c >> 5), rr = r & 15, cc = c & 31, ob = rr * 64 + cc * 2; return st * 1024 + (ob ^ (((ob >> 9) & 1) << 5)); }
__host__ __device__ __forceinline__ void stage_rc(int b, int& R, int& C) { const int st = b / 1024, sb = b % 1024, swz = sb ^ (((sb >> 9) & 1) << 5); R = (st >> 1) * 16 + swz / 64; C = (st & 1) * 32 + (swz % 64) / 2; }
__host__ __device__ __forceinline__ int perm32(int rho) { const int n = rho >> 4, i = rho & 15; return 8 * (i >> 2) + 4 * n + (i & 3); }

struct Unit { int pm, pn; };
struct Gemm { const bf16_t* A; const bf16_t* Bt; int M, N, K; };

struct StaticOrder {
    int nM, nN, nwg, G, c;
    __host__ __device__ void init(int M, int N, int G_, int c_) { nM = M / BM; nN = N / BM; nwg = nM * nN; G = G_; c = c_; }
    __host__ __device__ bool next(int i, Unit& u) const {
        const long L = (long)i * G + c; if (L >= nwg) return false;
        int wgid = (int)L; { const int q = nwg / NXCD, r = nwg % NXCD, xcd = wgid % NXCD, off = wgid / NXCD; wgid = (xcd < r ? xcd * (q + 1) : r * (q + 1) + (xcd - r) * q) + off; }
        const int nig = WGM * nN, gid = wgid / nig, fm = gid * WGM, gsz = (nM - fm) < WGM ? (nM - fm) : WGM;
        u.pm = fm + ((wgid % nig) % gsz); u.pn = (wgid % nig) / gsz; return true;
    }
    __device__ __forceinline__ void a_ready(const Unit&) const {}
    __device__ __forceinline__ void done(const Unit&) const {}
};

__device__ __forceinline__ unsigned cvt_pk_bf16(float lo, float hi) { unsigned r; asm volatile("v_cvt_pk_bf16_f32 %0, %1, %2" : "=v"(r) : "v"(lo), "v"(hi)); return r; }
template <int ACT  > struct EpiBf16 {
    static constexpr bool PERM = true, AFTER_DRAIN = false;
    bf16_t* O; int ldc; const float* rss;
    __device__ __forceinline__ void operator()(const f32x4 (&acc)[2][2][4][2], const Unit& u, int wr, int wc, int fr, int fq) const {
        const int row0 = u.pm * BM + wr * 64 + fr, col0 = u.pn * BM + wc * 32 + 8 * fq;
#pragma unroll
        for (int ai = 0; ai < 2; ++ai)
#pragma unroll
            for (int m = 0; m < 4; ++m) { const int row = row0 + ai * HALF + m * 16; bf16_t* rowp = O + (size_t)row * ldc + col0;
                f32x4 pr = *(const f32x4*)(rss + (size_t)row * 16 + 4 * fq); float ssum = (pr[0] + pr[1]) + (pr[2] + pr[3]);
                ssum += ::xor16f(ssum); ssum += ::xor32f(ssum);
                const float rs = __builtin_amdgcn_rsqf(ssum * (1.f / 1024.f) + 1e-6f);
#pragma unroll
                for (int bj = 0; bj < 2; ++bj) { f32x4 v0 = acc[ai][bj][m][0] * rs, v1 = acc[ai][bj][m][1] * rs;
                    if (ACT == 2) {
#pragma unroll
                        for (int e = 0; e < 4; ++e) { const float a = v0[e] > 0.f ? v0[e] : 0.f, b = v1[e] > 0.f ? v1[e] : 0.f; v0[e] = a * a; v1[e] = b * b; } }
                    u32x4 w; w.x = cvt_pk_bf16(v0[0], v0[1]); w.y = cvt_pk_bf16(v0[2], v0[3]); w.z = cvt_pk_bf16(v1[0], v1[1]); w.w = cvt_pk_bf16(v1[2], v1[3]);
                    *(u32x4*)(rowp + bj * HALF) = w; } }
    }
};
struct EpiResF32 {
    static constexpr bool PERM = true, AFTER_DRAIN = false;
    const float* base; float* out; int ldc; bf16_t* xn; float* rss;
    __device__ __forceinline__ void operator()(const f32x4 (&acc)[2][2][4][2], const Unit& u, int wr, int wc, int fr, int fq) const {
        const int row0 = u.pm * BM + wr * 64 + fr, col0 = u.pn * BM + wc * 32 + 8 * fq;
#pragma unroll
        for (int ai = 0; ai < 2; ++ai)
#pragma unroll
            for (int m = 0; m < 4; ++m) { const int row = row0 + ai * HALF + m * 16; const size_t off = (size_t)row * ldc + col0; float ss = 0.f;
#pragma unroll
                for (int bj = 0; bj < 2; ++bj) {
                    const f32x4 b0 = *(const f32x4*)(base + off + bj * HALF), b1 = *(const f32x4*)(base + off + bj * HALF + 4);
                    const f32x4 o0 = b0 + acc[ai][bj][m][0], o1 = b1 + acc[ai][bj][m][1];
                    *(f32x4*)(out + off + bj * HALF) = o0; *(f32x4*)(out + off + bj * HALF + 4) = o1;
                    if (xn) { u32x4 w; w.x = cvt_pk_bf16(o0[0], o0[1]); w.y = cvt_pk_bf16(o0[2], o0[3]); w.z = cvt_pk_bf16(o1[0], o1[1]); w.w = cvt_pk_bf16(o1[2], o1[3]); *(u32x4*)(xn + off + bj * HALF) = w;
                        ss += ((o0[0] * o0[0] + o0[1] * o0[1]) + (o0[2] * o0[2] + o0[3] * o0[3])) + ((o1[0] * o1[0] + o1[1] * o1[1]) + (o1[2] * o1[2] + o1[3] * o1[3])); } }
                if (xn) { ss += ::xor16f(ss); ss += ::xor32f(ss); if (fq == 0) rss[(size_t)row * 16 + 4 * u.pn + wc] = ss; } }
    }
};

template <class Epi, class Sched, bool ALIGN_EPI = false, bool SP2 = false>
__device__ __forceinline__ void gemm_phase(PG8_LAS unsigned char* lds, const Gemm g, const Sched& S, const Epi& E, const int wave_id  ) {
    int tid_l = wave_id * 64 + ::hwl_();
    const int tid = tid_l, wid = __builtin_amdgcn_readfirstlane(tid >> 6), lane = tid & 63, wr = wid >> 2, wc = wid & 3, fr = lane & 15, fq = lane >> 4;
    const int K = g.K, nt = K / BK;
    unsigned voffA[2], voffB[2];
#pragma unroll
    for (int i = 0; i < 2; ++i) { int R, C; stage_rc(tid * 16 + i * 8192, R, C); const int Rb = Epi::PERM ? ((R & ~31) + perm32(R & 31)) : R;
        voffA[i] = (unsigned)(R * K + C) * 2u; voffB[i] = (unsigned)(Rb * K + C) * 2u; }
    const size_t kstep = (size_t)(BK * 2);
    const size_t hstep = (size_t)HALF * K * 2;
    const size_t tstep = 2 * hstep;
    const unsigned ldsw = (unsigned)wid * 1024u;
    const int aoff = lds_byte(wr * 64 + fr, fq * 8), boff = lds_byte(wc * 32 + fr, fq * 8);
#define PG8_SA(b, h) (((b) * 2 + (h)) * HTB)
#define PG8_SB(b, h) ((4 + (b) * 2 + (h)) * HTB)
#define PG8_STAGE(bufoff, gbase, voff) do { _Pragma("unroll") for (int _i = 0; _i < 2; ++_i) \
        __builtin_amdgcn_global_load_lds((const unsigned*)((const char*)(gbase) + (voff)[_i]), (PG8_LAS unsigned*)(lds + (bufoff) + ldsw + _i * 8192), 16, 0, 0); } while (0)
#define PG8_LDA(dst, b, h) do { _Pragma("unroll") for (int m = 0; m < 4; ++m) _Pragma("unroll") for (int k = 0; k < 2; ++k) dst[m][k] = *(const PG8_LAS bf16x8*)(lds + PG8_SA(b, h) + aoff + m * 2048 + k * 1024); } while (0)
#define PG8_LDB(dst, b, h) do { _Pragma("unroll") for (int n = 0; n < 2; ++n) _Pragma("unroll") for (int k = 0; k < 2; ++k) dst[n][k] = *(const PG8_LAS bf16x8*)(lds + PG8_SB(b, h) + boff + n * 2048 + k * 1024); } while (0)
#define PG8_MMA(ai, bj, At, Bt) do { __builtin_amdgcn_s_setprio(1); _Pragma("unroll") for (int m = 0; m < 4; ++m) _Pragma("unroll") for (int n = 0; n < 2; ++n) _Pragma("unroll") for (int k = 0; k < 2; ++k) \
        acc[ai][bj][m][n] = __builtin_amdgcn_mfma_f32_16x16x32_bf16(Bt[n][k], At[m][k], acc[ai][bj][m][n], 0, 0, 0); __builtin_amdgcn_s_setprio(0); } while (0)
#define PG8_WAIT_V(n) asm volatile("s_waitcnt vmcnt(" #n ")" ::: "memory")
#define PG8_WAIT_L(n) asm volatile("s_waitcnt lgkmcnt(" #n ")" ::: "memory")
#define PG8_BAR __builtin_amdgcn_s_barrier()
#define PG8_SCHED __builtin_amdgcn_sched_barrier(0)
    Unit cur, nxt; int ui = 0;
    if (!S.next(0, cur)) return;
    f32x4 acc[2][2][4][2];
#pragma unroll
    for (int a = 0; a < 2; ++a)
#pragma unroll
        for (int b = 0; b < 2; ++b)
#pragma unroll
            for (int m = 0; m < 4; ++m)
#pragma unroll
                for (int n = 0; n < 2; ++n) acc[a][b][m][n] = (f32x4){0.f, 0.f, 0.f, 0.f};
    bf16x8 At[4][2], B0[2][2], B1[2][2];
    const char* cA = (const char*)g.A + (size_t)cur.pm * tstep; const char* cB = (const char*)g.Bt + (size_t)cur.pn * tstep;
    S.a_ready(cur);
    if constexpr (SP2) {
        PG8_STAGE(PG8_SB(0, 0), cB, voffB); PG8_STAGE(PG8_SB(0, 1), cB + hstep, voffB); PG8_STAGE(PG8_SA(0, 0), cA, voffA); PG8_STAGE(PG8_SA(0, 1), cA + hstep, voffA);
        if (wr == 1) PG8_BAR;
        PG8_WAIT_V(2); PG8_BAR;
        PG8_STAGE(PG8_SB(1, 0), cB + kstep, voffB); PG8_STAGE(PG8_SA(1, 0), cA + kstep, voffA); PG8_STAGE(PG8_SB(1, 1), cB + hstep + kstep, voffB);
        PG8_WAIT_V(6); PG8_BAR;
    } else {
        PG8_STAGE(PG8_SB(0, 0), cB, voffB); PG8_STAGE(PG8_SA(0, 0), cA, voffA); PG8_STAGE(PG8_SB(0, 1), cB + hstep, voffB); PG8_STAGE(PG8_SA(0, 1), cA + hstep, voffA);
        if (wr == 1) PG8_BAR;
        PG8_WAIT_V(4); PG8_BAR;
        PG8_STAGE(PG8_SB(1, 0), cB + kstep, voffB); PG8_STAGE(PG8_SA(1, 0), cA + kstep, voffA); PG8_STAGE(PG8_SB(1, 1), cB + hstep + kstep, voffB);
        PG8_WAIT_V(6); PG8_BAR;
    }
    for (;;) {
        const bool has_next = S.next(ui + 1, nxt);
        const char* nA = has_next ? (const char*)g.A + (size_t)nxt.pm * tstep : cA; const char* nB = has_next ? (const char*)g.Bt + (size_t)nxt.pn * tstep : cB;
        for (int t = 0; t < nt; t += 2) {
            const bool last = (t == nt - 2);
            const char* a1 = cA + (size_t)(t + 1) * kstep;
            const char* a2 = last ? nA : cA + (size_t)(t + 2) * kstep; const char* b2 = last ? nB : cB + (size_t)(t + 2) * kstep;
            const char* a3 = a2 + kstep; const char* b3 = b2 + kstep;
            if (last && has_next) S.a_ready(nxt);
            if constexpr (SP2) {
            PG8_LDB(B0, 0, 0); PG8_LDB(B1, 0, 1); PG8_SCHED; PG8_LDA(At, 0, 0); PG8_STAGE(PG8_SA(1, 1), a1 + hstep, voffA);
            PG8_WAIT_V(8); PG8_WAIT_L(0); PG8_BAR; PG8_MMA(0, 0, At, B0); PG8_MMA(0, 1, At, B1); PG8_BAR; PG8_SCHED;
            PG8_LDA(At, 0, 1); PG8_STAGE(PG8_SB(0, 0), b2, voffB); PG8_STAGE(PG8_SB(0, 1), b2 + hstep, voffB); PG8_STAGE(PG8_SA(0, 0), a2, voffA);
            PG8_WAIT_V(8); PG8_WAIT_L(0); PG8_BAR; PG8_MMA(1, 0, At, B0); PG8_MMA(1, 1, At, B1); PG8_BAR; PG8_SCHED;
            PG8_LDB(B0, 1, 0); PG8_LDB(B1, 1, 1); PG8_SCHED; PG8_LDA(At, 1, 0); PG8_STAGE(PG8_SA(0, 1), a2 + hstep, voffA);
            PG8_WAIT_V(8); PG8_WAIT_L(0); PG8_BAR; PG8_MMA(0, 0, At, B0); PG8_MMA(0, 1, At, B1); PG8_BAR; PG8_SCHED;
            PG8_LDA(At, 1, 1); PG8_STAGE(PG8_SB(1, 0), b3, voffB); PG8_STAGE(PG8_SB(1, 1), b3 + hstep, voffB); PG8_STAGE(PG8_SA(1, 0), a3, voffA);
            PG8_WAIT_V(8); PG8_WAIT_L(0); PG8_BAR; PG8_MMA(1, 0, At, B0); PG8_MMA(1, 1, At, B1); PG8_BAR; PG8_SCHED;
            } else {
            PG8_LDB(B0, 0, 0); PG8_SCHED; PG8_LDA(At, 0, 0); PG8_STAGE(PG8_SA(1, 1), a1 + hstep, voffA);
            PG8_WAIT_L(8); PG8_BAR; PG8_WAIT_L(0); PG8_MMA(0, 0, At, B0); PG8_BAR; PG8_SCHED;
            PG8_LDB(B1, 0, 1); PG8_STAGE(PG8_SB(0, 0), b2, voffB);
            PG8_BAR; PG8_WAIT_L(0); PG8_MMA(0, 1, At, B1); PG8_BAR;
            PG8_LDA(At, 0, 1); PG8_STAGE(PG8_SA(0, 0), a2, voffA);
            PG8_BAR; PG8_WAIT_L(0); PG8_MMA(1, 0, At, B0); PG8_BAR; PG8_SCHED;
            PG8_STAGE(PG8_SB(0, 1), b2 + hstep, voffB);
            PG8_WAIT_V(6); PG8_BAR; PG8_MMA(1, 1, At, B1); PG8_BAR;
            PG8_LDB(B0, 1, 0); PG8_SCHED; PG8_LDA(At, 1, 0); PG8_STAGE(PG8_SA(0, 1), a2 + hstep, voffA);
            PG8_WAIT_L(8); PG8_BAR; PG8_WAIT_L(0); PG8_MMA(0, 0, At, B0); PG8_BAR; PG8_SCHED;
            PG8_LDB(B1, 1, 1); PG8_STAGE(PG8_SB(1, 0), b3, voffB);
            PG8_BAR; PG8_WAIT_L(0); PG8_MMA(0, 1, At, B1); PG8_BAR;
            PG8_LDA(At, 1, 1); PG8_STAGE(PG8_SA(1, 0), a3, voffA);
            PG8_BAR; PG8_WAIT_L(0); PG8_MMA(1, 0, At, B0); PG8_BAR; PG8_SCHED;
            PG8_STAGE(PG8_SB(1, 1), b3 + hstep, voffB);
            PG8_WAIT_V(6); PG8_BAR; PG8_MMA(1, 1, At, B1); PG8_BAR;
            }
        }
        if constexpr (ALIGN_EPI) { if (wr == 0) PG8_BAR; }
        if constexpr (!Epi::AFTER_DRAIN) { E(acc, cur, wr, wc, fr, fq); S.done(cur); }
        if (!has_next) break;
#pragma unroll
        for (int a = 0; a < 2; ++a)
#pragma unroll
            for (int b = 0; b < 2; ++b)
#pragma unroll
                for (int m = 0; m < 4; ++m)
#pragma unroll
                    for (int n = 0; n < 2; ++n) acc[a][b][m][n] = (f32x4){0.f, 0.f, 0.f, 0.f};
        cur = nxt; cA = nA; cB = nB; ++ui;
        if constexpr (ALIGN_EPI) { if (wr == 1) PG8_BAR; }
    }
    PG8_WAIT_V(0);
    if constexpr (!ALIGN_EPI) { if (wr == 0) PG8_BAR; }
    PG8_BAR;
    if constexpr (Epi::AFTER_DRAIN) { E.fused(acc, cur, wr, wc, fr, fq, lds, wid, lane); S.done(cur); }
#undef PG8_SA
#undef PG8_SB
#undef PG8_STAGE
#undef PG8_LDA
#undef PG8_LDB
#undef PG8_MMA
#undef PG8_WAIT_V
#undef PG8_WAIT_L
#undef PG8_BAR
#undef PG8_SCHED
}
}
constexpr int NWAVES = 8;
constexpr int BATCH = 16, SEQ = 2048, DM = 1024, DEPTH = 4, DFF = 4096;
constexpr int M = BATCH * SEQ;
constexpr int DIN = 2824;
constexpr int ZP = 3072;
constexpr int ZC_RW_R = 0, ZC_RW_K = 256, ZC_RW_V = 512, ZC_RW_DW = 768;
constexpr int ZC_GD_Q = 1024, ZC_GD_K = 1280, ZC_GD_V = 1536, ZC_GD_G = 1792;
constexpr int ZC_AT_Q = 2048, ZC_AT_K = 2560, ZC_AT_V = 2688;
constexpr int ZC_GD_B = 2816, ZC_GD_A = 2820;
__host__ __device__ __forceinline__ int win_src_col(int n) {
    if (n < 2048) return n;
    if (n < 2816) return n + 8;
    if (n < 2824) return n - 2816 + 2048;
    return -1;
}
constexpr size_t MiB = 1u << 20;
constexpr size_t WS_CTL = 0, CTL_ZERO_BYTES = 1 * MiB;
constexpr size_t WS_WIN = 1 * MiB;
constexpr size_t WS_WOUT = WS_WIN + (size_t)DEPTH * ZP * DM * 2;
constexpr size_t WS_W1 = WS_WOUT + (size_t)DEPTH * DM * DM * 2;
constexpr size_t WS_W2 = WS_W1 + (size_t)DEPTH * DFF * DM * 2;
constexpr size_t WS_XN = WS_W2 + (size_t)DEPTH * DM * DFF * 2;
constexpr size_t WS_Z = WS_XN + (size_t)M * DM * 2;
constexpr size_t WS_Y = WS_Z + (size_t)M * ZP * 2;
constexpr size_t WS_H = WS_Z;
constexpr size_t WS_HB = WS_Y + (size_t)M * DM * 2;
constexpr size_t WS_RSS = WS_HB + (size_t)256 * 8 * 24576;
constexpr size_t WS_XS = WS_RSS + (size_t)2 * DEPTH * M * 16 * 4;
constexpr size_t WS_END = WS_XS + (size_t)128 * 16384;
static_assert(WS_H + (size_t)M * DFF * 2 <= WS_HB, "H overlay");
static_assert(WS_END <= 512 * MiB, "d_ws map");
constexpr int CW_TMO = 8192, CW_SEQ = 16384;
constexpr int CW_BAR = 4096;
constexpr int RING_OFF = 0, RING_BYTES = 131072;
constexpr int LDSCTL_OFF = 158720, MISC_OFF = LDSCTL_OFF + 320;
constexpr int BIAS_OFF = LDSCTL_OFF + 1024;
constexpr int LDS_BYTES = 163840;
static_assert(BIAS_OFF + 4096 <= LDS_BYTES, "LDS map");

#define GAS __attribute__((address_space(1)))
#define LAS __attribute__((address_space(3)))
typedef unsigned short bf16;
typedef unsigned v4u __attribute__((ext_vector_type(4)));
typedef unsigned v2u __attribute__((ext_vector_type(2)));
typedef float f32x4 __attribute__((ext_vector_type(4)));
typedef GAS unsigned gu32;
#define RLX_AGENT __ATOMIC_RELAXED, __HIP_MEMORY_SCOPE_AGENT
#define LDS_WAIT() asm volatile("s_waitcnt lgkmcnt(0)" ::: "memory")
#define VM_WAIT() asm volatile("s_waitcnt vmcnt(0)" ::: "memory")
__device__ __forceinline__ int hw_lane() { return hwl_(); }
__device__ __forceinline__ unsigned f2bf(float f) { unsigned u = __builtin_bit_cast(unsigned, f); return (u + 0x7fffu + ((u >> 16) & 1u)) >> 16; }
__device__ __forceinline__ unsigned pk2(float lo, float hi) { return f2bf(lo) | (f2bf(hi) << 16); }
__device__ __forceinline__ float bf2f(unsigned short h) { return __builtin_bit_cast(float, (unsigned)h << 16); }
__device__ __forceinline__ float bflo(unsigned u) { return __builtin_bit_cast(float, u << 16); }
__device__ __forceinline__ float bfhi(unsigned u) { return __builtin_bit_cast(float, u & 0xffff0000u); }
__device__ __forceinline__ float sigmoidf_(float x) { return 1.f / (1.f + __expf(-x)); }
__device__ __forceinline__ float softplusf_(float x) { return fmaxf(x, 0.f) + log1pf(__expf(-fabsf(x))); }
__device__ __forceinline__ float dppf(float v, const int ctrl_sel) {
    int r;
    const int s = __builtin_bit_cast(int, v);
    if (ctrl_sel == 0) r = __builtin_amdgcn_update_dpp(0, s, 0xB1, 0xF, 0xF, true);
    else if (ctrl_sel == 1) r = __builtin_amdgcn_update_dpp(0, s, 0x4E, 0xF, 0xF, true);
    else if (ctrl_sel == 2) r = __builtin_amdgcn_update_dpp(0, s, 0x141, 0xF, 0xF, true);
    else r = __builtin_amdgcn_update_dpp(0, s, 0x140, 0xF, 0xF, true);
    return __builtin_bit_cast(float, r);
}
__device__ __forceinline__ float wave_allsum(float v) {
    v += dppf(v, 0); v += dppf(v, 1); v += dppf(v, 2); v += dppf(v, 3);
    const float a = __builtin_bit_cast(float, __builtin_amdgcn_readlane(__builtin_bit_cast(int, v), 0));
    const float b = __builtin_bit_cast(float, __builtin_amdgcn_readlane(__builtin_bit_cast(int, v), 16));
    const float c = __builtin_bit_cast(float, __builtin_amdgcn_readlane(__builtin_bit_cast(int, v), 32));
    const float d = __builtin_bit_cast(float, __builtin_amdgcn_readlane(__builtin_bit_cast(int, v), 48));
    return (a + b) + (c + d);
}
#define XB_TMO      128
#define XB_XCNT(j)  (256  + 64 * (j))
#define XB_XSUB(j)  (1280 + 64 * (j))
#define XB_XGEN(j)  (2304 + 64 * (j))
#define XB_TOP      3328
#define XB_TOPGEN   3392
#define XCD_BAR_WORDS 3456
#define XB_SPIN_CAP (1u << 18)

__device__ __forceinline__ unsigned xb_ld(unsigned* p)              { return __hip_atomic_load(p, __ATOMIC_RELAXED, __HIP_MEMORY_SCOPE_AGENT); }
__device__ __forceinline__ unsigned xb_add(unsigned* p, unsigned v) { return __hip_atomic_fetch_add(p, v, __ATOMIC_RELAXED, __HIP_MEMORY_SCOPE_AGENT); }
__device__ __forceinline__ unsigned xb_xcc_id() { return (unsigned)__builtin_amdgcn_s_getreg((3 << 11) | 20) & 0xFu; }
#define XB_SPIN(cond, bar) do { unsigned _sp = 0; while (cond) { __builtin_amdgcn_s_sleep(1); \
    if ((++_sp & 255u) == 0u) { if (xb_ld(&(bar)[XB_TMO])) break; if (_sp > XB_SPIN_CAP) { atomicAdd(&(bar)[XB_TMO], 1u); break; } } } } while (0)

struct XcdBarrier {
    unsigned* bar; unsigned x;
    volatile LAS unsigned* st;
};

__device__ __forceinline__ XcdBarrier xcd_barrier_post(unsigned* bar, volatile LAS unsigned* st, const bool t0  ) {
    XcdBarrier b; b.bar = bar; b.x = xb_xcc_id(); b.st = st;
    if (t0) (void)xb_add(&bar[XB_XCNT(b.x)], 1u);
    return b;
}
__device__ __forceinline__ void xcd_barrier_complete(unsigned* bar, unsigned x, unsigned& nloc, unsigned& nx) {
    const unsigned G = gridDim.x * gridDim.y * gridDim.z;
    unsigned sum, cnt, mine, sp = 0u;
    for (;;) {
        sum = 0u; cnt = 0u; mine = 0u;
#pragma unroll
        for (unsigned j = 0; j < 16; ++j) { const unsigned c = xb_ld(&bar[XB_XCNT(j)]); sum += c; cnt += (c > 0u) ? 1u : 0u; mine = (j == x) ? c : mine; }
        if (sum == G) break;
        __builtin_amdgcn_s_sleep(1);
        if ((++sp & 255u) == 0u) { if (xb_ld(&bar[XB_TMO])) break; if (sp > XB_SPIN_CAP) { atomicAdd(&bar[XB_TMO], 1u); break; } }
    }
    nloc = mine > 0u ? mine : 1u; nx = cnt > 0u ? cnt : 1u;
}

__device__ __forceinline__ void xcd_barrier(const XcdBarrier& b, const bool t0  ) {
    asm volatile("s_waitcnt vmcnt(0)" ::: "memory");
    __syncthreads();
    if (t0) {
        unsigned* bar = b.bar;
        __builtin_amdgcn_s_waitcnt(0);
        unsigned nloc = b.st[0], nx = b.st[1];
        if (nloc == 0u) { xcd_barrier_complete(bar, b.x, nloc, nx); b.st[0] = nloc; b.st[1] = nx; }
        const unsigned old = xb_add(&bar[XB_XSUB(b.x)], 1u);
        const unsigned gen = old / nloc;
        if (old + 1u == (gen + 1u) * nloc) {
            __builtin_amdgcn_fence(__ATOMIC_RELEASE, "agent");
            asm volatile("s_waitcnt vmcnt(0)" ::: "memory");
            const unsigned og = xb_add(&bar[XB_TOP], 1u);
            const unsigned tg = og / nx;
            if (og + 1u == (tg + 1u) * nx) xb_add(&bar[XB_TOPGEN], 1u);
            else XB_SPIN(xb_ld(&bar[XB_TOPGEN]) == tg, bar);
            __builtin_amdgcn_fence(__ATOMIC_ACQUIRE, "agent");
            xb_add(&bar[XB_XGEN(b.x)], 1u);
            asm volatile("s_waitcnt vmcnt(0)" ::: "memory");
        } else {
            XB_SPIN(xb_ld(&bar[XB_XGEN(b.x)]) == gen, bar);
            __builtin_amdgcn_fence(__ATOMIC_ACQUIRE, "agent");
            asm volatile("s_waitcnt vmcnt(0)" ::: "memory");
        }
    }
    __syncthreads();
}
struct Frame {
    LAS unsigned char* lds;
    int wave;
    int vcu, G;
    unsigned char* ws;
    float* out;
};
typedef const float* cfp;
typedef const __attribute__((address_space(4))) cfp* karg_tab;
__device__ __forceinline__ karg_tab ktab() { karg_tab t = (karg_tab)__builtin_amdgcn_kernarg_segment_ptr(); asm volatile("" : "+s"(t)); return t; }
#define INP(i) (ktab()[i])
__device__ __forceinline__ int ltid() { return hw_lane(); }
__device__ __forceinline__ unsigned char* lnd(unsigned char* p) { asm volatile("" : "+s"(p)); return p; }
#define WSP(off) (lnd(F.ws) + (off))
#define FZ ((bf16*)WSP(WS_Z))
#define FY ((bf16*)WSP(WS_Y))
#define FXN ((bf16*)WSP(WS_XN))
#define FH ((bf16*)WSP(WS_H))
enum { I_X = 0, I_LN1 = 1, I_WIN = 2, I_MU = 3, I_W0 = 4, I_WUP = 5, I_A0 = 6, I_AUP = 7, I_GUP = 8, I_KK = 9, I_KA = 10, I_RK = 11, I_LNXW = 12, I_LNXB = 13,
       I_CONV = 14, I_ALOG = 15, I_DTB = 16, I_GNW = 17, I_QNW = 18, I_KNW = 19, I_SINK = 20, I_RELB = 21, I_WOUT = 22, I_LN2 = 23, I_WFF1 = 24, I_WFF2 = 25 };

template <bool MAP>
__device__ __forceinline__ void p0_transpose_item(const float* W, int K, int Nsrc, int Ndst, bf16* WT, LAS float* scr, int item, int lane, const float* kscale = nullptr) {
    const int nblk = Ndst / 64, kb = item / nblk, nb = item % nblk, k0 = 64 * kb, n0 = 64 * nb;
    const int c4 = lane & 15, r = lane >> 4;
    const int nn = n0 + 4 * c4; const int src = MAP ? win_src_col(nn) : nn;
#pragma unroll 8
    for (int i = 0; i < 16; ++i) { const int kk = 4 * i + r;
        f32x4 v = {0.f, 0.f, 0.f, 0.f}; if (src >= 0) v = *(const GAS f32x4*)(W + (size_t)(k0 + kk) * Nsrc + src);
        const float sc = kscale ? kscale[k0 + kk] : 1.f;
        LAS float* d = scr + kk * 65 + 4 * c4; d[0] = v.x * sc; d[1] = v.y * sc; d[2] = v.z * sc; d[3] = v.w * sc; }
    LDS_WAIT(); asm volatile("" ::: "memory");
    const int c = lane & 7;
#pragma unroll
    for (int j = 0; j < 8; ++j) { const int n = (lane >> 3) + 8 * j; const LAS float* s = scr + (8 * c) * 65 + n;
        v4u o; o.x = pk2(s[0 * 65], s[1 * 65]); o.y = pk2(s[2 * 65], s[3 * 65]); o.z = pk2(s[4 * 65], s[5 * 65]); o.w = pk2(s[6 * 65], s[7 * 65]);
        *(GAS v4u*)(WT + (size_t)(n0 + n) * K + k0 + 8 * c) = o; }
    LDS_WAIT(); asm volatile("" ::: "memory");
}
__device__ __forceinline__ void cast_rows(Frame& F, const float* x, bf16* xn, float* rss) {
    const int lane = ltid() & 63;
    const int gw = F.vcu * NWAVES + F.wave, NGW = F.G * NWAVES;
    for (int m = gw; m < M; m += NGW) {
        const GAS f32x4* xr = (const GAS f32x4*)(x + (size_t)m * DM) + lane;
        f32x4 v[4]; float s = 0.f;
#pragma unroll
        for (int j = 0; j < 4; ++j) { v[j] = xr[64 * j]; s += (v[j].x * v[j].x + v[j].y * v[j].y) + (v[j].z * v[j].z + v[j].w * v[j].w); }
        s = wave_allsum(s);
        if (lane < 16) rss[(size_t)m * 16 + lane] = (lane == 0) ? s : 0.f;
        GAS unsigned long long* o8 = (GAS unsigned long long*)(xn + (size_t)m * DM) + lane;
#pragma unroll
        for (int j = 0; j < 4; ++j) o8[64 * j] = (unsigned long long)pk2(v[j].x, v[j].y) | ((unsigned long long)pk2(v[j].z, v[j].w) << 32);
    }
}
__device__ __forceinline__ void p0_prologue(Frame& F) {
    const int lane_ = ltid() & 63;
    LAS float* scr = (LAS float*)(F.lds + RING_OFF + F.wave * 16640);
    const int gw = F.vcu * NWAVES + F.wave, NGW = F.G * NWAVES;
    constexpr int I_IN = (DM / 64) * (ZP / 64), I_O = (DM / 64) * (DM / 64), I_1 = (DM / 64) * (DFF / 64), I_2 = (DFF / 64) * (DM / 64);
    constexpr int PER_L = I_IN + I_O + I_1 + I_2, NITEMS = DEPTH * PER_L;
    for (int it = gw; it < NITEMS; it += NGW) {
        const int l = it / PER_L; int r = it % PER_L;
        if (r < I_IN) { p0_transpose_item<true>(INP(I_WIN) + (size_t)l * DM * DIN, DM, DIN, ZP, ((bf16*)WSP(WS_WIN)) + (size_t)l * ZP * DM, scr, r, lane_, INP(I_LN1) + (size_t)l * DM); continue; } r -= I_IN;
        if (r < I_O) { p0_transpose_item<false>(INP(I_WOUT) + (size_t)l * DM * DM, DM, DM, DM, ((bf16*)WSP(WS_WOUT)) + (size_t)l * DM * DM, scr, r, lane_); continue; } r -= I_O;
        if (r < I_1) { p0_transpose_item<false>(INP(I_WFF1) + (size_t)l * DM * DFF, DM, DFF, DFF, ((bf16*)WSP(WS_W1)) + (size_t)l * DFF * DM, scr, r, lane_, INP(I_LN2) + (size_t)l * DM); continue; } r -= I_1;
        p0_transpose_item<false>(INP(I_WFF2) + (size_t)l * DFF * DM, DFF, DM, DM, ((bf16*)WSP(WS_W2)) + (size_t)l * DM * DFF, scr, r, lane_);
    }
    cast_rows(F, INP(I_X), FXN, (float*)WSP(WS_RSS));
}

#define MX_DEV __device__ __forceinline__
#define MX_G __attribute__((address_space(1)))
#define MX_L __attribute__((address_space(3)))
#define MX_EXP(x) __expf(x)
#define MX_LOG1P(x) log1pf(x)
#define MXIN(i) ((const MX_G float*)INP(i))
#define MX_VMWAIT() asm volatile("s_waitcnt vmcnt(0)" ::: "memory")
#define MX_LDSWAIT() asm volatile("s_waitcnt lgkmcnt(0)" ::: "memory")
#define MX_SCHED() __builtin_amdgcn_sched_barrier(0)
#define MX_LAUNDER_S(p) asm volatile("" : "+s"(p))
#define MX_LAUNDER_V(p) asm volatile("" : "+v"(p))
#define MX_CONSUME(x) asm volatile("" :: "v"(x))
#define MX_FMAC(acc, a, b) asm("v_fmac_f32_e32 %0, %1, %2" : "+v"(acc) : "v"(a), "v"(b))
#define MX_RCP(x) __builtin_amdgcn_rcpf(x)
#define MX_RSQ(x) __builtin_amdgcn_rsqf(x)
#define MX_LOG(x) __logf(x)
typedef __bf16 mx_bf2_t __attribute__((ext_vector_type(2)));
typedef float mx_f2_t __attribute__((ext_vector_type(2)));
__device__ __forceinline__ unsigned mx_hwpk2(float lo, float hi) { mx_f2_t v = {lo, hi}; return __builtin_bit_cast(unsigned, __builtin_convertvector(v, mx_bf2_t)); }
#define MX_PK2(lo, hi) mx_hwpk2(lo, hi)
#define MX_UNIFORM(x) __builtin_amdgcn_readfirstlane(x)
#define MX_ROW_SHR(v, d) __builtin_bit_cast(float, __builtin_amdgcn_update_dpp(0, __builtin_bit_cast(int, (v)), 0x110 + (d), 0xF, 0xF, true))
#define MX_ROW_SHRU(v, d) ((unsigned)__builtin_amdgcn_update_dpp(0, (int)(v), 0x110 + (d), 0xF, 0xF, true))
#define MX_ROW_RORU(v, d) ((unsigned)__builtin_amdgcn_update_dpp(0, (int)(v), 0x120 + (d), 0xF, 0xF, true))
#define MX_ROW_LAST(v) __builtin_bit_cast(float, __builtin_amdgcn_update_dpp(0, __builtin_bit_cast(int, (v)), 0x15F, 0xF, 0xF, true))
#define MX_ROW_SHR(v, d) __builtin_bit_cast(float, __builtin_amdgcn_update_dpp(0, __builtin_bit_cast(int, (v)), 0x110 + (d), 0xF, 0xF, true))
#define MX_ROW_LAST(v) __builtin_bit_cast(float, __builtin_amdgcn_update_dpp(0, __builtin_bit_cast(int, (v)), 0x15F, 0xF, 0xF, true))
typedef unsigned mx_u2_t __attribute__((ext_vector_type(2)));
__device__ __forceinline__ float mx_hw_rowsum4(float v) {
    const mx_u2_t a = __builtin_amdgcn_permlane16_swap(__builtin_bit_cast(unsigned, v), __builtin_bit_cast(unsigned, v), false, false);
    const float s = __builtin_bit_cast(float, a.x) + __builtin_bit_cast(float, a.y);
    const mx_u2_t b = __builtin_amdgcn_permlane32_swap(__builtin_bit_cast(unsigned, s), __builtin_bit_cast(unsigned, s), false, false);
    return __builtin_bit_cast(float, b.x) + __builtin_bit_cast(float, b.y);
}
#define MX_ROWSUM4(v) mx_hw_rowsum4(v)
#define MX_FLAG_LOAD(p) __hip_atomic_load((p), __ATOMIC_RELAXED, __HIP_MEMORY_SCOPE_AGENT)
#define MX_FLAG_STORE(p, v) __hip_atomic_store((p), (v), __ATOMIC_RELAXED, __HIP_MEMORY_SCOPE_AGENT)
#define MX_FLAG_ADD(p, v) __hip_atomic_fetch_add((p), (v), __ATOMIC_RELAXED, __HIP_MEMORY_SCOPE_AGENT)
#define MX_SLEEP() __builtin_amdgcn_s_sleep(2)
#define MX_SC1_LOAD64(p) __hip_atomic_load((p), __ATOMIC_RELAXED, __HIP_MEMORY_SCOPE_AGENT)
#define MX_SC1_STORE64(p, v) __hip_atomic_store((p), (v), __ATOMIC_RELAXED, __HIP_MEMORY_SCOPE_AGENT)
__device__ __forceinline__ int mx_lane() { return ltid() & 63; }
__device__ __forceinline__ void mx_wgsync() { __syncthreads(); }
__device__ __forceinline__ float mx_shfl_xor(float v, int m) { return m == 16 ? xor16f(v) : xor32f(v); }
__device__ __forceinline__ float mx_shfl16l(float v, int src, int lane) { return __builtin_bit_cast(float, __builtin_amdgcn_ds_bpermute(((lane & 48) | src) << 2, __builtin_bit_cast(int, v))); }
typedef short mx_bf16x8_t __attribute__((ext_vector_type(8)));
typedef float mx_f32x4_t __attribute__((ext_vector_type(4)));
__device__ __forceinline__ mx_f32x4_t mx_mfma(mx_bf16x8_t a, mx_bf16x8_t b, mx_f32x4_t c) { return __builtin_amdgcn_mfma_f32_16x16x32_bf16(a, b, c, 0, 0, 0); }
typedef short mx_s16x4_t __attribute__((ext_vector_type(4)));
#define MX_MFMA16(a, b, c) __builtin_amdgcn_mfma_f32_16x16x16bf16_1k(__builtin_bit_cast(mx_s16x4_t, a), __builtin_bit_cast(mx_s16x4_t, b), c, 0, 0, 0)
typedef short mx_bf16x8 __attribute__((ext_vector_type(8)));
typedef float mx_f32x4 __attribute__((ext_vector_type(4)));
typedef unsigned mx_u32x4 __attribute__((ext_vector_type(4)));
typedef unsigned mx_u32x2 __attribute__((ext_vector_type(2)));

MX_DEV unsigned mx_bf(float f) { unsigned u = __builtin_bit_cast(unsigned, f); return (u + 0x7fffu + ((u >> 16) & 1u)) >> 16; }
MX_DEV unsigned mx_pk2(float lo, float hi) { return MX_PK2(lo, hi); }
MX_DEV float mx_lo(unsigned u) { return __builtin_bit_cast(float, u << 16); }
MX_DEV float mx_hi(unsigned u) { return __builtin_bit_cast(float, u & 0xffff0000u); }
MX_DEV mx_bf16x8 mx_frag8(const float* a, const float* b) {
    mx_u32x4 w; w.x = mx_pk2(a[0], a[1]); w.y = mx_pk2(a[2], a[3]); w.z = mx_pk2(b[0], b[1]); w.w = mx_pk2(b[2], b[3]); return __builtin_bit_cast(mx_bf16x8, w); }
MX_DEV mx_bf16x8 mx_frag8v(mx_f32x4 a, mx_f32x4 b) {
    mx_u32x4 w; w.x = mx_pk2(a.x, a.y); w.y = mx_pk2(a.z, a.w); w.z = mx_pk2(b.x, b.y); w.w = mx_pk2(b.z, b.w); return __builtin_bit_cast(mx_bf16x8, w); }
MX_DEV mx_u32x2 mx_frag4(mx_f32x4 a) { mx_u32x2 w; w.x = mx_pk2(a.x, a.y); w.y = mx_pk2(a.z, a.w); return w; }
MX_DEV mx_f32x4 mx_mfma(mx_u32x2 a, mx_u32x2 b, mx_f32x4 c) { return MX_MFMA16(a, b, c); }
typedef unsigned long long mx_u64x2 __attribute__((ext_vector_type(2)));
MX_DEV mx_u32x2 mx_frag4p(mx_u32x2 p) { return p; }
MX_DEV mx_u32x2 mx_pack4(mx_f32x4 a) { mx_u32x2 p; p.x = mx_pk2(a.x, a.y); p.y = mx_pk2(a.z, a.w); return p; }
MX_DEV mx_f32x4 mx_zero4() { mx_f32x4 z = {0.f, 0.f, 0.f, 0.f}; return z; }
MX_DEV float mx_sigmoid(float x) { return MX_RCP(1.f + MX_EXP(-x)); }
MX_DEV float mx_softplus(float x) { return fmaxf(x, 0.f) + MX_LOG(1.f + MX_EXP(-fabsf(x))); }
MX_DEV float mx_rowsum4(float v) { v += mx_shfl_xor(v, 16); v += mx_shfl_xor(v, 32); return v; }

constexpr int MX_HB_WA = 0, MX_HB_RT = 2048, MX_HB_ARB = 4096, MX_HB_ARK = 4608, MX_HB_BH = 5120, MX_HB_KH = 7168, MX_HB_VC = 9216, MX_HB_U0 = 11264, MX_HB_GAM = 13312, MX_HB_SLOT = 13568;
constexpr int MX_GB_GT = 0, MX_GB_EE = 2048, MX_GB_SLOT = 4096;
constexpr int MX_LDS_HB = 0, MX_LDS_WW = 108544, MX_LDS_WA = 117760, MX_LDS_WG = 126976, MX_LDS_PAR = 144384, MX_LDS_ST = 148480, MX_LDS_GAM = 152576  , MX_LDS_END = 156672, MX_RS64 = 144, MX_RS128 = 272;
constexpr int MX_P_MUR = 256, MX_P_MUK = 320, MX_P_MUV = 384, MX_P_W0 = 448, MX_P_A0 = 512, MX_P_KK = 576, MX_P_KA = 640, MX_P_RK = 704, MX_P_LNW = 768, MX_P_LNB = 832, MX_P_GNW = 768;

MX_DEV void mx_prep_back(float (&lw)[16], float (&a)[16], float (&b)[16], float (&k2)[16], float (&r)[16], float (&v)[16], MX_L unsigned char* slot, MX_L unsigned char* gamp  , bool midbar, int lane) {
    const int tk = lane & 15, g = lane >> 4;
    float G[16];
#pragma unroll
    for (int i = 0; i < 16; ++i) G[i] = lw[i];
#pragma unroll
    for (int i = 0; i < 16; ++i) { G[i] += MX_ROW_SHR(G[i], 1); G[i] += MX_ROW_SHR(G[i], 2); G[i] += MX_ROW_SHR(G[i], 4); G[i] += MX_ROW_SHR(G[i], 8); }
    MX_SCHED();
    mx_bf16x8 AtF[2], BtF[2], KtF[2], RtF[2], BhF[2], KhF[2], VF[2];
    {
        float x[16];
#pragma unroll
        for (int i = 0; i < 16; ++i) { x[i] = a[i] * MX_EXP(G[i] - lw[i]); }
        AtF[0] = mx_frag8(x, x + 4); AtF[1] = mx_frag8(x + 8, x + 12);
    }
    MX_SCHED();
    {
        float x[16];
#pragma unroll
        for (int i = 0; i < 16; ++i) { x[i] = r[i] * MX_EXP(G[i]); }
        RtF[0] = mx_frag8(x, x + 4); RtF[1] = mx_frag8(x + 8, x + 12);
        VF[0] = mx_frag8(v, v + 4); VF[1] = mx_frag8(v + 8, v + 12);
    }
    MX_SCHED();
    {
        float x[16], y[16];
#pragma unroll
        for (int i = 0; i < 16; ++i) { const float e = MX_EXP(-G[i]); x[i] = b[i] * e; y[i] = k2[i] * e; }
        BtF[0] = mx_frag8(x, x + 4); BtF[1] = mx_frag8(x + 8, x + 12); KtF[0] = mx_frag8(y, y + 4); KtF[1] = mx_frag8(y + 8, y + 12);
    }
    MX_SCHED();
    {
        float x[16], y[16], gam[16];
#pragma unroll
        for (int i = 0; i < 16; ++i) { const float gc = MX_ROW_LAST(G[i]); const float e = MX_EXP(gc - G[i]); x[i] = b[i] * e; y[i] = k2[i] * e; gam[i] = MX_EXP(gc); }
        BhF[0] = mx_frag8(x, x + 4); BhF[1] = mx_frag8(x + 8, x + 12); KhF[0] = mx_frag8(y, y + 4); KhF[1] = mx_frag8(y + 8, y + 12);
        if (tk == 0) {
#pragma unroll
            for (int ct = 0; ct < 4; ++ct) { mx_f32x4 q = {gam[4 * ct], gam[4 * ct + 1], gam[4 * ct + 2], gam[4 * ct + 3]}; *(MX_L mx_f32x4*)(gamp + (unsigned)((16 * ct + 4 * g) * 4)) = q; } }
    }
    MX_SCHED();
    const mx_f32x4 z4 = mx_zero4();
    mx_f32x4 L = mx_mfma(BtF[1], AtF[1], mx_mfma(BtF[0], AtF[0], z4));
    mx_f32x4 LT = mx_mfma(AtF[1], BtF[1], mx_mfma(AtF[0], BtF[0], z4));
    mx_f32x4 Lak = mx_mfma(KtF[1], AtF[1], mx_mfma(KtF[0], AtF[0], z4));
    mx_f32x4 Arb = mx_mfma(BtF[1], RtF[1], mx_mfma(BtF[0], RtF[0], z4));
    mx_f32x4 Ark = mx_mfma(KtF[1], RtF[1], mx_mfma(KtF[0], RtF[0], z4));
#pragma unroll
    for (int e = 0; e < 4; ++e) { const int s = 4 * g + e;
        L[e] = (s < tk) ? L[e] : 0.f; LT[e] = (s > tk) ? LT[e] : 0.f; Lak[e] = (s < tk) ? Lak[e] : 0.f; Arb[e] = (s <= tk) ? Arb[e] : 0.f; Ark[e] = (s <= tk) ? Ark[e] : 0.f; }
    if (midbar) { MX_LDSWAIT(); mx_wgsync(); }
    *(MX_L mx_bf16x8*)(slot + (unsigned)(MX_HB_RT + lane * 16)) = RtF[0]; *(MX_L mx_bf16x8*)(slot + (unsigned)(MX_HB_RT + 1024 + lane * 16)) = RtF[1];
    *(MX_L mx_u32x2*)(slot + (unsigned)(MX_HB_ARB + lane * 8)) = mx_pack4(Arb); *(MX_L mx_u32x2*)(slot + (unsigned)(MX_HB_ARK + lane * 8)) = mx_pack4(Ark);
    mx_f32x4 T = L;
#pragma unroll
    for (int e = 0; e < 4; ++e) T[e] += (4 * g + e == tk) ? 1.f : 0.f;
    {
        const mx_u32x2 fL = mx_frag4(L), fLT = mx_frag4(LT);
        const mx_f32x4 L2 = mx_mfma(fLT, fL, z4), L2T = mx_mfma(fL, fLT, z4);
        const mx_u32x2 fL2 = mx_frag4(L2), fL2T = mx_frag4(L2T);
        T = mx_mfma(fL2T, mx_frag4(T), T);
        const mx_f32x4 L4 = mx_mfma(fL2T, fL2, z4), L4T = mx_mfma(fL2, fL2T, z4);
        const mx_u32x2 fL4 = mx_frag4(L4), fL4T = mx_frag4(L4T);
        T = mx_mfma(fL4T, mx_frag4(T), T);
        const mx_f32x4 L8T = mx_mfma(fL4, fL4T, z4);
        T = mx_mfma(mx_frag4(L8T), mx_frag4(T), T);
    }
    const mx_u32x2 fT = mx_frag4(T), fLak = mx_frag4(Lak);
    mx_bf16x8 Sel[2];
#pragma unroll
    for (int p = 0; p < 2; ++p) { mx_u32x4 w = {0u, 0u, 0u, 0u};
        if ((tk >> 2) == g) { const unsigned one = (tk & 1) ? 0x3F800000u : 0x00003F80u; const int q = 2 * p + ((tk & 3) >> 1); w.x = (q == 0) ? one : 0u; w.y = (q == 1) ? one : 0u; w.z = (q == 2) ? one : 0u; w.w = (q == 3) ? one : 0u; }
        Sel[p] = __builtin_bit_cast(mx_bf16x8, w); }
#pragma unroll
    for (int ks = 0; ks < 2; ++ks) {
        mx_f32x4 w0 = mx_mfma(mx_frag4(mx_mfma(AtF[ks], Sel[0], z4)), fT, z4);
        mx_f32x4 w1 = mx_mfma(mx_frag4(mx_mfma(AtF[ks], Sel[1], z4)), fT, z4);
        *(MX_L mx_bf16x8*)(slot + (unsigned)(MX_HB_WA + ks * 1024 + lane * 16)) = mx_frag8v(w0, w1);
    }
#pragma unroll
    for (int ct = 0; ct < 4; ++ct) {
        const mx_f32x4 vc = mx_mfma(VF[ct >> 1], Sel[ct & 1], z4);
        const mx_u32x2 vp = mx_pack4(vc);
        *(MX_L mx_u32x2*)(slot + (unsigned)(MX_HB_VC + ct * 512 + lane * 8)) = vp;
        const mx_f32x4 X = mx_mfma(fLak, mx_frag4p(vp), z4);
        const mx_f32x4 U0 = mx_mfma(fT, mx_frag4(X), z4);
        *(MX_L mx_u32x2*)(slot + (unsigned)(MX_HB_U0 + ct * 512 + lane * 8)) = mx_pack4(U0);
        *(MX_L mx_u32x2*)(slot + (unsigned)(MX_HB_BH + ct * 512 + lane * 8)) = mx_pack4(mx_mfma(BhF[ct >> 1], Sel[ct & 1], z4));
        *(MX_L mx_u32x2*)(slot + (unsigned)(MX_HB_KH + ct * 512 + lane * 8)) = mx_pack4(mx_mfma(KhF[ct >> 1], Sel[ct & 1], z4));
    }
}
MX_DEV void mx_load_t16(const MX_G unsigned short* p, bool ok, int g, float (&x)[16]) {
#pragma unroll
    for (int ct = 0; ct < 4; ++ct) { mx_u32x2 w = {0u, 0u}; if (ok) w = *(const MX_G mx_u32x2*)(p + 16 * ct + 4 * g);
        x[4 * ct] = mx_lo(w.x); x[4 * ct + 1] = mx_hi(w.x); x[4 * ct + 2] = mx_lo(w.y); x[4 * ct + 3] = mx_hi(w.y); }
}
MX_DEV void mx_load_par(const MX_G float* p, int g, float (&x)[16]) {
#pragma unroll
    for (int ct = 0; ct < 4; ++ct) { const mx_f32x4 w = *(const MX_G mx_f32x4*)(p + 16 * ct + 4 * g); x[4 * ct] = w.x; x[4 * ct + 1] = w.y; x[4 * ct + 2] = w.z; x[4 * ct + 3] = w.w; }
}
MX_DEV void mx_store_t16(MX_G unsigned char* p, int lane, const float (&x)[16]) {
#pragma unroll
    for (int ct = 0; ct < 4; ++ct) { mx_u32x2 w; w.x = mx_pk2(x[4 * ct], x[4 * ct + 1]); w.y = mx_pk2(x[4 * ct + 2], x[4 * ct + 3]); *(MX_G mx_u32x2*)(p + ct * 512 + lane * 8) = w; }
}

MX_DEV void mx_load_parL(const MX_L float* p, int g, float (&x)[16]) {
#pragma unroll
    for (int ct = 0; ct < 4; ++ct) { const mx_f32x4 w = *(const MX_L mx_f32x4*)(p + 16 * ct + 4 * g); x[4 * ct] = w.x; x[4 * ct + 1] = w.y; x[4 * ct + 2] = w.z; x[4 * ct + 3] = w.w; }
}
struct MxRaw16 { mx_u32x2 w[4]; };
MX_DEV MxRaw16 mx_raw_t16(const MX_G unsigned short* p, bool ok, int g) { MxRaw16 r;
#pragma unroll
    for (int ct = 0; ct < 4; ++ct) { mx_u32x2 w = {0u, 0u}; if (ok) w = *(const MX_G mx_u32x2*)(p + 16 * ct + 4 * g); r.w[ct] = w; }
    return r; }
MX_DEV void mx_unpack16(const MxRaw16& r, float (&x)[16]) {
#pragma unroll
    for (int ct = 0; ct < 4; ++ct) { x[4 * ct] = mx_lo(r.w[ct].x); x[4 * ct + 1] = mx_hi(r.w[ct].x); x[4 * ct + 2] = mx_lo(r.w[ct].y); x[4 * ct + 3] = mx_hi(r.w[ct].y); }
}
MX_DEV unsigned mx_shr_u(unsigned v, int d) { return d == 1 ? MX_ROW_SHRU(v, 1) : (d == 2 ? MX_ROW_SHRU(v, 2) : MX_ROW_SHRU(v, 3)); }
MX_DEV unsigned mx_ror_u(unsigned v, int d) { return d == 1 ? MX_ROW_RORU(v, 1) : (d == 2 ? MX_ROW_RORU(v, 2) : MX_ROW_RORU(v, 3)); }
MX_DEV MxRaw16 mx_raw_tail(const MX_G unsigned short* p  , int t0, int tk, int g) { MxRaw16 r;
#pragma unroll
    for (int ct = 0; ct < 4; ++ct) { mx_u32x2 w = {0u, 0u}; if (tk >= 13 && t0 - 16 + tk >= 0) w = *(const MX_G mx_u32x2*)(p + 16 * ct + 4 * g); r.w[ct] = w; }
    return r; }
MX_DEV MxRaw16 mx_raw_prev(const MxRaw16& cur, const MxRaw16& tail, int tk, int d) {
    MxRaw16 r;
#pragma unroll
    for (int ct = 0; ct < 4; ++ct) {
        const unsigned sx = mx_shr_u(cur.w[ct].x, d), sy = mx_shr_u(cur.w[ct].y, d), tx = mx_ror_u(tail.w[ct].x, d), ty = mx_ror_u(tail.w[ct].y, d);
        r.w[ct].x = (tk >= d) ? sx : tx; r.w[ct].y = (tk >= d) ? sy : ty; }
    return r;
}
MX_DEV void mx_prep_rwkv(int l, int h, const MX_G unsigned short* zseq  , int chunk, MX_L unsigned char* slot, MX_G unsigned char* gslot, MX_L unsigned char* gamp, bool midbar, const MX_L unsigned char* lds, int lane) {
    const int tk = lane & 15, g = lane >> 4, t = 16 * chunk + tk;
    const MX_G unsigned short* zrow = zseq + (size_t)t * ZP; const MX_G unsigned short* zprev = zrow - ZP; const bool hp = t > 0;
    const MX_L float* par = (const MX_L float*)(lds + MX_LDS_PAR);
    const mx_f32x4 z4 = mx_zero4();
    mx_u32x4 cwv[8], pwv[8];
#pragma unroll
    for (int ks = 0; ks < 8; ++ks) { const int col = ZC_RW_DW + 32 * ks + 8 * g; cwv[ks] = *(const MX_G mx_u32x4*)(zrow + col); mx_u32x4 pw = {0u, 0u, 0u, 0u}; if (tk == 15 && chunk > 0) pw = *(const MX_G mx_u32x4*)(zrow - (size_t)16 * ZP + col); pwv[ks] = pw; }
    const MxRaw16 kc = mx_raw_t16(zrow + ZC_RW_K + 64 * h, true, g), rc = mx_raw_t16(zrow + ZC_RW_R + 64 * h, true, g), vc_ = mx_raw_t16(zrow + ZC_RW_V + 64 * h, true, g);
    const MX_G unsigned short* ztail = zrow - (size_t)16 * ZP;
    const MxRaw16 kt_ = mx_raw_tail(ztail + ZC_RW_K + 64 * h, 16 * chunk, tk, g), rt_ = mx_raw_tail(ztail + ZC_RW_R + 64 * h, 16 * chunk, tk, g), vt_ = mx_raw_tail(ztail + ZC_RW_V + 64 * h, 16 * chunk, tk, g);
    MX_SCHED();
    mx_f32x4 accw[4], acca[4], accg[4];
#pragma unroll
    for (int ct = 0; ct < 4; ++ct) { accw[ct] = z4; acca[ct] = z4; accg[ct] = z4; }
#pragma unroll
    for (int ks = 0; ks < 8; ++ks) {
        const mx_u32x4 cw = cwv[ks]; mx_u32x4 pw = pwv[ks];
        { const unsigned sx = MX_ROW_SHRU(cw.x, 1), sy = MX_ROW_SHRU(cw.y, 1), sz = MX_ROW_SHRU(cw.z, 1), sw = MX_ROW_SHRU(cw.w, 1), tx = MX_ROW_RORU(pw.x, 1), ty = MX_ROW_RORU(pw.y, 1), tz = MX_ROW_RORU(pw.z, 1), tw = MX_ROW_RORU(pw.w, 1);
          pw.x = tk ? sx : tx; pw.y = tk ? sy : ty; pw.z = tk ? sz : tz; pw.w = tk ? sw : tw; }
        const mx_f32x4 m0 = *(const MX_L mx_f32x4*)(par + 32 * ks + 8 * g), m1 = *(const MX_L mx_f32x4*)(par + 32 * ks + 8 * g + 4);
        float x[8];
        x[0] = mx_lo(cw.x) + (mx_lo(pw.x) - mx_lo(cw.x)) * m0.x; x[1] = mx_hi(cw.x) + (mx_hi(pw.x) - mx_hi(cw.x)) * m0.y; x[2] = mx_lo(cw.y) + (mx_lo(pw.y) - mx_lo(cw.y)) * m0.z; x[3] = mx_hi(cw.y) + (mx_hi(pw.y) - mx_hi(cw.y)) * m0.w;
        x[4] = mx_lo(cw.z) + (mx_lo(pw.z) - mx_lo(cw.z)) * m1.x; x[5] = mx_hi(cw.z) + (mx_hi(pw.z) - mx_hi(cw.z)) * m1.y; x[6] = mx_lo(cw.w) + (mx_lo(pw.w) - mx_lo(cw.w)) * m1.z; x[7] = mx_hi(cw.w) + (mx_hi(pw.w) - mx_hi(cw.w)) * m1.w;
#pragma unroll
        for (int e = 0; e < 8; ++e) { if (ks < 2) x[e] = 2.f * MX_RCP(1.f + MX_EXP(-2.f * x[e])) - 1.f; else if (ks >= 4) x[e] = mx_sigmoid(x[e]); }
        const mx_bf16x8 bf = mx_frag8(x, x + 4);
#pragma unroll
        for (int ct = 0; ct < 4; ++ct) {
            if (ks < 2) accw[ct] = mx_mfma(*(const MX_L mx_bf16x8*)(lds + MX_LDS_WW + (16 * ct + tk) * MX_RS64 + (32 * ks + 8 * g) * 2), bf, accw[ct]);
            else if (ks < 4) acca[ct] = mx_mfma(*(const MX_L mx_bf16x8*)(lds + MX_LDS_WA + (16 * ct + tk) * MX_RS64 + (32 * (ks - 2) + 8 * g) * 2), bf, acca[ct]);
            else accg[ct] = mx_mfma(*(const MX_L mx_bf16x8*)(lds + MX_LDS_WG + (16 * ct + tk) * MX_RS128 + (32 * (ks - 4) + 8 * g) * 2), bf, accg[ct]);
        }
        MX_SCHED();
    }
    float lw[16], a[16], b[16], k2[16], r[16], v[16];
    {
        float zc[16], zp[16], pr[16];
        mx_load_parL(par + MX_P_A0, g, pr);
#pragma unroll
        for (int i = 0; i < 16; ++i) b[i] = mx_sigmoid(pr[i] + acca[i >> 2][i & 3]);
        mx_unpack16(kc, zc); mx_unpack16(mx_raw_prev(kc, kt_, tk, 1), zp); mx_load_parL(par + MX_P_MUK, g, pr);
#pragma unroll
        for (int i = 0; i < 16; ++i) k2[i] = zc[i] + (zp[i] - zc[i]) * pr[i];
        mx_load_parL(par + MX_P_KK, g, pr);
        float ss = 0.f;
#pragma unroll
        for (int i = 0; i < 16; ++i) { a[i] = k2[i] * pr[i]; ss += a[i] * a[i]; }
        ss = mx_rowsum4(ss);
        const float rn = MX_RSQ(ss + 1e-6f);
        mx_load_parL(par + MX_P_KA, g, pr);
#pragma unroll
        for (int i = 0; i < 16; ++i) { const float kk = a[i] * rn, ic = b[i]; b[i] = kk * ic; a[i] = -kk; k2[i] = k2[i] * (1.f + (ic - 1.f) * pr[i]); }
    }
    MX_SCHED();
    float bs = 0.f;
    {
        float zc[16], zp[16], pr[16];
        mx_unpack16(rc, zc); mx_unpack16(mx_raw_prev(rc, rt_, tk, 1), zp); mx_load_parL(par + MX_P_MUR, g, pr);
#pragma unroll
        for (int i = 0; i < 16; ++i) r[i] = zc[i] + (zp[i] - zc[i]) * pr[i];
        mx_load_parL(par + MX_P_RK, g, pr);
#pragma unroll
        for (int i = 0; i < 16; ++i) bs += r[i] * k2[i] * pr[i];
        bs = mx_rowsum4(bs);
    }
    MX_SCHED();
    {
        float zc[16], zp[16], pr[16];
        mx_unpack16(vc_, zc); mx_unpack16(mx_raw_prev(vc_, vt_, tk, 1), zp); mx_load_parL(par + MX_P_MUV, g, pr);
#pragma unroll
        for (int i = 0; i < 16; ++i) v[i] = zc[i] + (zp[i] - zc[i]) * pr[i];
        mx_load_parL(par + MX_P_LNW, g, pr);
#pragma unroll
        for (int i = 0; i < 16; ++i) zc[i] = accg[i >> 2][i & 3] * pr[i];
        mx_store_t16(gslot + MX_GB_GT, lane, zc);
        mx_load_parL(par + MX_P_LNB, g, pr);
#pragma unroll
        for (int i = 0; i < 16; ++i) zp[i] = (pr[i] + bs * v[i]) * accg[i >> 2][i & 3];
        mx_store_t16(gslot + MX_GB_EE, lane, zp);
    }
    MX_SCHED();
    {
        float pr[16];
        mx_load_parL(par + MX_P_W0, g, pr);
#pragma unroll
        for (int i = 0; i < 16; ++i) { const float u = pr[i] + accw[i >> 2][i & 3]; lw[i] = -0.60653065971263342f * mx_sigmoid(u); }
    }
    MX_SCHED();
    mx_prep_back(lw, a, b, k2, r, v, slot, gamp, midbar, lane);
}
MX_DEV void mx_prep_gdn(int l, int h, const MX_G unsigned short* zseq, int chunk, MX_L unsigned char* slot, MX_G unsigned char* gslot, MX_L unsigned char* gamp, bool midbar, const MX_L unsigned char* lds, int lane) {
    const int tk = lane & 15, g = lane >> 4, t = 16 * chunk + tk;
    const MX_G unsigned short* zrow = zseq + (size_t)t * ZP;
    const MX_L float* par = (const MX_L float*)(lds + MX_LDS_PAR);
    const MxRaw16 cq = mx_raw_t16(zrow + ZC_GD_Q + 64 * h, true, g), ck = mx_raw_t16(zrow + ZC_GD_K + 64 * h, true, g), cv = mx_raw_t16(zrow + ZC_GD_V + 64 * h, true, g);
    const MX_G unsigned short* ztail = zrow - (size_t)16 * ZP;
    const MxRaw16 tq = mx_raw_tail(ztail + ZC_GD_Q + 64 * h, 16 * chunk, tk, g), tk_ = mx_raw_tail(ztail + ZC_GD_K + 64 * h, 16 * chunk, tk, g), tv = mx_raw_tail(ztail + ZC_GD_V + 64 * h, 16 * chunk, tk, g);
    const MxRaw16 rg = mx_raw_t16(zrow + ZC_GD_G + 64 * h, true, g);
    const float bl = mx_lo((unsigned)zrow[ZC_GD_B + h]), al = mx_lo((unsigned)zrow[ZC_GD_A + h]);
    MX_SCHED();
    float q[16], k[16], v[16];
#pragma unroll
    for (int i = 0; i < 16; ++i) { q[i] = 0.f; k[i] = 0.f; v[i] = 0.f; }
#pragma unroll
    for (int d = 0; d < 4; ++d) {
        float x[16], w[16];
        if (d == 3) mx_unpack16(cq, x); else mx_unpack16(mx_raw_prev(cq, tq, tk, 3 - d), x);
        mx_load_parL(par + d * 192, g, w);
#pragma unroll
        for (int i = 0; i < 16; ++i) MX_FMAC(q[i], w[i], x[i]);
        if (d == 3) mx_unpack16(ck, x); else mx_unpack16(mx_raw_prev(ck, tk_, tk, 3 - d), x);
        mx_load_parL(par + d * 192 + 64, g, w);
#pragma unroll
        for (int i = 0; i < 16; ++i) MX_FMAC(k[i], w[i], x[i]);
        if (d == 3) mx_unpack16(cv, x); else mx_unpack16(mx_raw_prev(cv, tv, tk, 3 - d), x);
        mx_load_parL(par + d * 192 + 128, g, w);
#pragma unroll
        for (int i = 0; i < 16; ++i) MX_FMAC(v[i], w[i], x[i]);
        MX_SCHED();
    }
    float sq = 0.f, sk = 0.f;
#pragma unroll
    for (int i = 0; i < 16; ++i) { q[i] = q[i] * mx_sigmoid(q[i]); k[i] = k[i] * mx_sigmoid(k[i]); v[i] = v[i] * mx_sigmoid(v[i]); sq += q[i] * q[i]; sk += k[i] * k[i]; }
    sq = mx_rowsum4(sq); sk = mx_rowsum4(sk);
    const float rqn = 0.125f * MX_RSQ(sq + 1e-6f), rkn = MX_RSQ(sk + 1e-6f);
    const float beta = mx_sigmoid(bl);
    const float gl = -MX_EXP(MXIN(I_ALOG)[l * 4 + h]) * mx_softplus(al + MXIN(I_DTB)[l * 4 + h]);
    const float wb = -MX_EXP(gl) * beta;
    float lw[16], a[16], b[16];
#pragma unroll
    for (int i = 0; i < 16; ++i) { const float kn = k[i] * rkn; lw[i] = gl; a[i] = kn; b[i] = wb * kn; k[i] = kn; q[i] = q[i] * rqn; v[i] = beta * v[i]; }
    {
        float zg[16], pr[16], ee[16];
        mx_unpack16(rg, zg); mx_load_parL(par + MX_P_GNW, g, pr);
#pragma unroll
        for (int i = 0; i < 16; ++i) { zg[i] = pr[i] * (zg[i] * mx_sigmoid(zg[i])); ee[i] = 0.f; }
        mx_store_t16(gslot + MX_GB_GT, lane, zg); mx_store_t16(gslot + MX_GB_EE, lane, ee);
    }
    MX_SCHED();
    mx_prep_back(lw, a, b, k, q, v, slot, gamp, midbar, lane);
}
struct MxOps { mx_bf16x8 wa0, wa1, rt0, rt1; mx_u32x2 arb, ark, vc; mx_f32x4 u0; mx_f32x4 gm0, gm1, gm2, gm3; mx_u32x2 bh0, bh1, bh2, bh3, kh0, kh1, kh2, kh3; };
MX_DEV MxOps mx_scan_load(const MX_L unsigned char* slot, const MX_L unsigned char* gamp, int it, int lane) {
    const int g = lane >> 4;
    MxOps o;
    o.wa0 = *(const MX_L mx_bf16x8*)(slot + (unsigned)(MX_HB_WA + lane * 16)); o.wa1 = *(const MX_L mx_bf16x8*)(slot + (unsigned)(MX_HB_WA + 1024 + lane * 16));
    o.rt0 = *(const MX_L mx_bf16x8*)(slot + (unsigned)(MX_HB_RT + lane * 16)); o.rt1 = *(const MX_L mx_bf16x8*)(slot + (unsigned)(MX_HB_RT + 1024 + lane * 16));
    o.arb = *(const MX_L mx_u32x2*)(slot + (unsigned)(MX_HB_ARB + lane * 8)); o.ark = *(const MX_L mx_u32x2*)(slot + (unsigned)(MX_HB_ARK + lane * 8));
    o.vc = *(const MX_L mx_u32x2*)(slot + (unsigned)(MX_HB_VC + it * 512 + lane * 8));
    { const mx_u32x2 u = *(const MX_L mx_u32x2*)(slot + (unsigned)(MX_HB_U0 + it * 512 + lane * 8)); o.u0.x = mx_lo(u.x); o.u0.y = mx_hi(u.x); o.u0.z = mx_lo(u.y); o.u0.w = mx_hi(u.y); }
#define MX_LDJ(jt) do { o.gm##jt = *(const MX_L mx_f32x4*)(gamp + (unsigned)((16 * jt + 4 * g) * 4)); \
        o.bh##jt = *(const MX_L mx_u32x2*)(slot + (unsigned)(MX_HB_BH + jt * 512 + lane * 8)); o.kh##jt = *(const MX_L mx_u32x2*)(slot + (unsigned)(MX_HB_KH + jt * 512 + lane * 8)); } while (0)
    MX_LDJ(0); MX_LDJ(1); MX_LDJ(2); MX_LDJ(3);
#undef MX_LDJ
    return o;
}
MX_DEV mx_f32x4 mx_scan_compute(mx_f32x4 (&S)[4], const MxOps& o, int lane) {
    const int tk = lane & 15, g = lane >> 4;
    const mx_f32x4 z4 = mx_zero4();
    const mx_bf16x8 sb0 = mx_frag8v(S[0], S[1]), sb1 = mx_frag8v(S[2], S[3]);
    const mx_f32x4 U = mx_mfma(o.wa1, sb1, mx_mfma(o.wa0, sb0, o.u0));
    const mx_u32x2 ub = mx_frag4(U), vb = mx_frag4p(o.vc);
    mx_f32x4 Y = mx_mfma(o.rt1, sb1, mx_mfma(o.rt0, sb0, z4));
    Y = mx_mfma(mx_frag4p(o.ark), vb, mx_mfma(mx_frag4p(o.arb), ub, Y));
    S[0] = mx_mfma(mx_frag4p(o.kh0), vb, mx_mfma(mx_frag4p(o.bh0), ub, S[0] * o.gm0)); S[1] = mx_mfma(mx_frag4p(o.kh1), vb, mx_mfma(mx_frag4p(o.bh1), ub, S[1] * o.gm1));
    S[2] = mx_mfma(mx_frag4p(o.kh2), vb, mx_mfma(mx_frag4p(o.bh2), ub, S[2] * o.gm2)); S[3] = mx_mfma(mx_frag4p(o.kh3), vb, mx_mfma(mx_frag4p(o.bh3), ub, S[3] * o.gm3));
    mx_u32x2 selI = {0u, 0u};
    if ((tk >> 2) == g) { const unsigned one = (tk & 1) ? 0x3F800000u : 0x00003F80u; if ((tk & 3) >> 1) selI.y = one; else selI.x = one; }
    mx_f32x4 Yh, Yl;
#pragma unroll
    for (int e = 0; e < 4; ++e) { Yh[e] = __builtin_bit_cast(float, mx_bf(Y[e]) << 16); Yl[e] = Y[e] - Yh[e]; }
    return mx_mfma(mx_frag4(Yl), selI, mx_mfma(mx_frag4(Yh), selI, z4));
}
MX_DEV void mx_sequence(int l, int type, int h, const MX_G unsigned short* zseq, MX_G unsigned short* yseq  , int nchunks, MX_G unsigned char* gb  , MX_L unsigned char* lds, int wave,
                        int role, MX_G unsigned long long* xs, MX_G unsigned* flag, MX_G unsigned* tmo) {
    const int lane0 = mx_lane();
    {
        const int tid = wave * 64 + lane0;
        MX_L float* par = (MX_L float*)(lds + MX_LDS_PAR);
        if (type == 0) {
            const MX_G float* wup = MXIN(I_WUP) + l * 64 * 256 + 64 * h; const MX_G float* aup = MXIN(I_AUP) + l * 64 * 256 + 64 * h; const MX_G float* gup = MXIN(I_GUP) + l * 128 * 256 + 64 * h;
            for (int idx = tid; idx < 64 * 64; idx += 512) { const int ch = idx & 63, k = idx >> 6;
                *(MX_L unsigned short*)(lds + MX_LDS_WW + ch * MX_RS64 + k * 2) = (unsigned short)mx_bf(wup[k * 256 + ch]);
                *(MX_L unsigned short*)(lds + MX_LDS_WA + ch * MX_RS64 + k * 2) = (unsigned short)mx_bf(aup[k * 256 + ch]); }
            for (int idx = tid; idx < 64 * 128; idx += 512) { const int ch = idx & 63, k = idx >> 6;
                *(MX_L unsigned short*)(lds + MX_LDS_WG + ch * MX_RS128 + k * 2) = (unsigned short)mx_bf(gup[k * 256 + ch]); }
            const MX_G float* mu = MXIN(I_MU) + l * 1024;
            if (tid < 256) par[tid] = mu[ZC_RW_DW + tid];
            else if (tid < 448) { const int a = (tid - 256) >> 6, c = (tid - 256) & 63; par[tid] = mu[(a == 0 ? ZC_RW_R : (a == 1 ? ZC_RW_K : ZC_RW_V)) + 64 * h + c]; }
            if (tid < 448) { const int a = tid >> 6, c = tid & 63;
                const MX_G float* src = a == 0 ? MXIN(I_W0) : a == 1 ? MXIN(I_A0) : a == 2 ? MXIN(I_KK) : a == 3 ? MXIN(I_KA) : a == 4 ? MXIN(I_RK) : a == 5 ? MXIN(I_LNXW) : MXIN(I_LNXB);
                par[MX_P_W0 + tid] = src[l * 256 + 64 * h + c]; }
        } else {
            const MX_G float* cw = MXIN(I_CONV) + l * 4 * 768;
            for (int idx = tid; idx < 768; idx += 512) { const int d = idx / 192, a = (idx % 192) >> 6, c = idx & 63; par[idx] = cw[d * 768 + a * 256 + 64 * h + c]; }
            if (tid < 64) par[MX_P_GNW + tid] = MXIN(I_GNW)[l * 64 + tid];
        }
    }
    mx_wgsync();
    mx_f32x4 S[4];
#pragma unroll
    for (int jt = 0; jt < 4; ++jt) S[jt] = mx_zero4();
    MX_L float* st = (MX_L float*)(lds + MX_LDS_ST);
    typedef float mx_f32x2 __attribute__((ext_vector_type(2)));
    const int ngroups = nchunks / 8;
    for (int itr = role - 2; itr < ngroups; itr += 2) {
        int lane = lane0; MX_LAUNDER_V(lane);
        const int tk = lane & 15, g = lane >> 4;
        const bool scan_now = itr >= 0, more = itr + 2 < ngroups;
        const int par_c = (itr >> 1) & 1, par_n = ((itr + 2) >> 1) & 1;
        if (wave < 4 && scan_now) {
            MX_G unsigned char* gbp = gb + par_c * (8 * MX_GB_SLOT); MX_LAUNDER_S(gbp);
            const MX_L unsigned char* gamc = lds + MX_LDS_GAM + par_c * 2048;
            mx_f32x4 yk[8]; mx_u32x2 gtc[8], eec[8];
            if (itr > 0) {
                const unsigned want = 4u * (unsigned)itr;
                for (unsigned spins = 0;;) {
                    if ((unsigned)MX_UNIFORM(MX_FLAG_LOAD(flag)) >= want) break;
                    MX_SLEEP();
                    if (++spins > (1u << 20)) { if (lane == 0) MX_FLAG_STORE(tmo, 1u); break; }
                }
#pragma unroll
                for (int jt = 0; jt < 4; ++jt) { const MX_G unsigned long long* p = xs + (unsigned)(((wave * 4 + jt) * 64 + lane) * 2);
                    const unsigned long long a = MX_SC1_LOAD64(p), b = MX_SC1_LOAD64(p + 1);
                    mx_u32x4 w; w.x = (unsigned)a; w.y = (unsigned)(a >> 32); w.z = (unsigned)b; w.w = (unsigned)(b >> 32); S[jt] = __builtin_bit_cast(mx_f32x4, w); }
            }
            {
                MxOps oa = mx_scan_load(lds + MX_LDS_HB, gamc, wave, lane), ob;
#pragma unroll
                for (int c = 0; c < 8; c += 2) {
                    ob = mx_scan_load(lds + MX_LDS_HB + (c + 1) * MX_HB_SLOT, gamc + (c + 1) * 256, wave, lane);
                    MX_SCHED();
                    yk[c] = mx_scan_compute(S, oa, lane);
                    MX_SCHED();
                    if (c + 2 < 8) oa = mx_scan_load(lds + MX_LDS_HB + (c + 2) * MX_HB_SLOT, gamc + (c + 2) * 256, wave, lane);
                    MX_SCHED();
                    yk[c + 1] = mx_scan_compute(S, ob, lane);
                    MX_SCHED();
                }
            }
            if (itr + 1 < ngroups) {
#pragma unroll
                for (int jt = 0; jt < 4; ++jt) { MX_G unsigned long long* p = xs + (unsigned)(((wave * 4 + jt) * 64 + lane) * 2);
                    const mx_u32x4 w = __builtin_bit_cast(mx_u32x4, S[jt]);
                    MX_SC1_STORE64(p, (unsigned long long)w.x | ((unsigned long long)w.y << 32)); MX_SC1_STORE64(p + 1, (unsigned long long)w.z | ((unsigned long long)w.w << 32)); }
                MX_VMWAIT();
                if (lane == 0) MX_FLAG_ADD(flag, 1u);
            }
            unsigned pfw = 0u;
            if (more) {
                const MX_G unsigned short* zr = zseq + (size_t)(16 * (8 * (itr + 2) + 4 + wave) + tk) * ZP;
                if (type == 0) { pfw = *(const MX_G unsigned*)(zr + ZC_RW_DW + 64 * g); if (g < 3) pfw ^= *(const MX_G unsigned*)(zr + (g == 0 ? ZC_RW_R : (g == 1 ? ZC_RW_K : ZC_RW_V)) + 64 * h); }
                else { pfw = *(const MX_G unsigned*)(zr + (g == 0 ? ZC_GD_Q : (g == 1 ? ZC_GD_K : (g == 2 ? ZC_GD_V : ZC_GD_G))) + 64 * h); if (g == 0) pfw ^= *(const MX_G unsigned*)(zr + ZC_GD_B); }
            }
#pragma unroll
            for (int c = 0; c < 2; ++c) { const MX_G unsigned char* sl = gbp + c * MX_GB_SLOT;
                gtc[c] = *(const MX_G mx_u32x2*)(sl + (unsigned)(MX_GB_GT + wave * 512 + lane * 8)); eec[c] = *(const MX_G mx_u32x2*)(sl + (unsigned)(MX_GB_EE + wave * 512 + lane * 8)); }
#pragma unroll
            for (int c = 0; c < 8; ++c) {
                float s1 = (yk[c].x + yk[c].y) + (yk[c].z + yk[c].w), s2 = (yk[c].x * yk[c].x + yk[c].y * yk[c].y) + (yk[c].z * yk[c].z + yk[c].w * yk[c].w);
                s1 = mx_rowsum4(s1); s2 = mx_rowsum4(s2);
                if (g == 0) { mx_f32x2 p_; p_.x = s1; p_.y = s2; *(MX_L mx_f32x2*)(st + ((c * 4 + wave) * 16 + tk) * 2) = p_; }
            }
            MX_LDSWAIT(); mx_wgsync();
#pragma unroll
            for (int c = 2; c < 8; ++c) { const MX_G unsigned char* sl = gbp + c * MX_GB_SLOT;
                gtc[c] = *(const MX_G mx_u32x2*)(sl + (unsigned)(MX_GB_GT + wave * 512 + lane * 8)); eec[c] = *(const MX_G mx_u32x2*)(sl + (unsigned)(MX_GB_EE + wave * 512 + lane * 8)); }
#pragma unroll
            for (int c = 0; c < 8; ++c) {
                float s1 = 0.f, s2 = 0.f;
#pragma unroll
                for (int w = 0; w < 4; ++w) { const mx_f32x2 p_ = *(const MX_L mx_f32x2*)(st + ((c * 4 + w) * 16 + tk) * 2); s1 += p_.x; s2 += p_.y; }
                float mean, rstd;
                if (type == 0) { mean = s1 * (1.f / 64.f); const float var = fmaxf(s2 * (1.f / 64.f) - mean * mean, 0.f); rstd = MX_RSQ(var + 64e-5f); }
                else { mean = 0.f; rstd = MX_RSQ(s2 * (1.f / 64.f) + 1e-6f); }
                const float o0 = (yk[c].x - mean) * rstd * mx_lo(gtc[c].x) + mx_lo(eec[c].x), o1 = (yk[c].y - mean) * rstd * mx_hi(gtc[c].x) + mx_hi(eec[c].x);
                const float o2 = (yk[c].z - mean) * rstd * mx_lo(gtc[c].y) + mx_lo(eec[c].y), o3 = (yk[c].w - mean) * rstd * mx_hi(gtc[c].y) + mx_hi(eec[c].y);
                mx_u32x2 o; o.x = mx_pk2(o0, o1); o.y = mx_pk2(o2, o3);
                *(MX_G mx_u32x2*)(yseq + (size_t)(16 * (8 * itr + c) + tk) * DM + 16 * wave + 4 * g) = o;
            }
            MX_CONSUME(pfw);
        } else if (wave < 4) { mx_wgsync(); }
        MX_SCHED();
        if (more) {
            const int c = (wave < 4) ? wave + 4 : wave - 4;
            MX_G unsigned char* gbn = gb + par_n * (8 * MX_GB_SLOT) + c * MX_GB_SLOT; MX_LAUNDER_S(gbn);
            MX_L unsigned char* slot = lds + MX_LDS_HB + c * MX_HB_SLOT; MX_L unsigned char* gamn = lds + MX_LDS_GAM + par_n * 2048 + c * 256;
            if (type == 0) mx_prep_rwkv(l, h, zseq, 8 * (itr + 2) + c, slot, gbn, gamn, wave >= 4, lds, lane); else mx_prep_gdn(l, h, zseq, 8 * (itr + 2) + c, slot, gbn, gamn, wave >= 4, lds, lane);
        } else if (wave >= 4) { mx_wgsync(); }
        MX_VMWAIT(); MX_LDSWAIT(); mx_wgsync();
    }
}

MX_DEV void mx_attn_unit4(int kvh, int q0, const MX_G unsigned short* zseq  , MX_G unsigned short* yatt  ,
                          const MX_L float* btab_all  , float Mb, const float (&esink)[4]  , const float (&qkw)[16], MX_L unsigned char* vts  , int lane) {
    const int tk = lane & 15, g = lane >> 4;
    const mx_f32x4 z4 = mx_zero4();
    const MX_G unsigned short* qrow = zseq + (size_t)(q0 + tk) * ZP + ZC_AT_Q + 256 * kvh;
    mx_u32x4 qa = *(const MX_G mx_u32x4*)(qrow + 8 * g), qb = *(const MX_G mx_u32x4*)(qrow + 32 + 8 * g);
    mx_u32x4 kA[9], kB[9], vA[9], vB[9];
#pragma unroll
    for (int kt = 0; kt < 9; ++kt) {
        const int key0 = q0 - 128 + 16 * kt;
        if (key0 >= 0) {
            const MX_G unsigned short* krow = zseq + (size_t)(key0 + tk) * ZP + ZC_AT_K + 64 * kvh; const MX_G unsigned short* vrow = zseq + (size_t)(key0 + tk) * ZP + ZC_AT_V + 64 * kvh;
            kA[kt] = *(const MX_G mx_u32x4*)(krow + 8 * g); kB[kt] = *(const MX_G mx_u32x4*)(krow + 32 + 8 * g);
            const mx_u32x2 a_ = *(const MX_G mx_u32x2*)(vrow + 4 * g), b_ = *(const MX_G mx_u32x2*)(vrow + 16 + 4 * g), c_ = *(const MX_G mx_u32x2*)(vrow + 32 + 4 * g), d_ = *(const MX_G mx_u32x2*)(vrow + 48 + 4 * g);
            vA[kt].x = a_.x; vA[kt].y = a_.y; vA[kt].z = b_.x; vA[kt].w = b_.y; vB[kt].x = c_.x; vB[kt].y = c_.y; vB[kt].z = d_.x; vB[kt].w = d_.y;
        } else { const mx_u32x4 z_ = {0u, 0u, 0u, 0u}; kA[kt] = z_; kB[kt] = z_; vA[kt] = z_; vB[kt] = z_; }
    }
    MX_SCHED();
    mx_bf16x8 Sel[2];
#pragma unroll
    for (int p = 0; p < 2; ++p) { mx_u32x4 w = {0u, 0u, 0u, 0u};
        if ((tk >> 2) == g) { const unsigned one = (tk & 1) ? 0x3F800000u : 0x00003F80u; const int q = 2 * p + ((tk & 3) >> 1); w.x = (q == 0) ? one : 0u; w.y = (q == 1) ? one : 0u; w.z = (q == 2) ? one : 0u; w.w = (q == 3) ? one : 0u; }
        Sel[p] = __builtin_bit_cast(mx_bf16x8, w); }
    float rk[9];
#pragma unroll
    for (int kt = 0; kt < 9; ++kt) {
        float ssk = 0.f;
        { const unsigned kk[8] = {kA[kt].x, kA[kt].y, kA[kt].z, kA[kt].w, kB[kt].x, kB[kt].y, kB[kt].z, kB[kt].w};
#pragma unroll
          for (int i = 0; i < 8; ++i) { const float a = mx_lo(kk[i]), b = mx_hi(kk[i]); ssk += a * a + b * b; } }
        rk[kt] = MX_RSQ(mx_rowsum4(ssk) * (1.f / 64.f) + 1e-6f);
#pragma unroll
        for (int dt = 0; dt < 4; ++dt) *(MX_L mx_u32x2*)(vts + (unsigned)(((kt * 4 + dt) * 64 + lane) * 8)) = mx_pack4(mx_mfma(__builtin_bit_cast(mx_bf16x8, (dt >> 1) ? vB[kt] : vA[kt]), Sel[dt & 1], z4));
    }
    MX_LDSWAIT(); MX_SCHED();
    for (int hh = 0; hh < 4; ++hh) {
        const int h = 4 * kvh + hh;
        const mx_u32x4 cqa = qa, cqb = qb;
        if (hh < 3) { qa = *(const MX_G mx_u32x4*)(qrow + 64 * (hh + 1) + 8 * g); qb = *(const MX_G mx_u32x4*)(qrow + 64 * (hh + 1) + 32 + 8 * g); }
        const MX_L float* btab = btab_all + 128 * h;
        mx_bf16x8 QF[2];
        {
            float q[16]; float ss = 0.f;
            q[0] = mx_lo(cqa.x); q[1] = mx_hi(cqa.x); q[2] = mx_lo(cqa.y); q[3] = mx_hi(cqa.y); q[4] = mx_lo(cqa.z); q[5] = mx_hi(cqa.z); q[6] = mx_lo(cqa.w); q[7] = mx_hi(cqa.w);
            q[8] = mx_lo(cqb.x); q[9] = mx_hi(cqb.x); q[10] = mx_lo(cqb.y); q[11] = mx_hi(cqb.y); q[12] = mx_lo(cqb.z); q[13] = mx_hi(cqb.z); q[14] = mx_lo(cqb.w); q[15] = mx_hi(cqb.w);
#pragma unroll
            for (int i = 0; i < 16; ++i) ss += q[i] * q[i];
            ss = mx_rowsum4(ss);
            const float rs = MX_RSQ(ss * (1.f / 64.f) + 1e-6f);
#pragma unroll
            for (int i = 0; i < 16; ++i) q[i] = q[i] * rs * qkw[i];
            QF[0] = mx_frag8(q, q + 4); QF[1] = mx_frag8(q + 8, q + 12);
        }
        mx_f32x4 O[4];
#pragma unroll
        for (int dt = 0; dt < 4; ++dt) O[dt] = z4;
        float lsum = 0.f;
#pragma unroll
        for (int kt = 0; kt < 9; ++kt) {
            const int key0 = q0 - 128 + 16 * kt;
            const mx_f32x4 S = mx_mfma(__builtin_bit_cast(mx_bf16x8, kB[kt]), QF[1], mx_mfma(__builtin_bit_cast(mx_bf16x8, kA[kt]), QF[0], z4));
            mx_f32x4 P;
#pragma unroll
            for (int e = 0; e < 4; ++e) {
                const float rke = mx_shfl16l(rk[kt], 4 * g + e, lane);
                const int dist = (q0 + tk) - (key0 + 4 * g + e); const bool valid = (dist >= 0) && (dist < 128) && (key0 >= 0);
                float ex = MX_EXP(S[e] * rke + btab[dist & 127] - Mb); MX_LAUNDER_V(ex);
                P[e] = valid ? ex : 0.f; lsum += P[e];
            }
            const mx_u32x2 pf = mx_frag4(P);
#pragma unroll
            for (int dt = 0; dt < 4; ++dt) O[dt] = mx_mfma(mx_frag4p(*(const MX_L mx_u32x2*)(vts + (unsigned)(((kt * 4 + dt) * 64 + lane) * 8))), pf, O[dt]);
        }
        lsum = mx_rowsum4(lsum);
        const float inv = MX_RCP(lsum + esink[hh]);
        MX_G unsigned short* yrow = yatt + (size_t)(q0 + tk) * DM + 64 * h;
#pragma unroll
        for (int dt = 0; dt < 4; ++dt) { mx_u32x2 o; o.x = mx_pk2(O[dt].x * inv, O[dt].y * inv); o.y = mx_pk2(O[dt].z * inv, O[dt].w * inv); *(MX_G mx_u32x2*)(yrow + 16 * dt + 4 * g) = o; }
    }
}

__device__ __forceinline__ float wave_allmax(float v) {
    v = fmaxf(v, dppf(v, 0)); v = fmaxf(v, dppf(v, 1)); v = fmaxf(v, dppf(v, 2)); v = fmaxf(v, dppf(v, 3));
    const float a = __builtin_bit_cast(float, __builtin_amdgcn_readlane(__builtin_bit_cast(int, v), 0)), b = __builtin_bit_cast(float, __builtin_amdgcn_readlane(__builtin_bit_cast(int, v), 16));
    const float c = __builtin_bit_cast(float, __builtin_amdgcn_readlane(__builtin_bit_cast(int, v), 32)), d = __builtin_bit_cast(float, __builtin_amdgcn_readlane(__builtin_bit_cast(int, v), 48));
    return fmaxf(fmaxf(a, b), fmaxf(c, d));
}
__device__ __forceinline__ void mixer_phase(Frame& F, int l) {
    const int blk = blockIdx.x;
    {
        const int lane = ltid() & 63;
        const LAS float* btab_all = (const LAS float*)(F.lds + BIAS_OFF);
        float mb = 0.f;
#pragma unroll
        for (int i = 0; i < 16; ++i) mb = fmaxf(mb, fabsf(btab_all[lane + 64 * i]));
        const float Mb = 8.f * wave_allmax(fabsf(MXIN(I_QNW)[l * 64 + lane])) * wave_allmax(fabsf(MXIN(I_KNW)[l * 64 + lane])) + wave_allmax(mb);
        const int pair = blk >> 3, seg = blk & 7, b = pair >> 1, kvh = pair & 1;
        float esink[4];
#pragma unroll
        for (int hh = 0; hh < 4; ++hh) esink[hh] = __expf(MXIN(I_SINK)[l * 8 + 4 * kvh + hh] - Mb);
        float qkw[16];
#pragma unroll
        for (int i = 0; i < 16; ++i) { const int d = 32 * (i >> 3) + 8 * (lane >> 4) + (i & 7); qkw[i] = 0.125f * MXIN(I_QNW)[l * 64 + d] * MXIN(I_KNW)[l * 64 + d]; }
        const MX_G unsigned short* zseq = (const MX_G unsigned short*)FZ + (size_t)b * SEQ * ZP;
        MX_G unsigned short* yatt = (MX_G unsigned short*)FY + (size_t)b * SEQ * DM + 512;
        for (int i = 0; i < 2; ++i) {
            const int qt = 16 * seg + F.wave + 8 * i;
            int ln = lane; MX_LAUNDER_V(ln);
            mx_attn_unit4(kvh, 16 * qt, zseq, yatt, btab_all, Mb, esink, qkw, F.lds + RING_OFF + F.wave * 18432, ln);
        }
    }
    __syncthreads();
    {
        const int seq = blk & 127, role = blk >> 7, type = seq >> 6, bh = seq & 63, b = bh >> 2, h = bh & 3;
        const MX_G unsigned short* zseq = (const MX_G unsigned short*)FZ + (size_t)b * SEQ * ZP;
        MX_G unsigned short* yseq = (MX_G unsigned short*)FY + (size_t)b * SEQ * DM + type * 256 + 64 * h;
        MX_G unsigned* ctlw = (MX_G unsigned*)WSP(WS_CTL);
        mx_sequence(l, type, h, zseq, yseq, SEQ / 16, (MX_G unsigned char*)WSP(WS_HB) + (size_t)blk * (2 * 8 * MX_GB_SLOT), F.lds + RING_OFF, F.wave,
                    role, (MX_G unsigned long long*)WSP(WS_XS) + (size_t)seq * 2048, ctlw + CW_SEQ + (l * 128 + seq) * 64, ctlw + CW_TMO);
    }
}
constexpr int PH_PER_L = 5, NPH = 1 + DEPTH * PH_PER_L;
struct Args { const float* in[26]; float* out; unsigned char* ws; int ph_lo, ph_hi; };
__global__ void __launch_bounds__(NWAVES * 64, 2) fwd(Args args) {
    extern __shared__ __attribute__((aligned(16))) unsigned char lds[];
    Frame F;
    F.lds = (LAS unsigned char*)lds;
    const int tid0 = threadIdx.x; F.wave = __builtin_amdgcn_readfirstlane(tid0 >> 6);
    F.G = gridDim.x; { const int bx = blockIdx.x; F.vcu = (F.G % 8 == 0) ? (bx % 8) * (F.G / 8) + bx / 8 : bx; }
    F.ws = args.ws; F.out = args.out;
    for (int u = tid0; u < (BIAS_OFF - LDSCTL_OFF) / 4; u += NWAVES * 64) ((LAS unsigned*)(F.lds + LDSCTL_OFF))[u] = 0u;
    for (int u = tid0; u < 8 * 128; u += NWAVES * 64) {
        const int h = u >> 7, d = u & 127;
        int bucket;
        if (d < 16) bucket = d;
        else { int lg = 16 + (int)(logf((float)d / 16.f) / logf(8.f) * 16.f); bucket = lg < 31 ? lg : 31; }
        ((LAS float*)(F.lds + BIAS_OFF))[u] = INP(I_RELB)[bucket * 8 + h];
    }
    __syncthreads();
    const int lo = args.ph_lo, hi = args.ph_hi;
    const bool one = (hi - lo) > 1;
    XcdBarrier bar; bar.bar = (unsigned*)(F.ws + WS_CTL) + CW_BAR; bar.x = 0; bar.st = nullptr;
    if (one) bar = xcd_barrier_post((unsigned*)(F.ws + WS_CTL) + CW_BAR, (volatile LAS unsigned*)(F.lds + MISC_OFF) + 8, tid0 == 0);
#define IN(k) (lo <= (k) && (k) < hi)
#define SEAM(k) do { if (IN(k) && IN((k) + 1)) { XcdBarrier b2_ = bar; asm volatile("" : "+s"(b2_.bar)); xcd_barrier(b2_, F.wave == 0 && hw_lane() == 0); } } while (0)

    #ifndef DIS_PRO
    if (IN(0)) { p0_prologue(F); SEAM(0); }
#endif
    for (int l = 0; l < DEPTH; ++l) {
        const int pb = 1 + PH_PER_L * l;
        if (IN(pb + 0)) {
            pg8::Gemm g{FXN, ((bf16*)WSP(WS_WIN)) + (size_t)l * ZP * DM, M, ZP, DM}; pg8::StaticOrder S; S.init(M, ZP, F.G, (int)blockIdx.x);
            pg8::EpiBf16<0> E{FZ, ZP, (const float*)WSP(WS_RSS) + (size_t)(2 * l) * M * 16};
            pg8::gemm_phase<pg8::EpiBf16<0>, pg8::StaticOrder, true, true>(F.lds + RING_OFF, g, S, E, F.wave);
            SEAM(pb + 0);
        }
        if (IN(pb + 1)) { mixer_phase(F, l); SEAM(pb + 1); }
        if (IN(pb + 2)) {
            pg8::Gemm g{FY, ((bf16*)WSP(WS_WOUT)) + (size_t)l * DM * DM, M, DM, DM}; pg8::StaticOrder S; S.init(M, DM, F.G, (int)blockIdx.x);
            pg8::EpiResF32 E{l == 0 ? INP(I_X) : F.out, F.out, DM, FXN, (float*)WSP(WS_RSS) + (size_t)(2 * l + 1) * M * 16};
            pg8::gemm_phase<pg8::EpiResF32, pg8::StaticOrder, true, true>(F.lds + RING_OFF, g, S, E, F.wave);
            SEAM(pb + 2);
        }
        if (IN(pb + 3)) {
            pg8::Gemm g{FXN, ((bf16*)WSP(WS_W1)) + (size_t)l * DFF * DM, M, DFF, DM}; pg8::StaticOrder S; S.init(M, DFF, F.G, (int)blockIdx.x);
            pg8::EpiBf16<2> E{FH, DFF, (const float*)WSP(WS_RSS) + (size_t)(2 * l + 1) * M * 16};
            pg8::gemm_phase<pg8::EpiBf16<2>, pg8::StaticOrder, true, true>(F.lds + RING_OFF, g, S, E, F.wave);
            SEAM(pb + 3);
        }
        if (IN(pb + 4)) {
            pg8::Gemm g{FH, ((bf16*)WSP(WS_W2)) + (size_t)l * DM * DFF, M, DM, DFF}; pg8::StaticOrder S; S.init(M, DM, F.G, (int)blockIdx.x);
            pg8::EpiResF32 E{F.out, F.out, DM, l + 1 < DEPTH ? FXN : (bf16*)nullptr, l + 1 < DEPTH ? (float*)WSP(WS_RSS) + (size_t)(2 * l + 2) * M * 16 : (float*)nullptr};
            pg8::gemm_phase<pg8::EpiResF32, pg8::StaticOrder, true, true>(F.lds + RING_OFF, g, S, E, F.wave);
            SEAM(pb + 4);
        }
    }
#undef IN
#undef SEAM
}

#ifndef MK_ONE_LAUNCH
#define MK_ONE_LAUNCH 1
#endif
extern "C" void kernel_launch(void* const* d_in, const int* in_sizes, int n_in, void* d_out, int out_size, void* d_ws, size_t ws_size, hipStream_t stream) {
    static int grid = 0;
    if (grid == 0) {
        if (n_in != 26 || in_sizes[0] != M * DM || out_size != M * DM || ws_size < WS_END) { fprintf(stderr, "kernel_launch: unexpected shapes (n_in %d, in0 %d, out %d, ws %zu, need %zu)\n", n_in, n_in > 0 ? in_sizes[0] : -1, out_size, ws_size, (size_t)WS_END); grid = -1; return; }
        int dev = 0, cus = 0, per_cu = 0;
        if (hipGetDevice(&dev) != hipSuccess || hipDeviceGetAttribute(&cus, hipDeviceAttributeMultiprocessorCount, dev) != hipSuccess) { grid = -1; return; }
        if (hipFuncSetAttribute((const void*)fwd, hipFuncAttributeMaxDynamicSharedMemorySize, LDS_BYTES) != hipSuccess) { fprintf(stderr, "kernel_launch: hipFuncSetAttribute failed\n"); grid = -1; return; }
        if (hipOccupancyMaxActiveBlocksPerMultiprocessor(&per_cu, (const void*)fwd, NWAVES * 64, LDS_BYTES) != hipSuccess || per_cu < 1) fprintf(stderr, "kernel_launch: occupancy query reports %d\n", per_cu);
        (void)hipGetLastError();
        grid = cus;
    }
    if (grid < 0) return;
    if (hipMemsetAsync((char*)d_ws + WS_CTL, 0, CTL_ZERO_BYTES, stream) != hipSuccess) return;
    Args a{};
    for (int i = 0; i < 26; ++i) a.in[i] = (const float*)d_in[i];
    a.out = (float*)d_out; a.ws = (unsigned char*)d_ws;
#if MK_ONE_LAUNCH
    a.ph_lo = 0; a.ph_hi = NPH;
    hipLaunchKernelGGL(fwd, dim3(grid), dim3(NWAVES * 64), LDS_BYTES, stream, a);
#else
    for (int ph = 0; ph < NPH; ++ph) {
        a.ph_lo = ph; a.ph_hi = ph + 1;
        hipLaunchKernelGGL(fwd, dim3(grid), dim3(NWAVES * 64), LDS_BYTES, stream, a);
    }
#endif
}
```

```cpp
#include <hip/hip_runtime.h>
#include <cstdio>
#include <cstdint>
#include <cmath>
#include <type_traits>
__device__ __forceinline__ int hwl_() { int t; asm volatile("v_mbcnt_lo_u32_b32 %0, -1, 0\n\tv_mbcnt_hi_u32_b32 %0, -1, %0" : "=v"(t)); return t; }
__device__ __forceinline__ float xor16f(float v) { return __builtin_bit_cast(float, __builtin_amdgcn_ds_swizzle(__builtin_bit_cast(int, v), 0x401F)); }
__device__ __forceinline__ float xor32f(float v) { return __builtin_bit_cast(float, __builtin_amdgcn_ds_bpermute((hwl_() ^ 32) << 2, __builtin_bit_cast(int, v))); }
namespace pg8 {
#define PG8_LAS __attribute__((address_space(3)))
typedef unsigned short bf16_t;
typedef short bf16x8 __attribute__((ext_vector_type(8)));
typedef float f32x4 __attribute__((ext_vector_type(4)));
typedef unsigned u32x4 __attribute__((ext_vector_type(4)));
constexpr int BM = 256, BK = 64, HALF = 128, HTB = HALF * BK * 2  , STAGE_BYTES = 8 * HTB, NXCD = 8, WGM = 8;

__host__ __device__ __forceinline__ int lds_byte(int r, int c) { const int st = (r >> 4) * 2 + (c >> 5), rr = r & 15, cc = c & 31, ob = rr * 64 + cc * 2; return st * 1024 + (ob ^ (((ob >> 9) & 1) << 5)); }
__host__ __device__ __forceinline__ void stage_rc(int b, int& R, int& C) { const int st = b / 1024, sb = b % 1024, swz = sb ^ (((sb >> 9) & 1) << 5); R = (st >> 1) * 16 + swz / 64; C = (st & 1) * 32 + (swz % 64) / 2; }
__host__ __device__ __forceinline__ int perm32(int rho) { const int n = rho >> 4, i = rho & 15; return 8 * (i >> 2) + 4 * n + (i & 3); }

struct Unit { int pm, pn; };
struct Gemm { const bf16_t* A; const bf16_t* Bt; int M, N, K; };

struct StaticOrder {
    int nM, nN, nwg, G, c;
    __host__ __device__ void init(int M, int N, int G_, int c_) { nM = M / BM; nN = N / BM; nwg = nM * nN; G = G_; c = c_; }
    __host__ __device__ bool next(int i, Unit& u) const {
        const long L = (long)i * G + c; if (L >= nwg) return false;
        int wgid = (int)L; { const int q = nwg / NXCD, r = nwg % NXCD, xcd = wgid % NXCD, off = wgid / NXCD; wgid = (xcd < r ? xcd * (q + 1) : r * (q + 1) + (xcd - r) * q) + off; }
        const int nig = WGM * nN, gid = wgid / nig, fm = gid * WGM, gsz = (nM - fm) < WGM ? (nM - fm) : WGM;
        u.pm = fm + ((wgid % nig) % gsz); u.pn = (wgid % nig) / gsz; return true;
    }
    __device__ __forceinline__ void a_ready(const Unit&) const {}
    __device__ __forceinline__ void done(const Unit&) const {}
};

__device__ __forceinline__ unsigned cvt_pk_bf16(float lo, float hi) { unsigned r; asm volatile("v_cvt_pk_bf16_f32 %0, %1, %2" : "=v"(r) : "v"(lo), "v"(hi)); return r; }
template <int ACT  > struct EpiBf16 {
    static constexpr bool PERM = true, AFTER_DRAIN = false;
    static constexpr int NST = 16;
    bf16_t* O; int ldc; const float* rss;
    __device__ __forceinline__ void operator()(const f32x4 (&acc)[2][2][4][2], const Unit& u, int wr, int wc, int fr, int fq) const {
        const int row0 = u.pm * BM + wr * 64 + fr, col0 = u.pn * BM + wc * 32 + 8 * fq;
#pragma unroll
        for (int ai = 0; ai < 2; ++ai)
#pragma unroll
            for (int m = 0; m < 4; ++m) { const int row = row0 + ai * HALF + m * 16; bf16_t* rowp = O + (size_t)row * ldc + col0;
                f32x4 pr = *(const f32x4*)(rss + (size_t)row * 16 + 4 * fq); float ssum = (pr[0] + pr[1]) + (pr[2] + pr[3]);
                ssum += ::xor16f(ssum); ssum += ::xor32f(ssum);
                const float rs = __builtin_amdgcn_rsqf(ssum * (1.f / 1024.f) + 1e-6f);
#pragma unroll
                for (int bj = 0; bj < 2; ++bj) { f32x4 v0 = acc[ai][bj][m][0] * rs, v1 = acc[ai][bj][m][1] * rs;
                    if (ACT == 2) {
#pragma unroll
                        for (int e = 0; e < 4; ++e) { const float a = v0[e] > 0.f ? v0[e] : 0.f, b = v1[e] > 0.f ? v1[e] : 0.f; v0[e] = a * a; v1[e] = b * b; } }
                    u32x4 w; w.x = cvt_pk_bf16(v0[0], v0[1]); w.y = cvt_pk_bf16(v0[2], v0[3]); w.z = cvt_pk_bf16(v1[0], v1[1]); w.w = cvt_pk_bf16(v1[2], v1[3]);
                    *(u32x4*)(rowp + bj * HALF) = w; } }
    }
};
struct EpiResF32 {
    static constexpr bool PERM = true, AFTER_DRAIN = false;
    static constexpr int NST = 16;
    const float* base; float* out; int ldc; bf16_t* xn; float* rss;
    __device__ __forceinline__ void operator()(const f32x4 (&acc)[2][2][4][2], const Unit& u, int wr, int wc, int fr, int fq) const {
        const int row0 = u.pm * BM + wr * 64 + fr, col0 = u.pn * BM + wc * 32 + 8 * fq;
#pragma unroll
        for (int ai = 0; ai < 2; ++ai)
#pragma unroll
            for (int m = 0; m < 4; ++m) { const int row = row0 + ai * HALF + m * 16; const size_t off = (size_t)row * ldc + col0; float ss = 0.f;
#pragma unroll
                for (int bj = 0; bj < 2; ++bj) {
                    const f32x4 b0 = *(const f32x4*)(base + off + bj * HALF), b1 = *(const f32x4*)(base + off + bj * HALF + 4);
                    const f32x4 o0 = b0 + acc[ai][bj][m][0], o1 = b1 + acc[ai][bj][m][1];
                    *(f32x4*)(out + off + bj * HALF) = o0; *(f32x4*)(out + off + bj * HALF + 4) = o1;
                    if (xn) { u32x4 w; w.x = cvt_pk_bf16(o0[0], o0[1]); w.y = cvt_pk_bf16(o0[2], o0[3]); w.z = cvt_pk_bf16(o1[0], o1[1]); w.w = cvt_pk_bf16(o1[2], o1[3]); *(u32x4*)(xn + off + bj * HALF) = w;
                        ss += ((o0[0] * o0[0] + o0[1] * o0[1]) + (o0[2] * o0[2] + o0[3] * o0[3])) + ((o1[0] * o1[0] + o1[1] * o1[1]) + (o1[2] * o1[2] + o1[3] * o1[3])); } }
                if (xn) { ss += ::xor16f(ss); ss += ::xor32f(ss); if (fq == 0) rss[(size_t)row * 16 + 4 * u.pn + wc] = ss; } }
    }
};

struct EpiResBf16 {
    static constexpr bool PERM = true, AFTER_DRAIN = false;
    static constexpr int NST = 32;
    bf16_t* x; int ldc; float* outf; float* rss;
    __device__ __forceinline__ void operator()(const f32x4 (&acc)[2][2][4][2], const Unit& u, int wr, int wc, int fr, int fq) const {
        const int row0 = u.pm * BM + wr * 64 + fr, col0 = u.pn * BM + wc * 32 + 8 * fq;
#pragma unroll
        for (int ai = 0; ai < 2; ++ai)
#pragma unroll
            for (int m = 0; m < 4; ++m) { const int row = row0 + ai * HALF + m * 16; const size_t off = (size_t)row * ldc + col0; float ss = 0.f;
#pragma unroll
                for (int bj = 0; bj < 2; ++bj) {
                    const u32x4 b = *(const u32x4*)(x + off + bj * HALF);
                    f32x4 o0, o1;
                    o0[0] = __builtin_bit_cast(float, b.x << 16) + acc[ai][bj][m][0][0]; o0[1] = __builtin_bit_cast(float, b.x & 0xffff0000u) + acc[ai][bj][m][0][1];
                    o0[2] = __builtin_bit_cast(float, b.y << 16) + acc[ai][bj][m][0][2]; o0[3] = __builtin_bit_cast(float, b.y & 0xffff0000u) + acc[ai][bj][m][0][3];
                    o1[0] = __builtin_bit_cast(float, b.z << 16) + acc[ai][bj][m][1][0]; o1[1] = __builtin_bit_cast(float, b.z & 0xffff0000u) + acc[ai][bj][m][1][1];
                    o1[2] = __builtin_bit_cast(float, b.w << 16) + acc[ai][bj][m][1][2]; o1[3] = __builtin_bit_cast(float, b.w & 0xffff0000u) + acc[ai][bj][m][1][3];
                    if (outf) { *(f32x4*)(outf + off + bj * HALF) = o0; *(f32x4*)(outf + off + bj * HALF + 4) = o1; }
                    else { u32x4 w; w.x = cvt_pk_bf16(o0[0], o0[1]); w.y = cvt_pk_bf16(o0[2], o0[3]); w.z = cvt_pk_bf16(o1[0], o1[1]); w.w = cvt_pk_bf16(o1[2], o1[3]); *(u32x4*)(x + off + bj * HALF) = w;
                        ss += ((o0[0] * o0[0] + o0[1] * o0[1]) + (o0[2] * o0[2] + o0[3] * o0[3])) + ((o1[0] * o1[0] + o1[1] * o1[1]) + (o1[2] * o1[2] + o1[3] * o1[3])); } }
                if (!outf) { ss += ::xor16f(ss); ss += ::xor32f(ss); if (fq == 0) rss[(size_t)row * 16 + 4 * u.pn + wc] = ss; } }
    }
};
template <class Epi, class Sched, bool ALIGN_EPI = false, bool SP2 = false>
__device__ __forceinline__ void gemm_phase(PG8_LAS unsigned char* lds, const Gemm g, const Sched& S, const Epi& E, const int wave_id  ) {
    int tid_l = wave_id * 64 + ::hwl_();
    const int tid = tid_l, wid = __builtin_amdgcn_readfirstlane(tid >> 6), lane = tid & 63, wr = wid >> 2, wc = wid & 3, fr = lane & 15, fq = lane >> 4;
    const int K = g.K, nt = K / BK;
    unsigned voffA[2], voffB[2];
#pragma unroll
    for (int i = 0; i < 2; ++i) { int R, C; stage_rc(tid * 16 + i * 8192, R, C); const int Rb = Epi::PERM ? ((R & ~31) + perm32(R & 31)) : R;
        voffA[i] = (unsigned)(R * K + C) * 2u; voffB[i] = (unsigned)(Rb * K + C) * 2u; }
    const size_t kstep = (size_t)(BK * 2);
    const size_t hstep = (size_t)HALF * K * 2;
    const size_t tstep = 2 * hstep;
    const unsigned ldsw = (unsigned)wid * 1024u;
    const int aoff = lds_byte(wr * 64 + fr, fq * 8), boff = lds_byte(wc * 32 + fr, fq * 8);
#define PG8_SA(b, h) (((b) * 2 + (h)) * HTB)
#define PG8_SB(b, h) ((4 + (b) * 2 + (h)) * HTB)
#define PG8_STAGE(bufoff, gbase, voff) do { _Pragma("unroll") for (int _i = 0; _i < 2; ++_i) \
        __builtin_amdgcn_global_load_lds((const unsigned*)((const char*)(gbase) + (voff)[_i]), (PG8_LAS unsigned*)(lds + (bufoff) + ldsw + _i * 8192), 16, 0, 0); } while (0)
#define PG8_LDA(dst, b, h) do { _Pragma("unroll") for (int m = 0; m < 4; ++m) _Pragma("unroll") for (int k = 0; k < 2; ++k) dst[m][k] = *(const PG8_LAS bf16x8*)(lds + PG8_SA(b, h) + aoff + m * 2048 + k * 1024); } while (0)
#define PG8_LDB(dst, b, h) do { _Pragma("unroll") for (int n = 0; n < 2; ++n) _Pragma("unroll") for (int k = 0; k < 2; ++k) dst[n][k] = *(const PG8_LAS bf16x8*)(lds + PG8_SB(b, h) + boff + n * 2048 + k * 1024); } while (0)
#define PG8_MMA(ai, bj, At, Bt) do { __builtin_amdgcn_s_setprio(1); _Pragma("unroll") for (int m = 0; m < 4; ++m) _Pragma("unroll") for (int n = 0; n < 2; ++n) _Pragma("unroll") for (int k = 0; k < 2; ++k) \
        acc[ai][bj][m][n] = __builtin_amdgcn_mfma_f32_16x16x32_bf16(Bt[n][k], At[m][k], acc[ai][bj][m][n], 0, 0, 0); __builtin_amdgcn_s_setprio(0); } while (0)
#define PG8_WAIT_V(n) asm volatile("s_waitcnt vmcnt(" #n ")" ::: "memory")
#define PG8_WAIT_L(n) asm volatile("s_waitcnt lgkmcnt(" #n ")" ::: "memory")
#define PG8_BAR __builtin_amdgcn_s_barrier()
#define PG8_SCHED __builtin_amdgcn_sched_barrier(0)
    Unit cur, nxt; int ui = 0;
    if (!S.next(0, cur)) return;
    f32x4 acc[2][2][4][2];
#pragma unroll
    for (int a = 0; a < 2; ++a)
#pragma unroll
        for (int b = 0; b < 2; ++b)
#pragma unroll
            for (int m = 0; m < 4; ++m)
#pragma unroll
                for (int n = 0; n < 2; ++n) acc[a][b][m][n] = (f32x4){0.f, 0.f, 0.f, 0.f};
    bf16x8 At[4][2], B0[2][2], B1[2][2];
    const char* cA = (const char*)g.A + (size_t)cur.pm * tstep; const char* cB = (const char*)g.Bt + (size_t)cur.pn * tstep;
    S.a_ready(cur);
    if constexpr (SP2) {
        PG8_STAGE(PG8_SB(0, 0), cB, voffB); PG8_STAGE(PG8_SB(0, 1), cB + hstep, voffB); PG8_STAGE(PG8_SA(0, 0), cA, voffA); PG8_STAGE(PG8_SA(0, 1), cA + hstep, voffA);
        if (wr == 1) PG8_BAR;
        PG8_WAIT_V(2); PG8_BAR;
        PG8_STAGE(PG8_SB(1, 0), cB + kstep, voffB); PG8_STAGE(PG8_SA(1, 0), cA + kstep, voffA); PG8_STAGE(PG8_SB(1, 1), cB + hstep + kstep, voffB);
        PG8_WAIT_V(6); PG8_BAR;
    } else {
        PG8_STAGE(PG8_SB(0, 0), cB, voffB); PG8_STAGE(PG8_SA(0, 0), cA, voffA); PG8_STAGE(PG8_SB(0, 1), cB + hstep, voffB); PG8_STAGE(PG8_SA(0, 1), cA + hstep, voffA);
        if (wr == 1) PG8_BAR;
        PG8_WAIT_V(4); PG8_BAR;
        PG8_STAGE(PG8_SB(1, 0), cB + kstep, voffB); PG8_STAGE(PG8_SA(1, 0), cA + kstep, voffA); PG8_STAGE(PG8_SB(1, 1), cB + hstep + kstep, voffB);
        PG8_WAIT_V(6); PG8_BAR;
    }
    for (;;) {
        const bool has_next = S.next(ui + 1, nxt);
        const char* nA = has_next ? (const char*)g.A + (size_t)nxt.pm * tstep : cA; const char* nB = has_next ? (const char*)g.Bt + (size_t)nxt.pn * tstep : cB;
        for (int t = 0; t < nt; t += 2) {
            const bool last = (t == nt - 2);
            const char* a1 = cA + (size_t)(t + 1) * kstep;
            const char* a2 = last ? nA : cA + (size_t)(t + 2) * kstep; const char* b2 = last ? nB : cB + (size_t)(t + 2) * kstep;
            const char* a3 = a2 + kstep; const char* b3 = b2 + kstep;
            if (last && has_next) S.a_ready(nxt);
            if constexpr (SP2) {
            PG8_LDB(B0, 0, 0); PG8_LDB(B1, 0, 1); PG8_SCHED; PG8_LDA(At, 0, 0); PG8_STAGE(PG8_SA(1, 1), a1 + hstep, voffA);
            PG8_WAIT_V(8); PG8_WAIT_L(0); PG8_BAR; PG8_MMA(0, 0, At, B0); PG8_MMA(0, 1, At, B1); PG8_BAR; PG8_SCHED;
            PG8_LDA(At, 0, 1); PG8_STAGE(PG8_SB(0, 0), b2, voffB); PG8_STAGE(PG8_SB(0, 1), b2 + hstep, voffB); PG8_STAGE(PG8_SA(0, 0), a2, voffA);
            PG8_WAIT_V(8); PG8_WAIT_L(0); PG8_BAR; PG8_MMA(1, 0, At, B0); PG8_MMA(1, 1, At, B1); PG8_BAR; PG8_SCHED;
            PG8_LDB(B0, 1, 0); PG8_LDB(B1, 1, 1); PG8_SCHED; PG8_LDA(At, 1, 0); PG8_STAGE(PG8_SA(0, 1), a2 + hstep, voffA);
            PG8_WAIT_V(8); PG8_WAIT_L(0); PG8_BAR; PG8_MMA(0, 0, At, B0); PG8_MMA(0, 1, At, B1); PG8_BAR; PG8_SCHED;
            PG8_LDA(At, 1, 1); PG8_STAGE(PG8_SB(1, 0), b3, voffB); PG8_STAGE(PG8_SB(1, 1), b3 + hstep, voffB); PG8_STAGE(PG8_SA(1, 0), a3, voffA);
            PG8_WAIT_V(8); PG8_WAIT_L(0); PG8_BAR; PG8_MMA(1, 0, At, B0); PG8_MMA(1, 1, At, B1); PG8_BAR; PG8_SCHED;
            } else {
            PG8_LDB(B0, 0, 0); PG8_SCHED; PG8_LDA(At, 0, 0); PG8_STAGE(PG8_SA(1, 1), a1 + hstep, voffA);
            PG8_WAIT_L(8); PG8_BAR; PG8_WAIT_L(0); PG8_MMA(0, 0, At, B0); PG8_BAR; PG8_SCHED;
            PG8_LDB(B1, 0, 1); PG8_STAGE(PG8_SB(0, 0), b2, voffB);
            PG8_BAR; PG8_WAIT_L(0); PG8_MMA(0, 1, At, B1); PG8_BAR;
            PG8_LDA(At, 0, 1); PG8_STAGE(PG8_SA(0, 0), a2, voffA);
            PG8_BAR; PG8_WAIT_L(0); PG8_MMA(1, 0, At, B0); PG8_BAR; PG8_SCHED;
            PG8_STAGE(PG8_SB(0, 1), b2 + hstep, voffB);
            PG8_WAIT_V(6); PG8_BAR; PG8_MMA(1, 1, At, B1); PG8_BAR;
            PG8_LDB(B0, 1, 0); PG8_SCHED; PG8_LDA(At, 1, 0); PG8_STAGE(PG8_SA(0, 1), a2 + hstep, voffA);
            PG8_WAIT_L(8); PG8_BAR; PG8_WAIT_L(0); PG8_MMA(0, 0, At, B0); PG8_BAR; PG8_SCHED;
            PG8_LDB(B1, 1, 1); PG8_STAGE(PG8_SB(1, 0), b3, voffB);
            PG8_BAR; PG8_WAIT_L(0); PG8_MMA(0, 1, At, B1); PG8_BAR;
            PG8_LDA(At, 1, 1); PG8_STAGE(PG8_SA(1, 0), a3, voffA);
            PG8_BAR; PG8_WAIT_L(0); PG8_MMA(1, 0, At, B0); PG8_BAR; PG8_SCHED;
            PG8_STAGE(PG8_SB(1, 1), b3 + hstep, voffB);
            PG8_WAIT_V(6); PG8_BAR; PG8_MMA(1, 1, At, B1); PG8_BAR;
            }
        }
        if constexpr (ALIGN_EPI) { if (wr == 0) PG8_BAR; }
        if constexpr (!Epi::AFTER_DRAIN) { E(acc, cur, wr, wc, fr, fq); S.done(cur); }
        if (!has_next) break;
#pragma unroll
        for (int a = 0; a < 2; ++a)
#pragma unroll
            for (int b = 0; b < 2; ++b)
#pragma unroll
                for (int m = 0; m < 4; ++m)
#pragma unroll
                    for (int n = 0; n < 2; ++n) acc[a][b][m][n] = (f32x4){0.f, 0.f, 0.f, 0.f};
        cur = nxt; cA = nA; cB = nB; ++ui;
        if constexpr (ALIGN_EPI) { if (wr == 1) PG8_BAR; }
    }
    PG8_WAIT_V(0);
    if constexpr (!ALIGN_EPI) { if (wr == 0) PG8_BAR; }
    PG8_BAR;
    if constexpr (Epi::AFTER_DRAIN) { E.fused(acc, cur, wr, wc, fr, fq, lds, wid, lane); S.done(cur); }
#undef PG8_SA
#undef PG8_SB
#undef PG8_STAGE
#undef PG8_LDA
#undef PG8_LDB
#undef PG8_MMA
#undef PG8_WAIT_V
#undef PG8_WAIT_L
#undef PG8_BAR
#undef PG8_SCHED
}
}
constexpr int NWAVES = 8;
constexpr int BATCH = 16, SEQ = 2048, DM = 1024, DEPTH = 4, DFF = 4096;
constexpr int M = BATCH * SEQ;
constexpr int DIN = 2824;
constexpr int ZP = 3072;
constexpr int ZC_RW_R = 0, ZC_RW_K = 256, ZC_RW_V = 512, ZC_RW_DW = 768;
constexpr int ZC_GD_Q = 1024, ZC_GD_K = 1280, ZC_GD_V = 1536, ZC_GD_G = 1792;
constexpr int ZC_AT_Q = 2048, ZC_AT_K = 2560, ZC_AT_V = 2688;
constexpr int ZC_GD_B = 2816, ZC_GD_A = 2820;
__host__ __device__ __forceinline__ int win_src_col(int n) {
    if (n < 2048) return n;
    if (n < 2816) return n + 8;
    if (n < 2824) return n - 2816 + 2048;
    return -1;
}
constexpr size_t MiB = 1u << 20;
constexpr size_t WS_CTL = 0, CTL_ZERO_BYTES = 1 * MiB;
constexpr size_t WS_WIN = 1 * MiB;
constexpr size_t WS_WOUT = WS_WIN + (size_t)DEPTH * ZP * DM * 2;
constexpr size_t WS_W1 = WS_WOUT + (size_t)DEPTH * DM * DM * 2;
constexpr size_t WS_W2 = WS_W1 + (size_t)DEPTH * DFF * DM * 2;
constexpr size_t WS_XN = WS_W2 + (size_t)DEPTH * DM * DFF * 2;
constexpr size_t WS_Z = WS_XN + (size_t)M * DM * 2;
constexpr size_t WS_Y = WS_Z + (size_t)M * ZP * 2;
constexpr size_t WS_H = WS_Z;
constexpr size_t WS_HB = WS_Y + (size_t)M * DM * 2;
constexpr size_t WS_RSS = WS_HB + (size_t)256 * 8 * 24576;
constexpr size_t WS_XS = WS_RSS + (size_t)2 * DEPTH * M * 16 * 4;
constexpr size_t WS_END = WS_XS + (size_t)128 * 16384;
static_assert(WS_H + (size_t)M * DFF * 2 <= WS_HB, "H overlay");
static_assert(WS_END <= 512 * MiB, "d_ws map");
constexpr int CW_TMO = 8192, CW_SEQ = 16384;
constexpr int CW_BAR = 4096;
constexpr int RING_OFF = 0, RING_BYTES = 131072;
constexpr int LDSCTL_OFF = 158720, MISC_OFF = LDSCTL_OFF + 320;
constexpr int BIAS_OFF = LDSCTL_OFF + 1024;
constexpr int LDS_BYTES = 163840;
static_assert(BIAS_OFF + 4096 <= LDS_BYTES, "LDS map");

#define GAS __attribute__((address_space(1)))
#define LAS __attribute__((address_space(3)))
typedef unsigned short bf16;
typedef unsigned v4u __attribute__((ext_vector_type(4)));
typedef unsigned v2u __attribute__((ext_vector_type(2)));
typedef float f32x4 __attribute__((ext_vector_type(4)));
typedef GAS unsigned gu32;
#define RLX_AGENT __ATOMIC_RELAXED, __HIP_MEMORY_SCOPE_AGENT
#define LDS_WAIT() asm volatile("s_waitcnt lgkmcnt(0)" ::: "memory")
#define VM_WAIT() asm volatile("s_waitcnt vmcnt(0)" ::: "memory")
__device__ __forceinline__ int hw_lane() { return hwl_(); }
__device__ __forceinline__ unsigned f2bf(float f) { unsigned u = __builtin_bit_cast(unsigned, f); return (u + 0x7fffu + ((u >> 16) & 1u)) >> 16; }
__device__ __forceinline__ unsigned pk2(float lo, float hi) { return f2bf(lo) | (f2bf(hi) << 16); }
__device__ __forceinline__ float bf2f(unsigned short h) { return __builtin_bit_cast(float, (unsigned)h << 16); }
__device__ __forceinline__ float bflo(unsigned u) { return __builtin_bit_cast(float, u << 16); }
__device__ __forceinline__ float bfhi(unsigned u) { return __builtin_bit_cast(float, u & 0xffff0000u); }
__device__ __forceinline__ float sigmoidf_(float x) { return 1.f / (1.f + __expf(-x)); }
__device__ __forceinline__ float softplusf_(float x) { return fmaxf(x, 0.f) + log1pf(__expf(-fabsf(x))); }
__device__ __forceinline__ float dppf(float v, const int ctrl_sel) {
    int r;
    const int s = __builtin_bit_cast(int, v);
    if (ctrl_sel == 0) r = __builtin_amdgcn_update_dpp(0, s, 0xB1, 0xF, 0xF, true);
    else if (ctrl_sel == 1) r = __builtin_amdgcn_update_dpp(0, s, 0x4E, 0xF, 0xF, true);
    else if (ctrl_sel == 2) r = __builtin_amdgcn_update_dpp(0, s, 0x141, 0xF, 0xF, true);
    else r = __builtin_amdgcn_update_dpp(0, s, 0x140, 0xF, 0xF, true);
    return __builtin_bit_cast(float, r);
}
__device__ __forceinline__ float wave_allsum(float v) {
    v += dppf(v, 0); v += dppf(v, 1); v += dppf(v, 2); v += dppf(v, 3);
    const float a = __builtin_bit_cast(float, __builtin_amdgcn_readlane(__builtin_bit_cast(int, v), 0));
    const float b = __builtin_bit_cast(float, __builtin_amdgcn_readlane(__builtin_bit_cast(int, v), 16));
    const float c = __builtin_bit_cast(float, __builtin_amdgcn_readlane(__builtin_bit_cast(int, v), 32));
    const float d = __builtin_bit_cast(float, __builtin_amdgcn_readlane(__builtin_bit_cast(int, v), 48));
    return (a + b) + (c + d);
}
#define XB_TMO      128
#define XB_XCNT(j)  (256  + 64 * (j))
#define XB_XSUB(j)  (1280 + 64 * (j))
#define XB_XGEN(j)  (2304 + 64 * (j))
#define XB_TOP      3328
#define XB_TOPGEN   3392
#define XCD_BAR_WORDS 3456
#define XB_SPIN_CAP (1u << 18)

__device__ __forceinline__ unsigned xb_ld(unsigned* p)              { return __hip_atomic_load(p, __ATOMIC_RELAXED, __HIP_MEMORY_SCOPE_AGENT); }
__device__ __forceinline__ unsigned xb_add(unsigned* p, unsigned v) { return __hip_atomic_fetch_add(p, v, __ATOMIC_RELAXED, __HIP_MEMORY_SCOPE_AGENT); }
__device__ __forceinline__ unsigned xb_xcc_id() { return (unsigned)__builtin_amdgcn_s_getreg((3 << 11) | 20) & 0xFu; }
#define XB_SPIN(cond, bar) do { unsigned _sp = 0; while (cond) { __builtin_amdgcn_s_sleep(1); \
    if ((++_sp & 255u) == 0u) { if (xb_ld(&(bar)[XB_TMO])) break; if (_sp > XB_SPIN_CAP) { atomicAdd(&(bar)[XB_TMO], 1u); break; } } } } while (0)

struct XcdBarrier {
    unsigned* bar; unsigned x;
    volatile LAS unsigned* st;
};

__device__ __forceinline__ XcdBarrier xcd_barrier_post(unsigned* bar, volatile LAS unsigned* st, const bool t0  ) {
    XcdBarrier b; b.bar = bar; b.x = xb_xcc_id(); b.st = st;
    if (t0) (void)xb_add(&bar[XB_XCNT(b.x)], 1u);
    return b;
}
__device__ __forceinline__ void xcd_barrier_complete(unsigned* bar, unsigned x, unsigned& nloc, unsigned& nx) {
    const unsigned G = gridDim.x * gridDim.y * gridDim.z;
    unsigned sum, cnt, mine, sp = 0u;
    for (;;) {
        sum = 0u; cnt = 0u; mine = 0u;
#pragma unroll
        for (unsigned j = 0; j < 16; ++j) { const unsigned c = xb_ld(&bar[XB_XCNT(j)]); sum += c; cnt += (c > 0u) ? 1u : 0u; mine = (j == x) ? c : mine; }
        if (sum == G) break;
        __builtin_amdgcn_s_sleep(1);
        if ((++sp & 255u) == 0u) { if (xb_ld(&bar[XB_TMO])) break; if (sp > XB_SPIN_CAP) { atomicAdd(&bar[XB_TMO], 1u); break; } }
    }
    nloc = mine > 0u ? mine : 1u; nx = cnt > 0u ? cnt : 1u;
}

__device__ __forceinline__ void xcd_barrier(const XcdBarrier& b, const bool t0  ) {
    asm volatile("s_waitcnt vmcnt(0)" ::: "memory");
    __syncthreads();
    if (t0) {
        unsigned* bar = b.bar;
        __builtin_amdgcn_s_waitcnt(0);
        unsigned nloc = b.st[0], nx = b.st[1];
        if (nloc == 0u) { xcd_barrier_complete(bar, b.x, nloc, nx); b.st[0] = nloc; b.st[1] = nx; }
        const unsigned old = xb_add(&bar[XB_XSUB(b.x)], 1u);
        const unsigned gen = old / nloc;
        if (old + 1u == (gen + 1u) * nloc) {
            __builtin_amdgcn_fence(__ATOMIC_RELEASE, "agent");
            asm volatile("s_waitcnt vmcnt(0)" ::: "memory");
            const unsigned og = xb_add(&bar[XB_TOP], 1u);
            const unsigned tg = og / nx;
            if (og + 1u == (tg + 1u) * nx) xb_add(&bar[XB_TOPGEN], 1u);
            else XB_SPIN(xb_ld(&bar[XB_TOPGEN]) == tg, bar);
            __builtin_amdgcn_fence(__ATOMIC_ACQUIRE, "agent");
            xb_add(&bar[XB_XGEN(b.x)], 1u);
            asm volatile("s_waitcnt vmcnt(0)" ::: "memory");
        } else {
            XB_SPIN(xb_ld(&bar[XB_XGEN(b.x)]) == gen, bar);
            __builtin_amdgcn_fence(__ATOMIC_ACQUIRE, "agent");
            asm volatile("s_waitcnt vmcnt(0)" ::: "memory");
        }
    }
    __syncthreads();
}
struct Frame {
    LAS unsigned char* lds;
    int wave;
    int vcu, G;
    unsigned char* ws;
    float* out;
};
typedef const float* cfp;
typedef const __attribute__((address_space(4))) cfp* karg_tab;
__device__ __forceinline__ karg_tab ktab() { karg_tab t = (karg_tab)__builtin_amdgcn_kernarg_segment_ptr(); asm volatile("" : "+s"(t)); return t; }
#define INP(i) (ktab()[i])
__device__ __forceinline__ int ltid() { return hw_lane(); }
__device__ __forceinline__ unsigned char* lnd(unsigned char* p) { asm volatile("" : "+s"(p)); return p; }
#define WSP(off) (lnd(F.ws) + (off))
#define FZ ((bf16*)WSP(WS_Z))
#define FY ((bf16*)WSP(WS_Y))
#define FXN ((bf16*)WSP(WS_XN))
#define FH ((bf16*)WSP(WS_H))
enum { I_X = 0, I_LN1 = 1, I_WIN = 2, I_MU = 3, I_W0 = 4, I_WUP = 5, I_A0 = 6, I_AUP = 7, I_GUP = 8, I_KK = 9, I_KA = 10, I_RK = 11, I_LNXW = 12, I_LNXB = 13,
       I_CONV = 14, I_ALOG = 15, I_DTB = 16, I_GNW = 17, I_QNW = 18, I_KNW = 19, I_SINK = 20, I_RELB = 21, I_WOUT = 22, I_LN2 = 23, I_WFF1 = 24, I_WFF2 = 25 };

template <bool MAP>
__device__ __forceinline__ void p0_transpose_item(const float* W, int K, int Nsrc, int Ndst, bf16* WT, LAS float* scr, int item, int lane, const float* kscale = nullptr) {
    const int nblk = Ndst / 64, kb = item / nblk, nb = item % nblk, k0 = 64 * kb, n0 = 64 * nb;
    const int c4 = lane & 15, r = lane >> 4;
    const int nn = n0 + 4 * c4; const int src = MAP ? win_src_col(nn) : nn;
#pragma unroll 8
    for (int i = 0; i < 16; ++i) { const int kk = 4 * i + r;
        f32x4 v = {0.f, 0.f, 0.f, 0.f}; if (src >= 0) v = *(const GAS f32x4*)(W + (size_t)(k0 + kk) * Nsrc + src);
        const float sc = kscale ? kscale[k0 + kk] : 1.f;
        LAS float* d = scr + kk * 65 + 4 * c4; d[0] = v.x * sc; d[1] = v.y * sc; d[2] = v.z * sc; d[3] = v.w * sc; }
    LDS_WAIT(); asm volatile("" ::: "memory");
    const int c = lane & 7;
#pragma unroll
    for (int j = 0; j < 8; ++j) { const int n = (lane >> 3) + 8 * j; const LAS float* s = scr + (8 * c) * 65 + n;
        v4u o; o.x = pk2(s[0 * 65], s[1 * 65]); o.y = pk2(s[2 * 65], s[3 * 65]); o.z = pk2(s[4 * 65], s[5 * 65]); o.w = pk2(s[6 * 65], s[7 * 65]);
        *(GAS v4u*)(WT + (size_t)(n0 + n) * K + k0 + 8 * c) = o; }
    LDS_WAIT(); asm volatile("" ::: "memory");
}
__device__ __forceinline__ void cast_rows(Frame& F, const float* x, bf16* xn, float* rss) {
    const int lane = ltid() & 63;
    const int gw = F.vcu * NWAVES + F.wave, NGW = F.G * NWAVES;
    for (int m = gw; m < M; m += NGW) {
        const GAS f32x4* xr = (const GAS f32x4*)(x + (size_t)m * DM) + lane;
        f32x4 v[4]; float s = 0.f;
#pragma unroll
        for (int j = 0; j < 4; ++j) { v[j] = xr[64 * j]; s += (v[j].x * v[j].x + v[j].y * v[j].y) + (v[j].z * v[j].z + v[j].w * v[j].w); }
        s = wave_allsum(s);
        if (lane < 16) rss[(size_t)m * 16 + lane] = (lane == 0) ? s : 0.f;
        GAS unsigned long long* o8 = (GAS unsigned long long*)(xn + (size_t)m * DM) + lane;
#pragma unroll
        for (int j = 0; j < 4; ++j) o8[64 * j] = (unsigned long long)pk2(v[j].x, v[j].y) | ((unsigned long long)pk2(v[j].z, v[j].w) << 32);
    }
}
__device__ __forceinline__ void p0_prologue(Frame& F) {
    const int lane_ = ltid() & 63;
    LAS float* scr = (LAS float*)(F.lds + RING_OFF + F.wave * 16640);
    const int gw = F.vcu * NWAVES + F.wave, NGW = F.G * NWAVES;
    constexpr int I_IN = (DM / 64) * (ZP / 64), I_O = (DM / 64) * (DM / 64), I_1 = (DM / 64) * (DFF / 64), I_2 = (DFF / 64) * (DM / 64);
    constexpr int PER_L = I_IN + I_O + I_1 + I_2, NITEMS = DEPTH * PER_L;
    for (int it = gw; it < NITEMS; it += NGW) {
        const int l = it / PER_L; int r = it % PER_L;
        if (r < I_IN) { p0_transpose_item<true>(INP(I_WIN) + (size_t)l * DM * DIN, DM, DIN, ZP, ((bf16*)WSP(WS_WIN)) + (size_t)l * ZP * DM, scr, r, lane_, INP(I_LN1) + (size_t)l * DM); continue; } r -= I_IN;
        if (r < I_O) { p0_transpose_item<false>(INP(I_WOUT) + (size_t)l * DM * DM, DM, DM, DM, ((bf16*)WSP(WS_WOUT)) + (size_t)l * DM * DM, scr, r, lane_); continue; } r -= I_O;
        if (r < I_1) { p0_transpose_item<false>(INP(I_WFF1) + (size_t)l * DM * DFF, DM, DFF, DFF, ((bf16*)WSP(WS_W1)) + (size_t)l * DFF * DM, scr, r, lane_, INP(I_LN2) + (size_t)l * DM); continue; } r -= I_1;
        p0_transpose_item<false>(INP(I_WFF2) + (size_t)l * DFF * DM, DFF, DM, DM, ((bf16*)WSP(WS_W2)) + (size_t)l * DM * DFF, scr, r, lane_);
    }
    cast_rows(F, INP(I_X), FXN, (float*)WSP(WS_RSS));
}

#define MX_DEV __device__ __forceinline__
#define MX_G __attribute__((address_space(1)))
#define MX_L __attribute__((address_space(3)))
#define MX_EXP(x) __expf(x)
#define MX_LOG1P(x) log1pf(x)
#define MXIN(i) ((const MX_G float*)INP(i))
#define MX_VMWAIT() asm volatile("s_waitcnt vmcnt(0)" ::: "memory")
#define MX_LDSWAIT() asm volatile("s_waitcnt lgkmcnt(0)" ::: "memory")
#define MX_SCHED() __builtin_amdgcn_sched_barrier(0)
#define MX_LAUNDER_S(p) asm volatile("" : "+s"(p))
#define MX_LAUNDER_V(p) asm volatile("" : "+v"(p))
#define MX_CONSUME(x) asm volatile("" :: "v"(x))
#define MX_FMAC(acc, a, b) asm("v_fmac_f32_e32 %0, %1, %2" : "+v"(acc) : "v"(a), "v"(b))
#define MX_RCP(x) __builtin_amdgcn_rcpf(x)
#define MX_RSQ(x) __builtin_amdgcn_rsqf(x)
#define MX_LOG(x) __logf(x)
typedef __bf16 mx_bf2_t __attribute__((ext_vector_type(2)));
typedef float mx_f2_t __attribute__((ext_vector_type(2)));
__device__ __forceinline__ unsigned mx_hwpk2(float lo, float hi) { mx_f2_t v = {lo, hi}; return __builtin_bit_cast(unsigned, __builtin_convertvector(v, mx_bf2_t)); }
#define MX_PK2(lo, hi) mx_hwpk2(lo, hi)
#define MX_UNIFORM(x) __builtin_amdgcn_readfirstlane(x)
#define MX_ROW_SHR(v, d) __builtin_bit_cast(float, __builtin_amdgcn_update_dpp(0, __builtin_bit_cast(int, (v)), 0x110 + (d), 0xF, 0xF, true))
#define MX_ROW_SHRU(v, d) ((unsigned)__builtin_amdgcn_update_dpp(0, (int)(v), 0x110 + (d), 0xF, 0xF, true))
#define MX_ROW_RORU(v, d) ((unsigned)__builtin_amdgcn_update_dpp(0, (int)(v), 0x120 + (d), 0xF, 0xF, true))
#define MX_ROW_LAST(v) __builtin_bit_cast(float, __builtin_amdgcn_update_dpp(0, __builtin_bit_cast(int, (v)), 0x15F, 0xF, 0xF, true))
#define MX_ROW_SHR(v, d) __builtin_bit_cast(float, __builtin_amdgcn_update_dpp(0, __builtin_bit_cast(int, (v)), 0x110 + (d), 0xF, 0xF, true))
#define MX_ROW_LAST(v) __builtin_bit_cast(float, __builtin_amdgcn_update_dpp(0, __builtin_bit_cast(int, (v)), 0x15F, 0xF, 0xF, true))
typedef unsigned mx_u2_t __attribute__((ext_vector_type(2)));
__device__ __forceinline__ float mx_hw_rowsum4(float v) {
    const mx_u2_t a = __builtin_amdgcn_permlane16_swap(__builtin_bit_cast(unsigned, v), __builtin_bit_cast(unsigned, v), false, false);
    const float s = __builtin_bit_cast(float, a.x) + __builtin_bit_cast(float, a.y);
    const mx_u2_t b = __builtin_amdgcn_permlane32_swap(__builtin_bit_cast(unsigned, s), __builtin_bit_cast(unsigned, s), false, false);
    return __builtin_bit_cast(float, b.x) + __builtin_bit_cast(float, b.y);
}
#define MX_ROWSUM4(v) mx_hw_rowsum4(v)
#define MX_FLAG_LOAD(p) __hip_atomic_load((p), __ATOMIC_RELAXED, __HIP_MEMORY_SCOPE_AGENT)
#define MX_FLAG_STORE(p, v) __hip_atomic_store((p), (v), __ATOMIC_RELAXED, __HIP_MEMORY_SCOPE_AGENT)
#define MX_FLAG_ADD(p, v) __hip_atomic_fetch_add((p), (v), __ATOMIC_RELAXED, __HIP_MEMORY_SCOPE_AGENT)
#define MX_SLEEP() __builtin_amdgcn_s_sleep(2)
#define MX_SC1_LOAD64(p) __hip_atomic_load((p), __ATOMIC_RELAXED, __HIP_MEMORY_SCOPE_AGENT)
#define MX_SC1_STORE64(p, v) __hip_atomic_store((p), (v), __ATOMIC_RELAXED, __HIP_MEMORY_SCOPE_AGENT)
__device__ __forceinline__ int mx_lane() { return ltid() & 63; }
__device__ __forceinline__ void mx_wgsync() { __syncthreads(); }
__device__ __forceinline__ float mx_shfl_xor(float v, int m) { return m == 16 ? xor16f(v) : xor32f(v); }
__device__ __forceinline__ float mx_shfl16l(float v, int src, int lane) { return __builtin_bit_cast(float, __builtin_amdgcn_ds_bpermute(((lane & 48) | src) << 2, __builtin_bit_cast(int, v))); }
typedef short mx_bf16x8_t __attribute__((ext_vector_type(8)));
typedef float mx_f32x4_t __attribute__((ext_vector_type(4)));
__device__ __forceinline__ mx_f32x4_t mx_mfma(mx_bf16x8_t a, mx_bf16x8_t b, mx_f32x4_t c) { return __builtin_amdgcn_mfma_f32_16x16x32_bf16(a, b, c, 0, 0, 0); }
typedef short mx_s16x4_t __attribute__((ext_vector_type(4)));
#define MX_MFMA16(a, b, c) __builtin_amdgcn_mfma_f32_16x16x16bf16_1k(__builtin_bit_cast(mx_s16x4_t, a), __builtin_bit_cast(mx_s16x4_t, b), c, 0, 0, 0)
typedef short mx_bf16x8 __attribute__((ext_vector_type(8)));
typedef float mx_f32x4 __attribute__((ext_vector_type(4)));
typedef unsigned mx_u32x4 __attribute__((ext_vector_type(4)));
typedef unsigned mx_u32x2 __attribute__((ext_vector_type(2)));

MX_DEV unsigned mx_bf(float f) { unsigned u = __builtin_bit_cast(unsigned, f); return (u + 0x7fffu + ((u >> 16) & 1u)) >> 16; }
MX_DEV unsigned mx_pk2(float lo, float hi) { return MX_PK2(lo, hi); }
MX_DEV float mx_lo(unsigned u) { return __builtin_bit_cast(float, u << 16); }
MX_DEV float mx_hi(unsigned u) { return __builtin_bit_cast(float, u & 0xffff0000u); }
MX_DEV mx_bf16x8 mx_frag8(const float* a, const float* b) {
    mx_u32x4 w; w.x = mx_pk2(a[0], a[1]); w.y = mx_pk2(a[2], a[3]); w.z = mx_pk2(b[0], b[1]); w.w = mx_pk2(b[2], b[3]); return __builtin_bit_cast(mx_bf16x8, w); }
MX_DEV mx_bf16x8 mx_frag8v(mx_f32x4 a, mx_f32x4 b) {
    mx_u32x4 w; w.x = mx_pk2(a.x, a.y); w.y = mx_pk2(a.z, a.w); w.z = mx_pk2(b.x, b.y); w.w = mx_pk2(b.z, b.w); return __builtin_bit_cast(mx_bf16x8, w); }
MX_DEV mx_u32x2 mx_frag4(mx_f32x4 a) { mx_u32x2 w; w.x = mx_pk2(a.x, a.y); w.y = mx_pk2(a.z, a.w); return w; }
MX_DEV mx_f32x4 mx_mfma(mx_u32x2 a, mx_u32x2 b, mx_f32x4 c) { return MX_MFMA16(a, b, c); }
typedef unsigned long long mx_u64x2 __attribute__((ext_vector_type(2)));
MX_DEV mx_u32x2 mx_frag4p(mx_u32x2 p) { return p; }
MX_DEV mx_u32x2 mx_pack4(mx_f32x4 a) { mx_u32x2 p; p.x = mx_pk2(a.x, a.y); p.y = mx_pk2(a.z, a.w); return p; }
MX_DEV mx_f32x4 mx_zero4() { mx_f32x4 z = {0.f, 0.f, 0.f, 0.f}; return z; }
MX_DEV float mx_sigmoid(float x) { return MX_RCP(1.f + MX_EXP(-x)); }
MX_DEV float mx_softplus(float x) { return fmaxf(x, 0.f) + MX_LOG(1.f + MX_EXP(-fabsf(x))); }
MX_DEV float mx_rowsum4(float v) { v += mx_shfl_xor(v, 16); v += mx_shfl_xor(v, 32); return v; }

constexpr int MX_HB_WA = 0, MX_HB_RT = 2048, MX_HB_ARB = 4096, MX_HB_ARK = 4608, MX_HB_BH = 5120, MX_HB_KH = 7168, MX_HB_VC = 9216, MX_HB_U0 = 11264, MX_HB_GAM = 13312, MX_HB_SLOT = 13568;
constexpr int MX_GB_GT = 0, MX_GB_EE = 2048, MX_GB_SLOT = 4096;
constexpr int MX_LDS_HB = 0, MX_LDS_WW = 108544, MX_LDS_WA = 117760, MX_LDS_WG = 126976, MX_LDS_PAR = 144384, MX_LDS_ST = 148480, MX_LDS_GAM = 152576  , MX_LDS_END = 156672, MX_RS64 = 144, MX_RS128 = 272;
constexpr int MX_P_MUR = 256, MX_P_MUK = 320, MX_P_MUV = 384, MX_P_W0 = 448, MX_P_A0 = 512, MX_P_KK = 576, MX_P_KA = 640, MX_P_RK = 704, MX_P_LNW = 768, MX_P_LNB = 832, MX_P_GNW = 768;

MX_DEV void mx_prep_back(float (&lw)[16], float (&a)[16], float (&b)[16], float (&k2)[16], float (&r)[16], float (&v)[16], MX_L unsigned char* slot, MX_L unsigned char* gamp  , bool midbar, int lane) {
    const int tk = lane & 15, g = lane >> 4;
    float G[16];
#pragma unroll
    for (int i = 0; i < 16; ++i) G[i] = lw[i];
#pragma unroll
    for (int i = 0; i < 16; ++i) { G[i] += MX_ROW_SHR(G[i], 1); G[i] += MX_ROW_SHR(G[i], 2); G[i] += MX_ROW_SHR(G[i], 4); G[i] += MX_ROW_SHR(G[i], 8); }
    MX_SCHED();
    mx_bf16x8 AtF[2], BtF[2], KtF[2], RtF[2], BhF[2], KhF[2], VF[2];
    {
        float x[16];
#pragma unroll
        for (int i = 0; i < 16; ++i) { x[i] = a[i] * MX_EXP(G[i] - lw[i]); }
        AtF[0] = mx_frag8(x, x + 4); AtF[1] = mx_frag8(x + 8, x + 12);
    }
    MX_SCHED();
    {
        float x[16];
#pragma unroll
        for (int i = 0; i < 16; ++i) { x[i] = r[i] * MX_EXP(G[i]); }
        RtF[0] = mx_frag8(x, x + 4); RtF[1] = mx_frag8(x + 8, x + 12);
        VF[0] = mx_frag8(v, v + 4); VF[1] = mx_frag8(v + 8, v + 12);
    }
    MX_SCHED();
    {
        float x[16], y[16];
#pragma unroll
        for (int i = 0; i < 16; ++i) { const float e = MX_EXP(-G[i]); x[i] = b[i] * e; y[i] = k2[i] * e; }
        BtF[0] = mx_frag8(x, x + 4); BtF[1] = mx_frag8(x + 8, x + 12); KtF[0] = mx_frag8(y, y + 4); KtF[1] = mx_frag8(y + 8, y + 12);
    }
    MX_SCHED();
    {
        float x[16], y[16], gam[16];
#pragma unroll
        for (int i = 0; i < 16; ++i) { const float gc = MX_ROW_LAST(G[i]); const float e = MX_EXP(gc - G[i]); x[i] = b[i] * e; y[i] = k2[i] * e; gam[i] = MX_EXP(gc); }
        BhF[0] = mx_frag8(x, x + 4); BhF[1] = mx_frag8(x + 8, x + 12); KhF[0] = mx_frag8(y, y + 4); KhF[1] = mx_frag8(y + 8, y + 12);
        if (tk == 0) {
#pragma unroll
            for (int ct = 0; ct < 4; ++ct) { mx_f32x4 q = {gam[4 * ct], gam[4 * ct + 1], gam[4 * ct + 2], gam[4 * ct + 3]}; *(MX_L mx_f32x4*)(gamp + (unsigned)((16 * ct + 4 * g) * 4)) = q; } }
    }
    MX_SCHED();
    const mx_f32x4 z4 = mx_zero4();
    mx_f32x4 L = mx_mfma(BtF[1], AtF[1], mx_mfma(BtF[0], AtF[0], z4));
    mx_f32x4 LT = mx_mfma(AtF[1], BtF[1], mx_mfma(AtF[0], BtF[0], z4));
    mx_f32x4 Lak = mx_mfma(KtF[1], AtF[1], mx_mfma(KtF[0], AtF[0], z4));
    mx_f32x4 Arb = mx_mfma(BtF[1], RtF[1], mx_mfma(BtF[0], RtF[0], z4));
    mx_f32x4 Ark = mx_mfma(KtF[1], RtF[1], mx_mfma(KtF[0], RtF[0], z4));
#pragma unroll
    for (int e = 0; e < 4; ++e) { const int s = 4 * g + e;
        L[e] = (s < tk) ? L[e] : 0.f; LT[e] = (s > tk) ? LT[e] : 0.f; Lak[e] = (s < tk) ? Lak[e] : 0.f; Arb[e] = (s <= tk) ? Arb[e] : 0.f; Ark[e] = (s <= tk) ? Ark[e] : 0.f; }
    if (midbar) { MX_LDSWAIT(); mx_wgsync(); }
    *(MX_L mx_bf16x8*)(slot + (unsigned)(MX_HB_RT + lane * 16)) = RtF[0]; *(MX_L mx_bf16x8*)(slot + (unsigned)(MX_HB_RT + 1024 + lane * 16)) = RtF[1];
    *(MX_L mx_u32x2*)(slot + (unsigned)(MX_HB_ARB + lane * 8)) = mx_pack4(Arb); *(MX_L mx_u32x2*)(slot + (unsigned)(MX_HB_ARK + lane * 8)) = mx_pack4(Ark);
    mx_f32x4 T = L;
#pragma unroll
    for (int e = 0; e < 4; ++e) T[e] += (4 * g + e == tk) ? 1.f : 0.f;
    {
        const mx_u32x2 fL = mx_frag4(L), fLT = mx_frag4(LT);
        const mx_f32x4 L2 = mx_mfma(fLT, fL, z4), L2T = mx_mfma(fL, fLT, z4);
        const mx_u32x2 fL2 = mx_frag4(L2), fL2T = mx_frag4(L2T);
        T = mx_mfma(fL2T, mx_frag4(T), T);
        const mx_f32x4 L4 = mx_mfma(fL2T, fL2, z4), L4T = mx_mfma(fL2, fL2T, z4);
        const mx_u32x2 fL4 = mx_frag4(L4), fL4T = mx_frag4(L4T);
        T = mx_mfma(fL4T, mx_frag4(T), T);
        const mx_f32x4 L8T = mx_mfma(fL4, fL4T, z4);
        T = mx_mfma(mx_frag4(L8T), mx_frag4(T), T);
    }
    const mx_u32x2 fT = mx_frag4(T), fLak = mx_frag4(Lak);
    mx_bf16x8 Sel[2];
#pragma unroll
    for (int p = 0; p < 2; ++p) { mx_u32x4 w = {0u, 0u, 0u, 0u};
        if ((tk >> 2) == g) { const unsigned one = (tk & 1) ? 0x3F800000u : 0x00003F80u; const int q = 2 * p + ((tk & 3) >> 1); w.x = (q == 0) ? one : 0u; w.y = (q == 1) ? one : 0u; w.z = (q == 2) ? one : 0u; w.w = (q == 3) ? one : 0u; }
        Sel[p] = __builtin_bit_cast(mx_bf16x8, w); }
#pragma unroll
    for (int ks = 0; ks < 2; ++ks) {
        mx_f32x4 w0 = mx_mfma(mx_frag4(mx_mfma(AtF[ks], Sel[0], z4)), fT, z4);
        mx_f32x4 w1 = mx_mfma(mx_frag4(mx_mfma(AtF[ks], Sel[1], z4)), fT, z4);
        *(MX_L mx_bf16x8*)(slot + (unsigned)(MX_HB_WA + ks * 1024 + lane * 16)) = mx_frag8v(w0, w1);
    }
#pragma unroll
    for (int ct = 0; ct < 4; ++ct) {
        const mx_f32x4 vc = mx_mfma(VF[ct >> 1], Sel[ct & 1], z4);
        const mx_u32x2 vp = mx_pack4(vc);
        *(MX_L mx_u32x2*)(slot + (unsigned)(MX_HB_VC + ct * 512 + lane * 8)) = vp;
        const mx_f32x4 X = mx_mfma(fLak, mx_frag4p(vp), z4);
        const mx_f32x4 U0 = mx_mfma(fT, mx_frag4(X), z4);
        *(MX_L mx_u32x2*)(slot + (unsigned)(MX_HB_U0 + ct * 512 + lane * 8)) = mx_pack4(U0);
        *(MX_L mx_u32x2*)(slot + (unsigned)(MX_HB_BH + ct * 512 + lane * 8)) = mx_pack4(mx_mfma(BhF[ct >> 1], Sel[ct & 1], z4));
        *(MX_L mx_u32x2*)(slot + (unsigned)(MX_HB_KH + ct * 512 + lane * 8)) = mx_pack4(mx_mfma(KhF[ct >> 1], Sel[ct & 1], z4));
    }
}
MX_DEV void mx_load_t16(const MX_G unsigned short* p, bool ok, int g, float (&x)[16]) {
#pragma unroll
    for (int ct = 0; ct < 4; ++ct) { mx_u32x2 w = {0u, 0u}; if (ok) w = *(const MX_G mx_u32x2*)(p + 16 * ct + 4 * g);
        x[4 * ct] = mx_lo(w.x); x[4 * ct + 1] = mx_hi(w.x); x[4 * ct + 2] = mx_lo(w.y); x[4 * ct + 3] = mx_hi(w.y); }
}
MX_DEV void mx_load_par(const MX_G float* p, int g, float (&x)[16]) {
#pragma unroll
    for (int ct = 0; ct < 4; ++ct) { const mx_f32x4 w = *(const MX_G mx_f32x4*)(p + 16 * ct + 4 * g); x[4 * ct] = w.x; x[4 * ct + 1] = w.y; x[4 * ct + 2] = w.z; x[4 * ct + 3] = w.w; }
}
MX_DEV void mx_store_t16(MX_G unsigned char* p, int lane, const float (&x)[16]) {
#pragma unroll
    for (int ct = 0; ct < 4; ++ct) { mx_u32x2 w; w.x = mx_pk2(x[4 * ct], x[4 * ct + 1]); w.y = mx_pk2(x[4 * ct + 2], x[4 * ct + 3]); *(MX_G mx_u32x2*)(p + ct * 512 + lane * 8) = w; }
}

MX_DEV void mx_load_parL(const MX_L float* p, int g, float (&x)[16]) {
#pragma unroll
    for (int ct = 0; ct < 4; ++ct) { const mx_f32x4 w = *(const MX_L mx_f32x4*)(p + 16 * ct + 4 * g); x[4 * ct] = w.x; x[4 * ct + 1] = w.y; x[4 * ct + 2] = w.z; x[4 * ct + 3] = w.w; }
}
struct MxRaw16 { mx_u32x2 w[4]; };
MX_DEV MxRaw16 mx_raw_t16(const MX_G unsigned short* p, bool ok, int g) { MxRaw16 r;
#pragma unroll
    for (int ct = 0; ct < 4; ++ct) { mx_u32x2 w = {0u, 0u}; if (ok) w = *(const MX_G mx_u32x2*)(p + 16 * ct + 4 * g); r.w[ct] = w; }
    return r; }
MX_DEV void mx_unpack16(const MxRaw16& r, float (&x)[16]) {
#pragma unroll
    for (int ct = 0; ct < 4; ++ct) { x[4 * ct] = mx_lo(r.w[ct].x); x[4 * ct + 1] = mx_hi(r.w[ct].x); x[4 * ct + 2] = mx_lo(r.w[ct].y); x[4 * ct + 3] = mx_hi(r.w[ct].y); }
}
MX_DEV unsigned mx_shr_u(unsigned v, int d) { return d == 1 ? MX_ROW_SHRU(v, 1) : (d == 2 ? MX_ROW_SHRU(v, 2) : MX_ROW_SHRU(v, 3)); }
MX_DEV unsigned mx_ror_u(unsigned v, int d) { return d == 1 ? MX_ROW_RORU(v, 1) : (d == 2 ? MX_ROW_RORU(v, 2) : MX_ROW_RORU(v, 3)); }
MX_DEV MxRaw16 mx_raw_tail(const MX_G unsigned short* p  , int t0, int tk, int g) { MxRaw16 r;
#pragma unroll
    for (int ct = 0; ct < 4; ++ct) { mx_u32x2 w = {0u, 0u}; if (tk >= 13 && t0 - 16 + tk >= 0) w = *(const MX_G mx_u32x2*)(p + 16 * ct + 4 * g); r.w[ct] = w; }
    return r; }
MX_DEV MxRaw16 mx_raw_prev(const MxRaw16& cur, const MxRaw16& tail, int tk, int d) {
    MxRaw16 r;
#pragma unroll
    for (int ct = 0; ct < 4; ++ct) {
        const unsigned sx = mx_shr_u(cur.w[ct].x, d), sy = mx_shr_u(cur.w[ct].y, d), tx = mx_ror_u(tail.w[ct].x, d), ty = mx_ror_u(tail.w[ct].y, d);
        r.w[ct].x = (tk >= d) ? sx : tx; r.w[ct].y = (tk >= d) ? sy : ty; }
    return r;
}
MX_DEV void mx_prep_rwkv(int l, int h, const MX_G unsigned short* zseq  , int chunk, MX_L unsigned char* slot, MX_G unsigned char* gslot, MX_L unsigned char* gamp, bool midbar, const MX_L unsigned char* lds, int lane) {
    const int tk = lane & 15, g = lane >> 4, t = 16 * chunk + tk;
    const MX_G unsigned short* zrow = zseq + (size_t)t * ZP; const MX_G unsigned short* zprev = zrow - ZP; const bool hp = t > 0;
    const MX_L float* par = (const MX_L float*)(lds + MX_LDS_PAR);
    const mx_f32x4 z4 = mx_zero4();
    mx_u32x4 cwv[8], pwv[8];
#pragma unroll
    for (int ks = 0; ks < 8; ++ks) { const int col = ZC_RW_DW + 32 * ks + 8 * g; cwv[ks] = *(const MX_G mx_u32x4*)(zrow + col); mx_u32x4 pw = {0u, 0u, 0u, 0u}; if (tk == 15 && chunk > 0) pw = *(const MX_G mx_u32x4*)(zrow - (size_t)16 * ZP + col); pwv[ks] = pw; }
    const MxRaw16 kc = mx_raw_t16(zrow + ZC_RW_K + 64 * h, true, g), rc = mx_raw_t16(zrow + ZC_RW_R + 64 * h, true, g), vc_ = mx_raw_t16(zrow + ZC_RW_V + 64 * h, true, g);
    const MX_G unsigned short* ztail = zrow - (size_t)16 * ZP;
    const MxRaw16 kt_ = mx_raw_tail(ztail + ZC_RW_K + 64 * h, 16 * chunk, tk, g), rt_ = mx_raw_tail(ztail + ZC_RW_R + 64 * h, 16 * chunk, tk, g), vt_ = mx_raw_tail(ztail + ZC_RW_V + 64 * h, 16 * chunk, tk, g);
    MX_SCHED();
    mx_f32x4 accw[4], acca[4], accg[4];
#pragma unroll
    for (int ct = 0; ct < 4; ++ct) { accw[ct] = z4; acca[ct] = z4; accg[ct] = z4; }
#pragma unroll
    for (int ks = 0; ks < 8; ++ks) {
        const mx_u32x4 cw = cwv[ks]; mx_u32x4 pw = pwv[ks];
        { const unsigned sx = MX_ROW_SHRU(cw.x, 1), sy = MX_ROW_SHRU(cw.y, 1), sz = MX_ROW_SHRU(cw.z, 1), sw = MX_ROW_SHRU(cw.w, 1), tx = MX_ROW_RORU(pw.x, 1), ty = MX_ROW_RORU(pw.y, 1), tz = MX_ROW_RORU(pw.z, 1), tw = MX_ROW_RORU(pw.w, 1);
          pw.x = tk ? sx : tx; pw.y = tk ? sy : ty; pw.z = tk ? sz : tz; pw.w = tk ? sw : tw; }
        const mx_f32x4 m0 = *(const MX_L mx_f32x4*)(par + 32 * ks + 8 * g), m1 = *(const MX_L mx_f32x4*)(par + 32 * ks + 8 * g + 4);
        float x[8];
        x[0] = mx_lo(cw.x) + (mx_lo(pw.x) - mx_lo(cw.x)) * m0.x; x[1] = mx_hi(cw.x) + (mx_hi(pw.x) - mx_hi(cw.x)) * m0.y; x[2] = mx_lo(cw.y) + (mx_lo(pw.y) - mx_lo(cw.y)) * m0.z; x[3] = mx_hi(cw.y) + (mx_hi(pw.y) - mx_hi(cw.y)) * m0.w;
        x[4] = mx_lo(cw.z) + (mx_lo(pw.z) - mx_lo(cw.z)) * m1.x; x[5] = mx_hi(cw.z) + (mx_hi(pw.z) - mx_hi(cw.z)) * m1.y; x[6] = mx_lo(cw.w) + (mx_lo(pw.w) - mx_lo(cw.w)) * m1.z; x[7] = mx_hi(cw.w) + (mx_hi(pw.w) - mx_hi(cw.w)) * m1.w;
#pragma unroll
        for (int e = 0; e < 8; ++e) { if (ks < 2) x[e] = 2.f * MX_RCP(1.f + MX_EXP(-2.f * x[e])) - 1.f; else if (ks >= 4) x[e] = mx_sigmoid(x[e]); }
        const mx_bf16x8 bf = mx_frag8(x, x + 4);
#pragma unroll
        for (int ct = 0; ct < 4; ++ct) {
            if (ks < 2) accw[ct] = mx_mfma(*(const MX_L mx_bf16x8*)(lds + MX_LDS_WW + (16 * ct + tk) * MX_RS64 + (32 * ks + 8 * g) * 2), bf, accw[ct]);
            else if (ks < 4) acca[ct] = mx_mfma(*(const MX_L mx_bf16x8*)(lds + MX_LDS_WA + (16 * ct + tk) * MX_RS64 + (32 * (ks - 2) + 8 * g) * 2), bf, acca[ct]);
            else accg[ct] = mx_mfma(*(const MX_L mx_bf16x8*)(lds + MX_LDS_WG + (16 * ct + tk) * MX_RS128 + (32 * (ks - 4) + 8 * g) * 2), bf, accg[ct]);
        }
        MX_SCHED();
    }
    float lw[16], a[16], b[16], k2[16], r[16], v[16];
    {
        float zc[16], zp[16], pr[16];
        mx_load_parL(par + MX_P_A0, g, pr);
#pragma unroll
        for (int i = 0; i < 16; ++i) b[i] = mx_sigmoid(pr[i] + acca[i >> 2][i & 3]);
        mx_unpack16(kc, zc); mx_unpack16(mx_raw_prev(kc, kt_, tk, 1), zp); mx_load_parL(par + MX_P_MUK, g, pr);
#pragma unroll
        for (int i = 0; i < 16; ++i) k2[i] = zc[i] + (zp[i] - zc[i]) * pr[i];
        mx_load_parL(par + MX_P_KK, g, pr);
        float ss = 0.f;
#pragma unroll
        for (int i = 0; i < 16; ++i) { a[i] = k2[i] * pr[i]; ss += a[i] * a[i]; }
        ss = mx_rowsum4(ss);
        const float rn = MX_RSQ(ss + 1e-6f);
        mx_load_parL(par + MX_P_KA, g, pr);
#pragma unroll
        for (int i = 0; i < 16; ++i) { const float kk = a[i] * rn, ic = b[i]; b[i] = kk * ic; a[i] = -kk; k2[i] = k2[i] * (1.f + (ic - 1.f) * pr[i]); }
    }
    MX_SCHED();
    float bs = 0.f;
    {
        float zc[16], zp[16], pr[16];
        mx_unpack16(rc, zc); mx_unpack16(mx_raw_prev(rc, rt_, tk, 1), zp); mx_load_parL(par + MX_P_MUR, g, pr);
#pragma unroll
        for (int i = 0; i < 16; ++i) r[i] = zc[i] + (zp[i] - zc[i]) * pr[i];
        mx_load_parL(par + MX_P_RK, g, pr);
#pragma unroll
        for (int i = 0; i < 16; ++i) bs += r[i] * k2[i] * pr[i];
        bs = mx_rowsum4(bs);
    }
    MX_SCHED();
    {
        float zc[16], zp[16], pr[16];
        mx_unpack16(vc_, zc); mx_unpack16(mx_raw_prev(vc_, vt_, tk, 1), zp); mx_load_parL(par + MX_P_MUV, g, pr);
#pragma unroll
        for (int i = 0; i < 16; ++i) v[i] = zc[i] + (zp[i] - zc[i]) * pr[i];
        mx_load_parL(par + MX_P_LNW, g, pr);
#pragma unroll
        for (int i = 0; i < 16; ++i) zc[i] = accg[i >> 2][i & 3] * pr[i];
        mx_store_t16(gslot + MX_GB_GT, lane, zc);
        mx_load_parL(par + MX_P_LNB, g, pr);
#pragma unroll
        for (int i = 0; i < 16; ++i) zp[i] = (pr[i] + bs * v[i]) * accg[i >> 2][i & 3];
        mx_store_t16(gslot + MX_GB_EE, lane, zp);
    }
    MX_SCHED();
    {
        float pr[16];
        mx_load_parL(par + MX_P_W0, g, pr);
#pragma unroll
        for (int i = 0; i < 16; ++i) { const float u = pr[i] + accw[i >> 2][i & 3]; lw[i] = -0.60653065971263342f * mx_sigmoid(u); }
    }
    MX_SCHED();
    mx_prep_back(lw, a, b, k2, r, v, slot, gamp, midbar, lane);
}
MX_DEV void mx_prep_gdn(int l, int h, const MX_G unsigned short* zseq, int chunk, MX_L unsigned char* slot, MX_G unsigned char* gslot, MX_L unsigned char* gamp, bool midbar, const MX_L unsigned char* lds, int lane) {
    const int tk = lane & 15, g = lane >> 4, t = 16 * chunk + tk;
    const MX_G unsigned short* zrow = zseq + (size_t)t * ZP;
    const MX_L float* par = (const MX_L float*)(lds + MX_LDS_PAR);
    const MxRaw16 cq = mx_raw_t16(zrow + ZC_GD_Q + 64 * h, true, g), ck = mx_raw_t16(zrow + ZC_GD_K + 64 * h, true, g), cv = mx_raw_t16(zrow + ZC_GD_V + 64 * h, true, g);
    const MX_G unsigned short* ztail = zrow - (size_t)16 * ZP;
    const MxRaw16 tq = mx_raw_tail(ztail + ZC_GD_Q + 64 * h, 16 * chunk, tk, g), tk_ = mx_raw_tail(ztail + ZC_GD_K + 64 * h, 16 * chunk, tk, g), tv = mx_raw_tail(ztail + ZC_GD_V + 64 * h, 16 * chunk, tk, g);
    const MxRaw16 rg = mx_raw_t16(zrow + ZC_GD_G + 64 * h, true, g);
    const float bl = mx_lo((unsigned)zrow[ZC_GD_B + h]), al = mx_lo((unsigned)zrow[ZC_GD_A + h]);
    MX_SCHED();
    float q[16], k[16], v[16];
#pragma unroll
    for (int i = 0; i < 16; ++i) { q[i] = 0.f; k[i] = 0.f; v[i] = 0.f; }
#pragma unroll
    for (int d = 0; d < 4; ++d) {
        float x[16], w[16];
        if (d == 3) mx_unpack16(cq, x); else mx_unpack16(mx_raw_prev(cq, tq, tk, 3 - d), x);
        mx_load_parL(par + d * 192, g, w);
#pragma unroll
        for (int i = 0; i < 16; ++i) MX_FMAC(q[i], w[i], x[i]);
        if (d == 3) mx_unpack16(ck, x); else mx_unpack16(mx_raw_prev(ck, tk_, tk, 3 - d), x);
        mx_load_parL(par + d * 192 + 64, g, w);
#pragma unroll
        for (int i = 0; i < 16; ++i) MX_FMAC(k[i], w[i], x[i]);
        if (d == 3) mx_unpack16(cv, x); else mx_unpack16(mx_raw_prev(cv, tv, tk, 3 - d), x);
        mx_load_parL(par + d * 192 + 128, g, w);
#pragma unroll
        for (int i = 0; i < 16; ++i) MX_FMAC(v[i], w[i], x[i]);
        MX_SCHED();
    }
    float sq = 0.f, sk = 0.f;
#pragma unroll
    for (int i = 0; i < 16; ++i) { q[i] = q[i] * mx_sigmoid(q[i]); k[i] = k[i] * mx_sigmoid(k[i]); v[i] = v[i] * mx_sigmoid(v[i]); sq += q[i] * q[i]; sk += k[i] * k[i]; }
    sq = mx_rowsum4(sq); sk = mx_rowsum4(sk);
    const float rqn = 0.125f * MX_RSQ(sq + 1e-6f), rkn = MX_RSQ(sk + 1e-6f);
    const float beta = mx_sigmoid(bl);
    const float gl = -MX_EXP(MXIN(I_ALOG)[l * 4 + h]) * mx_softplus(al + MXIN(I_DTB)[l * 4 + h]);
    const float wb = -MX_EXP(gl) * beta;
    float lw[16], a[16], b[16];
#pragma unroll
    for (int i = 0; i < 16; ++i) { const float kn = k[i] * rkn; lw[i] = gl; a[i] = kn; b[i] = wb * kn; k[i] = kn; q[i] = q[i] * rqn; v[i] = beta * v[i]; }
    {
        float zg[16], pr[16], ee[16];
        mx_unpack16(rg, zg); mx_load_parL(par + MX_P_GNW, g, pr);
#pragma unroll
        for (int i = 0; i < 16; ++i) { zg[i] = pr[i] * (zg[i] * mx_sigmoid(zg[i])); ee[i] = 0.f; }
        mx_store_t16(gslot + MX_GB_GT, lane, zg); mx_store_t16(gslot + MX_GB_EE, lane, ee);
    }
    MX_SCHED();
    mx_prep_back(lw, a, b, k, q, v, slot, gamp, midbar, lane);
}
struct MxOps { mx_bf16x8 wa0, wa1, rt0, rt1; mx_u32x2 arb, ark, vc; mx_f32x4 u0; mx_f32x4 gm0, gm1, gm2, gm3; mx_u32x2 bh0, bh1, bh2, bh3, kh0, kh1, kh2, kh3; };
MX_DEV MxOps mx_scan_load(const MX_L unsigned char* slot, const MX_L unsigned char* gamp, int it, int lane) {
    const int g = lane >> 4;
    MxOps o;
    o.wa0 = *(const MX_L mx_bf16x8*)(slot + (unsigned)(MX_HB_WA + lane * 16)); o.wa1 = *(const MX_L mx_bf16x8*)(slot + (unsigned)(MX_HB_WA + 1024 + lane * 16));
    o.rt0 = *(const MX_L mx_bf16x8*)(slot + (unsigned)(MX_HB_RT + lane * 16)); o.rt1 = *(const MX_L mx_bf16x8*)(slot + (unsigned)(MX_HB_RT + 1024 + lane * 16));
    o.arb = *(const MX_L mx_u32x2*)(slot + (unsigned)(MX_HB_ARB + lane * 8)); o.ark = *(const MX_L mx_u32x2*)(slot + (unsigned)(MX_HB_ARK + lane * 8));
    o.vc = *(const MX_L mx_u32x2*)(slot + (unsigned)(MX_HB_VC + it * 512 + lane * 8));
    { const mx_u32x2 u = *(const MX_L mx_u32x2*)(slot + (unsigned)(MX_HB_U0 + it * 512 + lane * 8)); o.u0.x = mx_lo(u.x); o.u0.y = mx_hi(u.x); o.u0.z = mx_lo(u.y); o.u0.w = mx_hi(u.y); }
#define MX_LDJ(jt) do { o.gm##jt = *(const MX_L mx_f32x4*)(gamp + (unsigned)((16 * jt + 4 * g) * 4)); \
        o.bh##jt = *(const MX_L mx_u32x2*)(slot + (unsigned)(MX_HB_BH + jt * 512 + lane * 8)); o.kh##jt = *(const MX_L mx_u32x2*)(slot + (unsigned)(MX_HB_KH + jt * 512 + lane * 8)); } while (0)
    MX_LDJ(0); MX_LDJ(1); MX_LDJ(2); MX_LDJ(3);
#undef MX_LDJ
    return o;
}
MX_DEV mx_f32x4 mx_scan_compute(mx_f32x4 (&S)[4], const MxOps& o, int lane) {
    const int tk = lane & 15, g = lane >> 4;
    const mx_f32x4 z4 = mx_zero4();
    const mx_bf16x8 sb0 = mx_frag8v(S[0], S[1]), sb1 = mx_frag8v(S[2], S[3]);
    const mx_f32x4 U = mx_mfma(o.wa1, sb1, mx_mfma(o.wa0, sb0, o.u0));
    const mx_u32x2 ub = mx_frag4(U), vb = mx_frag4p(o.vc);
    mx_f32x4 Y = mx_mfma(o.rt1, sb1, mx_mfma(o.rt0, sb0, z4));
    Y = mx_mfma(mx_frag4p(o.ark), vb, mx_mfma(mx_frag4p(o.arb), ub, Y));
    S[0] = mx_mfma(mx_frag4p(o.kh0), vb, mx_mfma(mx_frag4p(o.bh0), ub, S[0] * o.gm0)); S[1] = mx_mfma(mx_frag4p(o.kh1), vb, mx_mfma(mx_frag4p(o.bh1), ub, S[1] * o.gm1));
    S[2] = mx_mfma(mx_frag4p(o.kh2), vb, mx_mfma(mx_frag4p(o.bh2), ub, S[2] * o.gm2)); S[3] = mx_mfma(mx_frag4p(o.kh3), vb, mx_mfma(mx_frag4p(o.bh3), ub, S[3] * o.gm3));
    mx_u32x2 selI = {0u, 0u};
    if ((tk >> 2) == g) { const unsigned one = (tk & 1) ? 0x3F800000u : 0x00003F80u; if ((tk & 3) >> 1) selI.y = one; else selI.x = one; }
    mx_f32x4 Yh, Yl;
#pragma unroll
    for (int e = 0; e < 4; ++e) { Yh[e] = __builtin_bit_cast(float, mx_bf(Y[e]) << 16); Yl[e] = Y[e] - Yh[e]; }
    return mx_mfma(mx_frag4(Yl), selI, mx_mfma(mx_frag4(Yh), selI, z4));
}
MX_DEV void mx_sequence(int l, int type, int h, const MX_G unsigned short* zseq, MX_G unsigned short* yseq  , int nchunks, MX_G unsigned char* gb  , MX_L unsigned char* lds, int wave,
                        int role, MX_G unsigned long long* xs, MX_G unsigned* flag, MX_G unsigned* tmo) {
    const int lane0 = mx_lane();
    {
        const int tid = wave * 64 + lane0;
        MX_L float* par = (MX_L float*)(lds + MX_LDS_PAR);
        if (type == 0) {
            const MX_G float* wup = MXIN(I_WUP) + l * 64 * 256 + 64 * h; const MX_G float* aup = MXIN(I_AUP) + l * 64 * 256 + 64 * h; const MX_G float* gup = MXIN(I_GUP) + l * 128 * 256 + 64 * h;
            for (int idx = tid; idx < 64 * 64; idx += 512) { const int ch = idx & 63, k = idx >> 6;
                *(MX_L unsigned short*)(lds + MX_LDS_WW + ch * MX_RS64 + k * 2) = (unsigned short)mx_bf(wup[k * 256 + ch]);
                *(MX_L unsigned short*)(lds + MX_LDS_WA + ch * MX_RS64 + k * 2) = (unsigned short)mx_bf(aup[k * 256 + ch]); }
            for (int idx = tid; idx < 64 * 128; idx += 512) { const int ch = idx & 63, k = idx >> 6;
                *(MX_L unsigned short*)(lds + MX_LDS_WG + ch * MX_RS128 + k * 2) = (unsigned short)mx_bf(gup[k * 256 + ch]); }
            const MX_G float* mu = MXIN(I_MU) + l * 1024;
            if (tid < 256) par[tid] = mu[ZC_RW_DW + tid];
            else if (tid < 448) { const int a = (tid - 256) >> 6, c = (tid - 256) & 63; par[tid] = mu[(a == 0 ? ZC_RW_R : (a == 1 ? ZC_RW_K : ZC_RW_V)) + 64 * h + c]; }
            if (tid < 448) { const int a = tid >> 6, c = tid & 63;
                const MX_G float* src = a == 0 ? MXIN(I_W0) : a == 1 ? MXIN(I_A0) : a == 2 ? MXIN(I_KK) : a == 3 ? MXIN(I_KA) : a == 4 ? MXIN(I_RK) : a == 5 ? MXIN(I_LNXW) : MXIN(I_LNXB);
                par[MX_P_W0 + tid] = src[l * 256 + 64 * h + c]; }
        } else {
            const MX_G float* cw = MXIN(I_CONV) + l * 4 * 768;
            for (int idx = tid; idx < 768; idx += 512) { const int d = idx / 192, a = (idx % 192) >> 6, c = idx & 63; par[idx] = cw[d * 768 + a * 256 + 64 * h + c]; }
            if (tid < 64) par[MX_P_GNW + tid] = MXIN(I_GNW)[l * 64 + tid];
        }
    }
    mx_wgsync();
    mx_f32x4 S[4];
#pragma unroll
    for (int jt = 0; jt < 4; ++jt) S[jt] = mx_zero4();
    MX_L float* st = (MX_L float*)(lds + MX_LDS_ST);
    typedef float mx_f32x2 __attribute__((ext_vector_type(2)));
    const int ngroups = nchunks / 8;
    for (int itr = role - 2; itr < ngroups; itr += 2) {
        int lane = lane0; MX_LAUNDER_V(lane);
        const int tk = lane & 15, g = lane >> 4;
        const bool scan_now = itr >= 0, more = itr + 2 < ngroups;
        const int par_c = (itr >> 1) & 1, par_n = ((itr + 2) >> 1) & 1;
        if (wave < 4 && scan_now) {
            MX_G unsigned char* gbp = gb + par_c * (8 * MX_GB_SLOT); MX_LAUNDER_S(gbp);
            const MX_L unsigned char* gamc = lds + MX_LDS_GAM + par_c * 2048;
            mx_f32x4 yk[8]; mx_u32x2 gtc[8], eec[8];
            if (itr > 0) {
                const unsigned want = 4u * (unsigned)itr;
                for (unsigned spins = 0;;) {
                    if ((unsigned)MX_UNIFORM(MX_FLAG_LOAD(flag)) >= want) break;
                    MX_SLEEP();
                    if (++spins > (1u << 20)) { if (lane == 0) MX_FLAG_STORE(tmo, 1u); break; }
                }
#pragma unroll
                for (int jt = 0; jt < 4; ++jt) { const MX_G unsigned long long* p = xs + (unsigned)(((wave * 4 + jt) * 64 + lane) * 2);
                    const unsigned long long a = MX_SC1_LOAD64(p), b = MX_SC1_LOAD64(p + 1);
                    mx_u32x4 w; w.x = (unsigned)a; w.y = (unsigned)(a >> 32); w.z = (unsigned)b; w.w = (unsigned)(b >> 32); S[jt] = __builtin_bit_cast(mx_f32x4, w); }
            }
#pragma unroll
            for (int c = 0; c < 8; ++c) {
                const MxOps o = mx_scan_load(lds + MX_LDS_HB + c * MX_HB_SLOT, gamc + c * 256, wave, lane);
                yk[c] = mx_scan_compute(S, o, lane);
                MX_SCHED();
            }
            if (itr + 1 < ngroups) {
#pragma unroll
                for (int jt = 0; jt < 4; ++jt) { MX_G unsigned long long* p = xs + (unsigned)(((wave * 4 + jt) * 64 + lane) * 2);
                    const mx_u32x4 w = __builtin_bit_cast(mx_u32x4, S[jt]);
                    MX_SC1_STORE64(p, (unsigned long long)w.x | ((unsigned long long)w.y << 32)); MX_SC1_STORE64(p + 1, (unsigned long long)w.z | ((unsigned long long)w.w << 32)); }
                MX_VMWAIT();
                if (lane == 0) MX_FLAG_ADD(flag, 1u);
            }
            unsigned pfw = 0u;
            if (more) {
                const MX_G unsigned short* zr = zseq + (size_t)(16 * (8 * (itr + 2) + 4 + wave) + tk) * ZP;
                if (type == 0) { pfw = *(const MX_G unsigned*)(zr + ZC_RW_DW + 64 * g); if (g < 3) pfw ^= *(const MX_G unsigned*)(zr + (g == 0 ? ZC_RW_R : (g == 1 ? ZC_RW_K : ZC_RW_V)) + 64 * h); }
                else { pfw = *(const MX_G unsigned*)(zr + (g == 0 ? ZC_GD_Q : (g == 1 ? ZC_GD_K : (g == 2 ? ZC_GD_V : ZC_GD_G))) + 64 * h); if (g == 0) pfw ^= *(const MX_G unsigned*)(zr + ZC_GD_B); }
            }
#pragma unroll
            for (int c = 0; c < 2; ++c) { const MX_G unsigned char* sl = gbp + c * MX_GB_SLOT;
                gtc[c] = *(const MX_G mx_u32x2*)(sl + (unsigned)(MX_GB_GT + wave * 512 + lane * 8)); eec[c] = *(const MX_G mx_u32x2*)(sl + (unsigned)(MX_GB_EE + wave * 512 + lane * 8)); }
#pragma unroll
            for (int c = 0; c < 8; ++c) {
                float s1 = (yk[c].x + yk[c].y) + (yk[c].z + yk[c].w), s2 = (yk[c].x * yk[c].x + yk[c].y * yk[c].y) + (yk[c].z * yk[c].z + yk[c].w * yk[c].w);
                s1 = mx_rowsum4(s1); s2 = mx_rowsum4(s2);
                if (g == 0) { mx_f32x2 p_; p_.x = s1; p_.y = s2; *(MX_L mx_f32x2*)(st + ((c * 4 + wave) * 16 + tk) * 2) = p_; }
            }
            MX_LDSWAIT(); mx_wgsync();
#pragma unroll
            for (int c = 2; c < 8; ++c) { const MX_G unsigned char* sl = gbp + c * MX_GB_SLOT;
                gtc[c] = *(const MX_G mx_u32x2*)(sl + (unsigned)(MX_GB_GT + wave * 512 + lane * 8)); eec[c] = *(const MX_G mx_u32x2*)(sl + (unsigned)(MX_GB_EE + wave * 512 + lane * 8)); }
#pragma unroll
            for (int c = 0; c < 8; ++c) {
                float s1 = 0.f, s2 = 0.f;
#pragma unroll
                for (int w = 0; w < 4; ++w) { const mx_f32x2 p_ = *(const MX_L mx_f32x2*)(st + ((c * 4 + w) * 16 + tk) * 2); s1 += p_.x; s2 += p_.y; }
                float mean, rstd;
                if (type == 0) { mean = s1 * (1.f / 64.f); const float var = fmaxf(s2 * (1.f / 64.f) - mean * mean, 0.f); rstd = MX_RSQ(var + 64e-5f); }
                else { mean = 0.f; rstd = MX_RSQ(s2 * (1.f / 64.f) + 1e-6f); }
                const float o0 = (yk[c].x - mean) * rstd * mx_lo(gtc[c].x) + mx_lo(eec[c].x), o1 = (yk[c].y - mean) * rstd * mx_hi(gtc[c].x) + mx_hi(eec[c].x);
                const float o2 = (yk[c].z - mean) * rstd * mx_lo(gtc[c].y) + mx_lo(eec[c].y), o3 = (yk[c].w - mean) * rstd * mx_hi(gtc[c].y) + mx_hi(eec[c].y);
                mx_u32x2 o; o.x = mx_pk2(o0, o1); o.y = mx_pk2(o2, o3);
                *(MX_G mx_u32x2*)(yseq + (size_t)(16 * (8 * itr + c) + tk) * DM + 16 * wave + 4 * g) = o;
            }
            MX_CONSUME(pfw);
        } else if (wave < 4) { mx_wgsync(); }
        MX_SCHED();
        if (more) {
            const int c = (wave < 4) ? wave + 4 : wave - 4;
            MX_G unsigned char* gbn = gb + par_n * (8 * MX_GB_SLOT) + c * MX_GB_SLOT; MX_LAUNDER_S(gbn);
            MX_L unsigned char* slot = lds + MX_LDS_HB + c * MX_HB_SLOT; MX_L unsigned char* gamn = lds + MX_LDS_GAM + par_n * 2048 + c * 256;
            if (type == 0) mx_prep_rwkv(l, h, zseq, 8 * (itr + 2) + c, slot, gbn, gamn, wave >= 4, lds, lane); else mx_prep_gdn(l, h, zseq, 8 * (itr + 2) + c, slot, gbn, gamn, wave >= 4, lds, lane);
        } else if (wave >= 4) { mx_wgsync(); }
        MX_VMWAIT(); MX_LDSWAIT(); mx_wgsync();
    }
}

MX_DEV void mx_attn_unit4(int kvh, int q0, const MX_G unsigned short* zseq  , MX_G unsigned short* yatt  ,
                          const MX_L float* btab_all  , float Mb, const float (&esink)[4]  , const float (&qkw)[16], MX_L unsigned char* vts  , int lane) {
    const int tk = lane & 15, g = lane >> 4;
    const mx_f32x4 z4 = mx_zero4();
    const MX_G unsigned short* qrow = zseq + (size_t)(q0 + tk) * ZP + ZC_AT_Q + 256 * kvh;
    mx_u32x4 qa = *(const MX_G mx_u32x4*)(qrow + 8 * g), qb = *(const MX_G mx_u32x4*)(qrow + 32 + 8 * g);
    mx_u32x4 kA[9], kB[9], vA[9], vB[9];
#pragma unroll
    for (int kt = 0; kt < 9; ++kt) {
        const int key0 = q0 - 128 + 16 * kt;
        if (key0 >= 0) {
            const MX_G unsigned short* krow = zseq + (size_t)(key0 + tk) * ZP + ZC_AT_K + 64 * kvh; const MX_G unsigned short* vrow = zseq + (size_t)(key0 + tk) * ZP + ZC_AT_V + 64 * kvh;
            kA[kt] = *(const MX_G mx_u32x4*)(krow + 8 * g); kB[kt] = *(const MX_G mx_u32x4*)(krow + 32 + 8 * g);
            const mx_u32x2 a_ = *(const MX_G mx_u32x2*)(vrow + 4 * g), b_ = *(const MX_G mx_u32x2*)(vrow + 16 + 4 * g), c_ = *(const MX_G mx_u32x2*)(vrow + 32 + 4 * g), d_ = *(const MX_G mx_u32x2*)(vrow + 48 + 4 * g);
            vA[kt].x = a_.x; vA[kt].y = a_.y; vA[kt].z = b_.x; vA[kt].w = b_.y; vB[kt].x = c_.x; vB[kt].y = c_.y; vB[kt].z = d_.x; vB[kt].w = d_.y;
        } else { const mx_u32x4 z_ = {0u, 0u, 0u, 0u}; kA[kt] = z_; kB[kt] = z_; vA[kt] = z_; vB[kt] = z_; }
    }
    MX_SCHED();
    mx_bf16x8 Sel[2];
#pragma unroll
    for (int p = 0; p < 2; ++p) { mx_u32x4 w = {0u, 0u, 0u, 0u};
        if ((tk >> 2) == g) { const unsigned one = (tk & 1) ? 0x3F800000u : 0x00003F80u; const int q = 2 * p + ((tk & 3) >> 1); w.x = (q == 0) ? one : 0u; w.y = (q == 1) ? one : 0u; w.z = (q == 2) ? one : 0u; w.w = (q == 3) ? one : 0u; }
        Sel[p] = __builtin_bit_cast(mx_bf16x8, w); }
    float rk[9];
#pragma unroll
    for (int kt = 0; kt < 9; ++kt) {
        float ssk = 0.f;
        { const unsigned kk[8] = {kA[kt].x, kA[kt].y, kA[kt].z, kA[kt].w, kB[kt].x, kB[kt].y, kB[kt].z, kB[kt].w};
#pragma unroll
          for (int i = 0; i < 8; ++i) { const float a = mx_lo(kk[i]), b = mx_hi(kk[i]); ssk += a * a + b * b; } }
        rk[kt] = MX_RSQ(mx_rowsum4(ssk) * (1.f / 64.f) + 1e-6f);
#pragma unroll
        for (int dt = 0; dt < 4; ++dt) *(MX_L mx_u32x2*)(vts + (unsigned)(((kt * 4 + dt) * 64 + lane) * 8)) = mx_pack4(mx_mfma(__builtin_bit_cast(mx_bf16x8, (dt >> 1) ? vB[kt] : vA[kt]), Sel[dt & 1], z4));
    }
    MX_LDSWAIT(); MX_SCHED();
    for (int hh = 0; hh < 4; ++hh) {
        const int h = 4 * kvh + hh;
        const mx_u32x4 cqa = qa, cqb = qb;
        if (hh < 3) { qa = *(const MX_G mx_u32x4*)(qrow + 64 * (hh + 1) + 8 * g); qb = *(const MX_G mx_u32x4*)(qrow + 64 * (hh + 1) + 32 + 8 * g); }
        const MX_L float* btab = btab_all + 128 * h;
        mx_bf16x8 QF[2];
        {
            float q[16]; float ss = 0.f;
            q[0] = mx_lo(cqa.x); q[1] = mx_hi(cqa.x); q[2] = mx_lo(cqa.y); q[3] = mx_hi(cqa.y); q[4] = mx_lo(cqa.z); q[5] = mx_hi(cqa.z); q[6] = mx_lo(cqa.w); q[7] = mx_hi(cqa.w);
            q[8] = mx_lo(cqb.x); q[9] = mx_hi(cqb.x); q[10] = mx_lo(cqb.y); q[11] = mx_hi(cqb.y); q[12] = mx_lo(cqb.z); q[13] = mx_hi(cqb.z); q[14] = mx_lo(cqb.w); q[15] = mx_hi(cqb.w);
#pragma unroll
            for (int i = 0; i < 16; ++i) ss += q[i] * q[i];
            ss = mx_rowsum4(ss);
            const float rs = MX_RSQ(ss * (1.f / 64.f) + 1e-6f);
#pragma unroll
            for (int i = 0; i < 16; ++i) q[i] = q[i] * rs * qkw[i];
            QF[0] = mx_frag8(q, q + 4); QF[1] = mx_frag8(q + 8, q + 12);
        }
        mx_f32x4 O[4];
#pragma unroll
        for (int dt = 0; dt < 4; ++dt) O[dt] = z4;
        float lsum = 0.f;
#pragma unroll
        for (int kt = 0; kt < 9; ++kt) {
            const int key0 = q0 - 128 + 16 * kt;
            const mx_f32x4 S = mx_mfma(__builtin_bit_cast(mx_bf16x8, kB[kt]), QF[1], mx_mfma(__builtin_bit_cast(mx_bf16x8, kA[kt]), QF[0], z4));
            mx_f32x4 P;
#pragma unroll
            for (int e = 0; e < 4; ++e) {
                const float rke = mx_shfl16l(rk[kt], 4 * g + e, lane);
                const int dist = (q0 + tk) - (key0 + 4 * g + e); const bool valid = (dist >= 0) && (dist < 128) && (key0 >= 0);
                float ex = MX_EXP(S[e] * rke + btab[dist & 127] - Mb); MX_LAUNDER_V(ex);
                P[e] = valid ? ex : 0.f; lsum += P[e];
            }
            const mx_u32x2 pf = mx_frag4(P);
#pragma unroll
            for (int dt = 0; dt < 4; ++dt) O[dt] = mx_mfma(mx_frag4p(*(const MX_L mx_u32x2*)(vts + (unsigned)(((kt * 4 + dt) * 64 + lane) * 8))), pf, O[dt]);
        }
        lsum = mx_rowsum4(lsum);
        const float inv = MX_RCP(lsum + esink[hh]);
        MX_G unsigned short* yrow = yatt + (size_t)(q0 + tk) * DM + 64 * h;
#pragma unroll
        for (int dt = 0; dt < 4; ++dt) { mx_u32x2 o; o.x = mx_pk2(O[dt].x * inv, O[dt].y * inv); o.y = mx_pk2(O[dt].z * inv, O[dt].w * inv); *(MX_G mx_u32x2*)(yrow + 16 * dt + 4 * g) = o; }
    }
}

__device__ __forceinline__ float wave_allmax(float v) {
    v = fmaxf(v, dppf(v, 0)); v = fmaxf(v, dppf(v, 1)); v = fmaxf(v, dppf(v, 2)); v = fmaxf(v, dppf(v, 3));
    const float a = __builtin_bit_cast(float, __builtin_amdgcn_readlane(__builtin_bit_cast(int, v), 0)), b = __builtin_bit_cast(float, __builtin_amdgcn_readlane(__builtin_bit_cast(int, v), 16));
    const float c = __builtin_bit_cast(float, __builtin_amdgcn_readlane(__builtin_bit_cast(int, v), 32)), d = __builtin_bit_cast(float, __builtin_amdgcn_readlane(__builtin_bit_cast(int, v), 48));
    return fmaxf(fmaxf(a, b), fmaxf(c, d));
}
__device__ __forceinline__ void mixer_phase(Frame& F, int l) {
    const int blk = blockIdx.x;
    {
        const int lane = ltid() & 63;
        const LAS float* btab_all = (const LAS float*)(F.lds + BIAS_OFF);
        float mb = 0.f;
#pragma unroll
        for (int i = 0; i < 16; ++i) mb = fmaxf(mb, fabsf(btab_all[lane + 64 * i]));
        const float Mb = 8.f * wave_allmax(fabsf(MXIN(I_QNW)[l * 64 + lane])) * wave_allmax(fabsf(MXIN(I_KNW)[l * 64 + lane])) + wave_allmax(mb);
        const int pair = blk >> 3, seg = blk & 7, b = pair >> 1, kvh = pair & 1;
        float esink[4];
#pragma unroll
        for (int hh = 0; hh < 4; ++hh) esink[hh] = __expf(MXIN(I_SINK)[l * 8 + 4 * kvh + hh] - Mb);
        float qkw[16];
#pragma unroll
        for (int i = 0; i < 16; ++i) { const int d = 32 * (i >> 3) + 8 * (lane >> 4) + (i & 7); qkw[i] = 0.125f * MXIN(I_QNW)[l * 64 + d] * MXIN(I_KNW)[l * 64 + d]; }
        const MX_G unsigned short* zseq = (const MX_G unsigned short*)FZ + (size_t)b * SEQ * ZP;
        MX_G unsigned short* yatt = (MX_G unsigned short*)FY + (size_t)b * SEQ * DM + 512;
        for (int i = 0; i < 2; ++i) {
            const int qt = 16 * seg + F.wave + 8 * i;
            int ln = lane; MX_LAUNDER_V(ln);
            mx_attn_unit4(kvh, 16 * qt, zseq, yatt, btab_all, Mb, esink, qkw, F.lds + RING_OFF + F.wave * 18432, ln);
        }
    }
    __syncthreads();
    {
        const int seq = blk & 127, role = blk >> 7, type = seq >> 6, bh = seq & 63, b = bh >> 2, h = bh & 3;
        const MX_G unsigned short* zseq = (const MX_G unsigned short*)FZ + (size_t)b * SEQ * ZP;
        MX_G unsigned short* yseq = (MX_G unsigned short*)FY + (size_t)b * SEQ * DM + type * 256 + 64 * h;
        MX_G unsigned* ctlw = (MX_G unsigned*)WSP(WS_CTL);
        mx_sequence(l, type, h, zseq, yseq, SEQ / 16, (MX_G unsigned char*)WSP(WS_HB) + (size_t)blk * (2 * 8 * MX_GB_SLOT), F.lds + RING_OFF, F.wave,
                    role, (MX_G unsigned long long*)WSP(WS_XS) + (size_t)seq * 2048, ctlw + CW_SEQ + (l * 128 + seq) * 64, ctlw + CW_TMO);
    }
}
constexpr int PH_PER_L = 5, NPH = 1 + DEPTH * PH_PER_L;
struct Args { const float* in[26]; float* out; unsigned char* ws; int ph_lo, ph_hi; };
__global__ void __launch_bounds__(NWAVES * 64, 2) fwd(Args args) {
    extern __shared__ __attribute__((aligned(16))) unsigned char lds[];
    Frame F;
    F.lds = (LAS unsigned char*)lds;
    const int tid0 = threadIdx.x; F.wave = __builtin_amdgcn_readfirstlane(tid0 >> 6);
    F.G = gridDim.x; { const int bx = blockIdx.x; F.vcu = (F.G % 8 == 0) ? (bx % 8) * (F.G / 8) + bx / 8 : bx; }
    F.ws = args.ws; F.out = args.out;
    for (int u = tid0; u < (BIAS_OFF - LDSCTL_OFF) / 4; u += NWAVES * 64) ((LAS unsigned*)(F.lds + LDSCTL_OFF))[u] = 0u;
    for (int u = tid0; u < 8 * 128; u += NWAVES * 64) {
        const int h = u >> 7, d = u & 127;
        int bucket;
        if (d < 16) bucket = d;
        else { int lg = 16 + (int)(logf((float)d / 16.f) / logf(8.f) * 16.f); bucket = lg < 31 ? lg : 31; }
        ((LAS float*)(F.lds + BIAS_OFF))[u] = INP(I_RELB)[bucket * 8 + h];
    }
    __syncthreads();
    const int lo = args.ph_lo, hi = args.ph_hi;
    const bool one = (hi - lo) > 1;
    XcdBarrier bar; bar.bar = (unsigned*)(F.ws + WS_CTL) + CW_BAR; bar.x = 0; bar.st = nullptr;
    if (one) bar = xcd_barrier_post((unsigned*)(F.ws + WS_CTL) + CW_BAR, (volatile LAS unsigned*)(F.lds + MISC_OFF) + 8, tid0 == 0);
#define IN(k) (lo <= (k) && (k) < hi)
#define SEAM(k) do { if (IN(k) && IN((k) + 1)) { XcdBarrier b2_ = bar; asm volatile("" : "+s"(b2_.bar)); xcd_barrier(b2_, F.wave == 0 && hw_lane() == 0); } } while (0)

    #ifndef DIS_PRO
    if (IN(0)) { p0_prologue(F); SEAM(0); }
#endif
    for (int l = 0; l < DEPTH; ++l) {
        const int pb = 1 + PH_PER_L * l;
        if (IN(pb + 0)) {
            pg8::Gemm g{FXN, ((bf16*)WSP(WS_WIN)) + (size_t)l * ZP * DM, M, ZP, DM}; pg8::StaticOrder S; S.init(M, ZP, F.G, (int)blockIdx.x);
            pg8::EpiBf16<0> E{FZ, ZP, (const float*)WSP(WS_RSS) + (size_t)(2 * l) * M * 16};
            pg8::gemm_phase<pg8::EpiBf16<0>, pg8::StaticOrder, true, true>(F.lds + RING_OFF, g, S, E, F.wave);
            SEAM(pb + 0);
        }
        if (IN(pb + 1)) { mixer_phase(F, l); SEAM(pb + 1); }
        if (IN(pb + 2)) {
            pg8::Gemm g{FY, ((bf16*)WSP(WS_WOUT)) + (size_t)l * DM * DM, M, DM, DM}; pg8::StaticOrder S; S.init(M, DM, F.G, (int)blockIdx.x);
            pg8::EpiResBf16 E{FXN, DM, (float*)nullptr, (float*)WSP(WS_RSS) + (size_t)(2 * l + 1) * M * 16};
            pg8::gemm_phase<pg8::EpiResBf16, pg8::StaticOrder, true, true>(F.lds + RING_OFF, g, S, E, F.wave);
            SEAM(pb + 2);
        }
        if (IN(pb + 3)) {
            pg8::Gemm g{FXN, ((bf16*)WSP(WS_W1)) + (size_t)l * DFF * DM, M, DFF, DM}; pg8::StaticOrder S; S.init(M, DFF, F.G, (int)blockIdx.x);
            pg8::EpiBf16<2> E{FH, DFF, (const float*)WSP(WS_RSS) + (size_t)(2 * l + 1) * M * 16};
            pg8::gemm_phase<pg8::EpiBf16<2>, pg8::StaticOrder, true, true>(F.lds + RING_OFF, g, S, E, F.wave);
            SEAM(pb + 3);
        }
        if (IN(pb + 4)) {
            pg8::Gemm g{FH, ((bf16*)WSP(WS_W2)) + (size_t)l * DM * DFF, M, DM, DFF}; pg8::StaticOrder S; S.init(M, DM, F.G, (int)blockIdx.x);
            pg8::EpiResBf16 E{FXN, DM, l + 1 < DEPTH ? (float*)nullptr : F.out, l + 1 < DEPTH ? (float*)WSP(WS_RSS) + (size_t)(2 * l + 2) * M * 16 : (float*)nullptr};
            pg8::gemm_phase<pg8::EpiResBf16, pg8::StaticOrder, true, true>(F.lds + RING_OFF, g, S, E, F.wave);
            SEAM(pb + 4);
        }
    }
#undef IN
#undef SEAM
}

#ifndef MK_ONE_LAUNCH
#define MK_ONE_LAUNCH 1
#endif
extern "C" void kernel_launch(void* const* d_in, const int* in_sizes, int n_in, void* d_out, int out_size, void* d_ws, size_t ws_size, hipStream_t stream) {
    static int grid = 0;
    if (grid == 0) {
        if (n_in != 26 || in_sizes[0] != M * DM || out_size != M * DM || ws_size < WS_END) { fprintf(stderr, "kernel_launch: unexpected shapes (n_in %d, in0 %d, out %d, ws %zu, need %zu)\n", n_in, n_in > 0 ? in_sizes[0] : -1, out_size, ws_size, (size_t)WS_END); grid = -1; return; }
        int dev = 0, cus = 0, per_cu = 0;
        if (hipGetDevice(&dev) != hipSuccess || hipDeviceGetAttribute(&cus, hipDeviceAttributeMultiprocessorCount, dev) != hipSuccess) { grid = -1; return; }
        if (hipFuncSetAttribute((const void*)fwd, hipFuncAttributeMaxDynamicSharedMemorySize, LDS_BYTES) != hipSuccess) { fprintf(stderr, "kernel_launch: hipFuncSetAttribute failed\n"); grid = -1; return; }
        if (hipOccupancyMaxActiveBlocksPerMultiprocessor(&per_cu, (const void*)fwd, NWAVES * 64, LDS_BYTES) != hipSuccess || per_cu < 1) fprintf(stderr, "kernel_launch: occupancy query reports %d\n", per_cu);
        (void)hipGetLastError();
        grid = cus;
    }
    if (grid < 0) return;
    if (hipMemsetAsync((char*)d_ws + WS_CTL, 0, CTL_ZERO_BYTES, stream) != hipSuccess) return;
    Args a{};
    for (int i = 0; i < 26; ++i) a.in[i] = (const float*)d_in[i];
    a.out = (float*)d_out; a.ws = (unsigned char*)d_ws;
#if MK_ONE_LAUNCH
    a.ph_lo = 0; a.ph_hi = NPH;
    hipLaunchKernelGGL(fwd, dim3(grid), dim3(NWAVES * 64), LDS_BYTES, stream, a);
#else
    for (int ph = 0; ph < NPH; ++ph) {
        a.ph_lo = ph; a.ph_hi = ph + 1;
        hipLaunchKernelGGL(fwd, dim3(grid), dim3(NWAVES * 64), LDS_BYTES, stream, a);
    }
#endif
}
```

```cpp
#include <hip/hip_runtime.h>
#include <cstdio>
#include <cstdint>
#include <cmath>
#include <type_traits>
__device__ __forceinline__ int hwl_() { int t; asm volatile("v_mbcnt_lo_u32_b32 %0, -1, 0\n\tv_mbcnt_hi_u32_b32 %0, -1, %0" : "=v"(t)); return t; }
__device__ __forceinline__ float xor16f(float v) { return __builtin_bit_cast(float, __builtin_amdgcn_ds_swizzle(__builtin_bit_cast(int, v), 0x401F)); }
__device__ __forceinline__ float xor32f(float v) { return __builtin_bit_cast(float, __builtin_amdgcn_ds_bpermute((hwl_() ^ 32) << 2, __builtin_bit_cast(int, v))); }
namespace pg8 {
#define PG8_LAS __attribute__((address_space(3)))
typedef unsigned short bf16_t;
typedef short bf16x8 __attribute__((ext_vector_type(8)));
typedef float f32x4 __attribute__((ext_vector_type(4)));
typedef unsigned u32x4 __attribute__((ext_vector_type(4)));
constexpr int BM = 256, BK = 64, HALF = 128, HTB = HALF * BK * 2  , STAGE_BYTES = 8 * HTB, NXCD = 8, WGM = 8;

__host__ __device__ __forceinline__ int lds_byte(int r, int c) { const int st = (r >> 4) * 2 + (c >> 5), rr = r & 15, cc = c & 31, ob = rr * 64 + cc * 2; return st * 1024 + (ob ^ (((ob >> 9) & 1) << 5)); }
__host__ __device__ __forceinline__ size_t tiled_byte(int row, int col, int nt) { return ((size_t)((row >> 8) * nt + (col >> 6)) * 2 + ((row >> 7) & 1)) * 16384 + lds_byte(row & 127, col & 63); }
__host__ __device__ __forceinline__ void stage_rc(int b, int& R, int& C) { const int st = b / 1024, sb = b % 1024, swz = sb ^ (((sb >> 9) & 1) << 5); R = (st >> 1) * 16 + swz / 64; C = (st & 1) * 32 + (swz % 64) / 2; }
__host__ __device__ __forceinline__ int perm32(int rho) { const int n = rho >> 4, i = rho & 15; return 8 * (i >> 2) + 4 * n + (i & 3); }

struct Unit { int pm, pn; };
struct Gemm { const bf16_t* A; const bf16_t* Bt; int M, N, K; };

struct StaticOrder {
    int nM, nN, nwg, G, c;
    __host__ __device__ void init(int M, int N, int G_, int c_) { nM = M / BM; nN = N / BM; nwg = nM * nN; G = G_; c = c_; }
    __host__ __device__ bool next(int i, Unit& u) const {
        const long L = (long)i * G + c; if (L >= nwg) return false;
        int wgid = (int)L; { const int q = nwg / NXCD, r = nwg % NXCD, xcd = wgid % NXCD, off = wgid / NXCD; wgid = (xcd < r ? xcd * (q + 1) : r * (q + 1) + (xcd - r) * q) + off; }
        const int nig = WGM * nN, gid = wgid / nig, fm = gid * WGM, gsz = (nM - fm) < WGM ? (nM - fm) : WGM;
        u.pm = fm + ((wgid % nig) % gsz); u.pn = (wgid % nig) / gsz; return true;
    }
    __device__ __forceinline__ void a_ready(const Unit&) const {}
    __device__ __forceinline__ void done(const Unit&) const {}
};

__device__ __forceinline__ unsigned cvt_pk_bf16(float lo, float hi) { unsigned r; asm volatile("v_cvt_pk_bf16_f32 %0, %1, %2" : "=v"(r) : "v"(lo), "v"(hi)); return r; }
#define PG8_GAS __attribute__((address_space(1)))
template <int ACT  , bool ZB = false  > struct EpiBf16 {
    static constexpr bool PERM = true, AFTER_DRAIN = false;
    static constexpr int NST = 16;
    bf16_t* O; int ldc; const float* rss;
    __device__ __forceinline__ void operator()(const f32x4 (&acc)[2][2][4][2], const Unit& u, int wr, int wc, int fr, int fq) const {
        const int row0 = u.pm * BM + wr * 64 + fr, col0 = u.pn * BM + wc * 32 + 8 * fq;
        float rs[8];
        { f32x4 pr[8];
#pragma unroll
          for (int r = 0; r < 8; ++r) pr[r] = *(const PG8_GAS f32x4*)(rss + (size_t)(row0 + (r >> 2) * HALF + (r & 3) * 16) * 16 + 4 * fq);
          __builtin_amdgcn_sched_barrier(0);
#pragma unroll
          for (int r = 0; r < 8; ++r) { float ssum = (pr[r][0] + pr[r][1]) + (pr[r][2] + pr[r][3]); ssum += ::xor16f(ssum); ssum += ::xor32f(ssum); rs[r] = __builtin_amdgcn_rsqf(ssum * (1.f / 1024.f) + 1e-6f); } }
#pragma unroll
        for (int ai = 0; ai < 2; ++ai)
#pragma unroll
            for (int m = 0; m < 4; ++m) { const int row = row0 + ai * HALF + m * 16; const float rsr = rs[ai * 4 + m];
                bf16_t* rowp = ZB ? O + ((size_t)(row >> 4) * (ldc / 64) + (col0 >> 6)) * 1024 + ((col0 >> 5) & 1) * 512 + (row & 15) * 32 + (col0 & 31) : (bf16_t*)((char*)O + tiled_byte(row, col0, ldc >> 6));
#pragma unroll
                for (int bj = 0; bj < 2; ++bj) { f32x4 v0 = acc[ai][bj][m][0] * rsr, v1 = acc[ai][bj][m][1] * rsr;
                    if (ACT == 2) {
#pragma unroll
                        for (int e = 0; e < 4; ++e) { const float a = v0[e] > 0.f ? v0[e] : 0.f, b = v1[e] > 0.f ? v1[e] : 0.f; v0[e] = a * a; v1[e] = b * b; } }
                    u32x4 w; w.x = cvt_pk_bf16(v0[0], v0[1]); w.y = cvt_pk_bf16(v0[2], v0[3]); w.z = cvt_pk_bf16(v1[0], v1[1]); w.w = cvt_pk_bf16(v1[2], v1[3]);
                    *(PG8_GAS u32x4*)(rowp + (ZB ? bj * (HALF / 64) * 1024 : bj * (HALF / 64) * 2 * 8192)) = w; } }
    }
};
struct EpiResF32 {
    static constexpr bool PERM = true, AFTER_DRAIN = false;
    static constexpr int NST = 16;
    const float* base; float* out; int ldc; bf16_t* xn; float* rss;
    __device__ __forceinline__ void operator()(const f32x4 (&acc)[2][2][4][2], const Unit& u, int wr, int wc, int fr, int fq) const {
        const int row0 = u.pm * BM + wr * 64 + fr, col0 = u.pn * BM + wc * 32 + 8 * fq;
#pragma unroll
        for (int ai = 0; ai < 2; ++ai)
#pragma unroll
            for (int m = 0; m < 4; ++m) { const int row = row0 + ai * HALF + m * 16; const size_t off = (size_t)row * ldc + col0; float ss = 0.f;
#pragma unroll
                for (int bj = 0; bj < 2; ++bj) {
                    const f32x4 b0 = *(const PG8_GAS f32x4*)(base + off + bj * HALF), b1 = *(const PG8_GAS f32x4*)(base + off + bj * HALF + 4);
                    const f32x4 o0 = b0 + acc[ai][bj][m][0], o1 = b1 + acc[ai][bj][m][1];
                    *(PG8_GAS f32x4*)(out + off + bj * HALF) = o0; *(PG8_GAS f32x4*)(out + off + bj * HALF + 4) = o1;
                    if (xn) { u32x4 w; w.x = cvt_pk_bf16(o0[0], o0[1]); w.y = cvt_pk_bf16(o0[2], o0[3]); w.z = cvt_pk_bf16(o1[0], o1[1]); w.w = cvt_pk_bf16(o1[2], o1[3]); *(PG8_GAS u32x4*)(xn + off + bj * HALF) = w;
                        ss += ((o0[0] * o0[0] + o0[1] * o0[1]) + (o0[2] * o0[2] + o0[3] * o0[3])) + ((o1[0] * o1[0] + o1[1] * o1[1]) + (o1[2] * o1[2] + o1[3] * o1[3])); } }
                if (xn) { ss += ::xor16f(ss); ss += ::xor32f(ss); if (fq == 0) *(PG8_GAS float*)(rss + (size_t)row * 16 + 4 * u.pn + wc) = ss; } }
    }
};

struct EpiResBf16 {
    static constexpr bool PERM = true, AFTER_DRAIN = false;
    static constexpr int NST = 32;
    bf16_t* x; int ldc; float* outf; float* rss;
    __device__ __forceinline__ void operator()(const f32x4 (&acc)[2][2][4][2], const Unit& u, int wr, int wc, int fr, int fq) const {
        const int row0 = u.pm * BM + wr * 64 + fr, col0 = u.pn * BM + wc * 32 + 8 * fq;
        const int ntx = ldc >> 6; constexpr size_t XH = (size_t)(HALF / 64) * 2 * 8192;
        u32x4 bv[8][2];
#pragma unroll
        for (int r = 0; r < 8; ++r) { const char* bp_ = (const char*)x + tiled_byte(row0 + (r >> 2) * HALF + (r & 3) * 16, col0, ntx); bv[r][0] = *(const PG8_GAS u32x4*)(bp_); bv[r][1] = *(const PG8_GAS u32x4*)(bp_ + 2 * XH); }
        __builtin_amdgcn_sched_barrier(0);
#pragma unroll
        for (int r = 0; r < 8; ++r) { const int ai = r >> 2, m = r & 3; const int row = row0 + ai * HALF + m * 16; const size_t off = (size_t)row * ldc + col0; float ss = 0.f;
#pragma unroll
            for (int bj = 0; bj < 2; ++bj) {
                const u32x4 b = bv[r][bj];
                f32x4 o0, o1;
                o0[0] = __builtin_bit_cast(float, b.x << 16) + acc[ai][bj][m][0][0]; o0[1] = __builtin_bit_cast(float, b.x & 0xffff0000u) + acc[ai][bj][m][0][1];
                o0[2] = __builtin_bit_cast(float, b.y << 16) + acc[ai][bj][m][0][2]; o0[3] = __builtin_bit_cast(float, b.y & 0xffff0000u) + acc[ai][bj][m][0][3];
                o1[0] = __builtin_bit_cast(float, b.z << 16) + acc[ai][bj][m][1][0]; o1[1] = __builtin_bit_cast(float, b.z & 0xffff0000u) + acc[ai][bj][m][1][1];
                o1[2] = __builtin_bit_cast(float, b.w << 16) + acc[ai][bj][m][1][2]; o1[3] = __builtin_bit_cast(float, b.w & 0xffff0000u) + acc[ai][bj][m][1][3];
                if (outf) { *(PG8_GAS f32x4*)(outf + off + bj * HALF) = o0; *(PG8_GAS f32x4*)(outf + off + bj * HALF + 4) = o1; }
                else { u32x4 w; w.x = cvt_pk_bf16(o0[0], o0[1]); w.y = cvt_pk_bf16(o0[2], o0[3]); w.z = cvt_pk_bf16(o1[0], o1[1]); w.w = cvt_pk_bf16(o1[2], o1[3]); *(PG8_GAS u32x4*)((char*)x + tiled_byte(row, col0, ntx) + bj * 2 * XH) = w;
                    ss += ((o0[0] * o0[0] + o0[1] * o0[1]) + (o0[2] * o0[2] + o0[3] * o0[3])) + ((o1[0] * o1[0] + o1[1] * o1[1]) + (o1[2] * o1[2] + o1[3] * o1[3])); } }
            if (!outf) { ss += ::xor16f(ss); ss += ::xor32f(ss); if (fq == 0) *(PG8_GAS float*)(rss + (size_t)row * 16 + 4 * u.pn + wc) = ss; } }
    }
};
template <int N> __device__ __forceinline__ void wait_v8_or(int relaxed) { static_assert(N > 8 && N <= 63, "vmcnt is 6 bits");
    asm volatile("s_cmp_lg_u32 %0, 0\n\ts_cbranch_scc1 .Lpg8wv%=\n\ts_waitcnt vmcnt(8)\n.Lpg8wv%=:\n\ts_waitcnt vmcnt(%1)" :: "s"(relaxed), "n"(N) : "memory", "scc"); }
template <class Epi, class Sched, bool ALIGN_EPI = false, bool SP2 = false>
__device__ __forceinline__ void gemm_phase(PG8_LAS unsigned char* lds, const Gemm g, const Sched& S, const Epi& E, const int wave_id  ) {
    int tid_l = wave_id * 64 + ::hwl_();
    const int tid = tid_l, wid = __builtin_amdgcn_readfirstlane(tid >> 6), lane = tid & 63, wr = wid >> 2, wc = wid & 3, fr = lane & 15, fq = lane >> 4;
    const int K = g.K, nt = K / BK;
    unsigned voffA[2], voffB[2];
#pragma unroll
    for (int i = 0; i < 2; ++i) { int R, C; stage_rc(tid * 16 + i * 8192, R, C); const int Rb = Epi::PERM ? ((R & ~31) + perm32(R & 31)) : R;
        voffA[i] = (unsigned)(tid * 16 + i * 8192); voffB[i] = voffA[i]; (void)Rb; (void)R; (void)C; }
    const size_t kstep = 2 * HTB;
    const size_t hstep = HTB;
    const size_t tstep = (size_t)nt * 2 * HTB;
    const size_t kstepB = 2 * HTB, hstepB = HTB, tstepB = (size_t)nt * 2 * HTB;
    const unsigned ldsw = (unsigned)wid * 1024u;
    const int aoff = lds_byte(wr * 64 + fr, fq * 8), boff = lds_byte(wc * 32 + fr, fq * 8);
#define PG8_SA(b, h) (((b) * 2 + (h)) * HTB)
#define PG8_SB(b, h) ((4 + (b) * 2 + (h)) * HTB)
#define PG8_STAGE(bufoff, gbase, voff) do { _Pragma("unroll") for (int _i = 0; _i < 2; ++_i) \
        __builtin_amdgcn_global_load_lds((const unsigned*)((const char*)(gbase) + (voff)[_i]), (PG8_LAS unsigned*)(lds + (bufoff) + ldsw + _i * 8192), 16, 0, 0); } while (0)
#define PG8_LDA(dst, b, h) do { _Pragma("unroll") for (int m = 0; m < 4; ++m) _Pragma("unroll") for (int k = 0; k < 2; ++k) dst[m][k] = *(const PG8_LAS bf16x8*)(lds + PG8_SA(b, h) + aoff + m * 2048 + k * 1024); } while (0)
#define PG8_LDB(dst, b, h) do { _Pragma("unroll") for (int n = 0; n < 2; ++n) _Pragma("unroll") for (int k = 0; k < 2; ++k) dst[n][k] = *(const PG8_LAS bf16x8*)(lds + PG8_SB(b, h) + boff + n * 2048 + k * 1024); } while (0)
#define PG8_MMA(ai, bj, At, Bt) do { __builtin_amdgcn_s_setprio(1); _Pragma("unroll") for (int m = 0; m < 4; ++m) _Pragma("unroll") for (int n = 0; n < 2; ++n) _Pragma("unroll") for (int k = 0; k < 2; ++k) \
        acc[ai][bj][m][n] = __builtin_amdgcn_mfma_f32_16x16x32_bf16(Bt[n][k], At[m][k], acc[ai][bj][m][n], 0, 0, 0); __builtin_amdgcn_s_setprio(0); } while (0)
#define PG8_WAIT_V(n) asm volatile("s_waitcnt vmcnt(" #n ")" ::: "memory")
#define PG8_WAIT_L(n) asm volatile("s_waitcnt lgkmcnt(" #n ")" ::: "memory")
#define PG8_BAR __builtin_amdgcn_s_barrier()
#define PG8_SCHED __builtin_amdgcn_sched_barrier(0)
    Unit cur, nxt; int ui = 0;
    if (!S.next(0, cur)) return;
    f32x4 acc[2][2][4][2];
#pragma unroll
    for (int a = 0; a < 2; ++a)
#pragma unroll
        for (int b = 0; b < 2; ++b)
#pragma unroll
            for (int m = 0; m < 4; ++m)
#pragma unroll
                for (int n = 0; n < 2; ++n) acc[a][b][m][n] = (f32x4){0.f, 0.f, 0.f, 0.f};
    bf16x8 At[4][2], B0[2][2], B1[2][2];
    const char* cA = (const char*)g.A + (size_t)cur.pm * tstep; const char* cB = (const char*)g.Bt + (size_t)cur.pn * tstepB;
    S.a_ready(cur);
    if constexpr (SP2) {
        PG8_STAGE(PG8_SB(0, 0), cB, voffB); PG8_STAGE(PG8_SB(0, 1), cB + hstepB, voffB); PG8_STAGE(PG8_SA(0, 0), cA, voffA); PG8_STAGE(PG8_SA(0, 1), cA + hstep, voffA);
        if (wr == 1) PG8_BAR;
        PG8_WAIT_V(2); PG8_BAR;
        PG8_STAGE(PG8_SB(1, 0), cB + kstepB, voffB); PG8_STAGE(PG8_SA(1, 0), cA + kstep, voffA); PG8_STAGE(PG8_SB(1, 1), cB + hstepB + kstepB, voffB);
        PG8_WAIT_V(6); PG8_BAR;
    } else {
        PG8_STAGE(PG8_SB(0, 0), cB, voffB); PG8_STAGE(PG8_SA(0, 0), cA, voffA); PG8_STAGE(PG8_SB(0, 1), cB + hstepB, voffB); PG8_STAGE(PG8_SA(0, 1), cA + hstep, voffA);
        if (wr == 1) PG8_BAR;
        PG8_WAIT_V(4); PG8_BAR;
        PG8_STAGE(PG8_SB(1, 0), cB + kstepB, voffB); PG8_STAGE(PG8_SA(1, 0), cA + kstep, voffA); PG8_STAGE(PG8_SB(1, 1), cB + hstepB + kstepB, voffB);
        PG8_WAIT_V(6); PG8_BAR;
    }
    for (;;) {
        const bool has_next = S.next(ui + 1, nxt);
        const char* nA = has_next ? (const char*)g.A + (size_t)nxt.pm * tstep : cA; const char* nB = has_next ? (const char*)g.Bt + (size_t)nxt.pn * tstepB : cB;
        for (int t = 0; t < nt; t += 2) {
            const bool last = (t == nt - 2);
            const char* a1 = cA + (size_t)(t + 1) * kstep;
            const char* a2 = last ? nA : cA + (size_t)(t + 2) * kstep; const char* b2 = last ? nB : cB + (size_t)(t + 2) * kstepB;
            const char* a3 = a2 + kstep; const char* b3 = b2 + kstepB;
            if (last && has_next) S.a_ready(nxt);
            if constexpr (SP2) {
            const int relaxed = __builtin_amdgcn_readfirstlane((t == 0 && ui > 0) ? 1 : 0);
            PG8_LDB(B0, 0, 0); PG8_LDB(B1, 0, 1); PG8_SCHED; PG8_LDA(At, 0, 0); PG8_STAGE(PG8_SA(1, 1), a1 + hstep, voffA);
            wait_v8_or<8 + Epi::NST>(relaxed); PG8_WAIT_L(0); PG8_BAR; PG8_MMA(0, 0, At, B0); PG8_MMA(0, 1, At, B1); PG8_BAR; PG8_SCHED;
            PG8_LDA(At, 0, 1); PG8_STAGE(PG8_SB(0, 0), b2, voffB); PG8_STAGE(PG8_SB(0, 1), b2 + hstepB, voffB); PG8_STAGE(PG8_SA(0, 0), a2, voffA);
            wait_v8_or<8 + Epi::NST>(relaxed); PG8_WAIT_L(0); PG8_BAR; PG8_MMA(1, 0, At, B0); PG8_MMA(1, 1, At, B1); PG8_BAR; PG8_SCHED;
            PG8_LDB(B0, 1, 0); PG8_LDB(B1, 1, 1); PG8_SCHED; PG8_LDA(At, 1, 0); PG8_STAGE(PG8_SA(0, 1), a2 + hstep, voffA);
            PG8_WAIT_V(8); PG8_WAIT_L(0); PG8_BAR; PG8_MMA(0, 0, At, B0); PG8_MMA(0, 1, At, B1); PG8_BAR; PG8_SCHED;
            PG8_LDA(At, 1, 1); PG8_STAGE(PG8_SB(1, 0), b3, voffB); PG8_STAGE(PG8_SB(1, 1), b3 + hstepB, voffB); PG8_STAGE(PG8_SA(1, 0), a3, voffA);
            PG8_WAIT_V(8); PG8_WAIT_L(0); PG8_BAR; PG8_MMA(1, 0, At, B0); PG8_MMA(1, 1, At, B1); PG8_BAR; PG8_SCHED;
            } else {
            PG8_LDB(B0, 0, 0); PG8_SCHED; PG8_LDA(At, 0, 0); PG8_STAGE(PG8_SA(1, 1), a1 + hstep, voffA);
            PG8_WAIT_L(8); PG8_BAR; PG8_WAIT_L(0); PG8_MMA(0, 0, At, B0); PG8_BAR; PG8_SCHED;
            PG8_LDB(B1, 0, 1); PG8_STAGE(PG8_SB(0, 0), b2, voffB);
            PG8_BAR; PG8_WAIT_L(0); PG8_MMA(0, 1, At, B1); PG8_BAR;
            PG8_LDA(At, 0, 1); PG8_STAGE(PG8_SA(0, 0), a2, voffA);
            PG8_BAR; PG8_WAIT_L(0); PG8_MMA(1, 0, At, B0); PG8_BAR; PG8_SCHED;
            PG8_STAGE(PG8_SB(0, 1), b2 + hstepB, voffB);
            PG8_WAIT_V(6); PG8_BAR; PG8_MMA(1, 1, At, B1); PG8_BAR;
            PG8_LDB(B0, 1, 0); PG8_SCHED; PG8_LDA(At, 1, 0); PG8_STAGE(PG8_SA(0, 1), a2 + hstep, voffA);
            PG8_WAIT_L(8); PG8_BAR; PG8_WAIT_L(0); PG8_MMA(0, 0, At, B0); PG8_BAR; PG8_SCHED;
            PG8_LDB(B1, 1, 1); PG8_STAGE(PG8_SB(1, 0), b3, voffB);
            PG8_BAR; PG8_WAIT_L(0); PG8_MMA(0, 1, At, B1); PG8_BAR;
            PG8_LDA(At, 1, 1); PG8_STAGE(PG8_SA(1, 0), a3, voffA);
            PG8_BAR; PG8_WAIT_L(0); PG8_MMA(1, 0, At, B0); PG8_BAR; PG8_SCHED;
            PG8_STAGE(PG8_SB(1, 1), b3 + hstepB, voffB);
            PG8_WAIT_V(6); PG8_BAR; PG8_MMA(1, 1, At, B1); PG8_BAR;
            }
        }
        if constexpr (ALIGN_EPI) { if (wr == 0) PG8_BAR; }
        if constexpr (!Epi::AFTER_DRAIN) { E(acc, cur, wr, wc, fr, fq); S.done(cur); }
        if (!has_next) break;
#pragma unroll
        for (int a = 0; a < 2; ++a)
#pragma unroll
            for (int b = 0; b < 2; ++b)
#pragma unroll
                for (int m = 0; m < 4; ++m)
#pragma unroll
                    for (int n = 0; n < 2; ++n) acc[a][b][m][n] = (f32x4){0.f, 0.f, 0.f, 0.f};
        cur = nxt; cA = nA; cB = nB; ++ui;
        if constexpr (ALIGN_EPI) { if (wr == 1) PG8_BAR; }
    }
    PG8_WAIT_V(0);
    if constexpr (!ALIGN_EPI) { if (wr == 0) PG8_BAR; }
    PG8_BAR;
    if constexpr (Epi::AFTER_DRAIN) { E.fused(acc, cur, wr, wc, fr, fq, lds, wid, lane); S.done(cur); }
#undef PG8_SA
#undef PG8_SB
#undef PG8_STAGE
#undef PG8_LDA
#undef PG8_LDB
#undef PG8_MMA
#undef PG8_WAIT_V
#undef PG8_WAIT_L
#undef PG8_BAR
#undef PG8_SCHED
}
}
constexpr int NWAVES = 8;
constexpr int BATCH = 16, SEQ = 2048, DM = 1024, DEPTH = 4, DFF = 4096;
constexpr int M = BATCH * SEQ;
constexpr int DIN = 2824;
constexpr int ZP = 3072;
constexpr int ZC_RW_R = 0, ZC_RW_K = 256, ZC_RW_V = 512, ZC_RW_DW = 768;
constexpr int ZC_GD_Q = 1024, ZC_GD_K = 1280, ZC_GD_V = 1536, ZC_GD_G = 1792;
constexpr int ZC_AT_Q = 2048, ZC_AT_K = 2560, ZC_AT_V = 2688;
constexpr int ZC_GD_B = 2816, ZC_GD_A = 2820;
__host__ __device__ __forceinline__ int win_src_col(int n) {
    if (n < 2048) return n;
    if (n < 2816) return n + 8;
    if (n < 2824) return n - 2816 + 2048;
    return -1;
}
constexpr size_t MiB = 1u << 20;
constexpr size_t WS_CTL = 0, CTL_ZERO_BYTES = 1 * MiB;
constexpr size_t WS_WIN = 1 * MiB;
constexpr size_t WS_WOUT = WS_WIN + (size_t)DEPTH * ZP * DM * 2;
constexpr size_t WS_W1 = WS_WOUT + (size_t)DEPTH * DM * DM * 2;
constexpr size_t WS_W2 = WS_W1 + (size_t)DEPTH * DFF * DM * 2;
constexpr size_t WS_XN = WS_W2 + (size_t)DEPTH * DM * DFF * 2;
constexpr size_t WS_Z = WS_XN + (size_t)M * DM * 2;
constexpr size_t WS_Y = WS_Z + (size_t)M * ZP * 2;
constexpr size_t WS_H = WS_Z;
constexpr size_t WS_HB = WS_Y + (size_t)M * DM * 2;
constexpr size_t WS_RSS = WS_HB + (size_t)256 * 8 * 24576;
constexpr size_t WS_XS = WS_RSS + (size_t)2 * DEPTH * M * 16 * 4;
constexpr size_t WS_END = WS_XS + (size_t)128 * 16384;
static_assert(WS_H + (size_t)M * DFF * 2 <= WS_HB, "H overlay");
static_assert(WS_END <= 512 * MiB, "d_ws map");
constexpr int CW_TMO = 8192, CW_SEQ = 16384;
constexpr int CW_BAR = 4096;
constexpr int RING_OFF = 0, RING_BYTES = 131072;
constexpr int LDSCTL_OFF = 158720, MISC_OFF = LDSCTL_OFF + 320;
constexpr int BIAS_OFF = LDSCTL_OFF + 1024;
constexpr int LDS_BYTES = 163840;
static_assert(BIAS_OFF + 4096 <= LDS_BYTES, "LDS map");

#define GAS __attribute__((address_space(1)))
#define LAS __attribute__((address_space(3)))
typedef unsigned short bf16;
typedef unsigned v4u __attribute__((ext_vector_type(4)));
typedef unsigned v2u __attribute__((ext_vector_type(2)));
typedef float f32x4 __attribute__((ext_vector_type(4)));
typedef GAS unsigned gu32;
#define RLX_AGENT __ATOMIC_RELAXED, __HIP_MEMORY_SCOPE_AGENT
#define LDS_WAIT() asm volatile("s_waitcnt lgkmcnt(0)" ::: "memory")
#define VM_WAIT() asm volatile("s_waitcnt vmcnt(0)" ::: "memory")
__device__ __forceinline__ int hw_lane() { return hwl_(); }
__device__ __forceinline__ unsigned f2bf(float f) { unsigned u = __builtin_bit_cast(unsigned, f); return (u + 0x7fffu + ((u >> 16) & 1u)) >> 16; }
__device__ __forceinline__ unsigned pk2(float lo, float hi) { return f2bf(lo) | (f2bf(hi) << 16); }
__device__ __forceinline__ float bf2f(unsigned short h) { return __builtin_bit_cast(float, (unsigned)h << 16); }
__device__ __forceinline__ float bflo(unsigned u) { return __builtin_bit_cast(float, u << 16); }
__device__ __forceinline__ float bfhi(unsigned u) { return __builtin_bit_cast(float, u & 0xffff0000u); }
__device__ __forceinline__ float sigmoidf_(float x) { return 1.f / (1.f + __expf(-x)); }
__device__ __forceinline__ float softplusf_(float x) { return fmaxf(x, 0.f) + log1pf(__expf(-fabsf(x))); }
__device__ __forceinline__ float dppf(float v, const int ctrl_sel) {
    int r;
    const int s = __builtin_bit_cast(int, v);
    if (ctrl_sel == 0) r = __builtin_amdgcn_update_dpp(0, s, 0xB1, 0xF, 0xF, true);
    else if (ctrl_sel == 1) r = __builtin_amdgcn_update_dpp(0, s, 0x4E, 0xF, 0xF, true);
    else if (ctrl_sel == 2) r = __builtin_amdgcn_update_dpp(0, s, 0x141, 0xF, 0xF, true);
    else r = __builtin_amdgcn_update_dpp(0, s, 0x140, 0xF, 0xF, true);
    return __builtin_bit_cast(float, r);
}
__device__ __forceinline__ float wave_allsum(float v) {
    v += dppf(v, 0); v += dppf(v, 1); v += dppf(v, 2); v += dppf(v, 3);
    const float a = __builtin_bit_cast(float, __builtin_amdgcn_readlane(__builtin_bit_cast(int, v), 0));
    const float b = __builtin_bit_cast(float, __builtin_amdgcn_readlane(__builtin_bit_cast(int, v), 16));
    const float c = __builtin_bit_cast(float, __builtin_amdgcn_readlane(__builtin_bit_cast(int, v), 32));
    const float d = __builtin_bit_cast(float, __builtin_amdgcn_readlane(__builtin_bit_cast(int, v), 48));
    return (a + b) + (c + d);
}
#define XB_TMO      128
#define XB_XCNT(j)  (256  + 64 * (j))
#define XB_XSUB(j)  (1280 + 64 * (j))
#define XB_XGEN(j)  (2304 + 64 * (j))
#define XB_TOP      3328
#define XB_TOPGEN   3392
#define XCD_BAR_WORDS 3456
#define XB_SPIN_CAP (1u << 18)

__device__ __forceinline__ unsigned xb_ld(unsigned* p)              { return __hip_atomic_load((GAS unsigned*)p, __ATOMIC_RELAXED, __HIP_MEMORY_SCOPE_AGENT); }
__device__ __forceinline__ unsigned xb_add(unsigned* p, unsigned v) { return __hip_atomic_fetch_add((GAS unsigned*)p, v, __ATOMIC_RELAXED, __HIP_MEMORY_SCOPE_AGENT); }
__device__ __forceinline__ unsigned xb_xcc_id() { return (unsigned)__builtin_amdgcn_s_getreg((3 << 11) | 20) & 0xFu; }
#define XB_SPIN(cond, bar) do { unsigned _sp = 0; while (cond) { __builtin_amdgcn_s_sleep(1); \
    if ((++_sp & 255u) == 0u) { if (xb_ld(&(bar)[XB_TMO])) break; if (_sp > XB_SPIN_CAP) { atomicAdd(&(bar)[XB_TMO], 1u); break; } } } } while (0)

struct XcdBarrier {
    unsigned* bar; unsigned x;
    volatile LAS unsigned* st;
};

__device__ __forceinline__ XcdBarrier xcd_barrier_post(unsigned* bar, volatile LAS unsigned* st, const bool t0  ) {
    XcdBarrier b; b.bar = bar; b.x = xb_xcc_id(); b.st = st;
    if (t0) (void)xb_add(&bar[XB_XCNT(b.x)], 1u);
    return b;
}
__device__ __forceinline__ void xcd_barrier_complete(unsigned* bar, unsigned x, unsigned& nloc, unsigned& nx) {
    const unsigned G = gridDim.x * gridDim.y * gridDim.z;
    unsigned sum, cnt, mine, sp = 0u;
    for (;;) {
        sum = 0u; cnt = 0u; mine = 0u;
#pragma unroll
        for (unsigned j = 0; j < 16; ++j) { const unsigned c = xb_ld(&bar[XB_XCNT(j)]); sum += c; cnt += (c > 0u) ? 1u : 0u; mine = (j == x) ? c : mine; }
        if (sum == G) break;
        __builtin_amdgcn_s_sleep(1);
        if ((++sp & 255u) == 0u) { if (xb_ld(&bar[XB_TMO])) break; if (sp > XB_SPIN_CAP) { atomicAdd(&bar[XB_TMO], 1u); break; } }
    }
    nloc = mine > 0u ? mine : 1u; nx = cnt > 0u ? cnt : 1u;
}

__device__ __forceinline__ void xcd_barrier(const XcdBarrier& b, const bool t0  ) {
    asm volatile("s_waitcnt vmcnt(0)" ::: "memory");
    __syncthreads();
    if (t0) {
        unsigned* bar = b.bar;
        __builtin_amdgcn_s_waitcnt(0);
        unsigned nloc = b.st[0], nx = b.st[1];
        if (nloc == 0u) { xcd_barrier_complete(bar, b.x, nloc, nx); b.st[0] = nloc; b.st[1] = nx; }
        const unsigned old = xb_add(&bar[XB_XSUB(b.x)], 1u);
        const unsigned gen = old / nloc;
        if (old + 1u == (gen + 1u) * nloc) {
            __builtin_amdgcn_fence(__ATOMIC_RELEASE, "agent");
            asm volatile("s_waitcnt vmcnt(0)" ::: "memory");
            const unsigned og = xb_add(&bar[XB_TOP], 1u);
            const unsigned tg = og / nx;
            if (og + 1u == (tg + 1u) * nx) xb_add(&bar[XB_TOPGEN], 1u);
            else XB_SPIN(xb_ld(&bar[XB_TOPGEN]) == tg, bar);
            __builtin_amdgcn_fence(__ATOMIC_ACQUIRE, "agent");
            xb_add(&bar[XB_XGEN(b.x)], 1u);
            asm volatile("s_waitcnt vmcnt(0)" ::: "memory");
        } else {
            XB_SPIN(xb_ld(&bar[XB_XGEN(b.x)]) == gen, bar);
            __builtin_amdgcn_fence(__ATOMIC_ACQUIRE, "agent");
            asm volatile("s_waitcnt vmcnt(0)" ::: "memory");
        }
    }
    __syncthreads();
}
struct Frame {
    LAS unsigned char* lds;
    int wave;
    int vcu, G;
    unsigned char* ws;
    float* out;
};
typedef const float* cfp;
typedef const __attribute__((address_space(4))) cfp* karg_tab;
__device__ __forceinline__ karg_tab ktab() { karg_tab t = (karg_tab)__builtin_amdgcn_kernarg_segment_ptr(); asm volatile("" : "+s"(t)); return t; }
#define INP(i) (ktab()[i])
__device__ __forceinline__ int ltid() { return hw_lane(); }
__device__ __forceinline__ unsigned char* lnd(unsigned char* p) { asm volatile("" : "+s"(p)); return p; }
#define WSP(off) (lnd(F.ws) + (off))
#define FZ ((bf16*)WSP(WS_Z))
#define FY ((bf16*)WSP(WS_Y))
#define FXN ((bf16*)WSP(WS_XN))
#define FH ((bf16*)WSP(WS_H))
enum { I_X = 0, I_LN1 = 1, I_WIN = 2, I_MU = 3, I_W0 = 4, I_WUP = 5, I_A0 = 6, I_AUP = 7, I_GUP = 8, I_KK = 9, I_KA = 10, I_RK = 11, I_LNXW = 12, I_LNXB = 13,
       I_CONV = 14, I_ALOG = 15, I_DTB = 16, I_GNW = 17, I_QNW = 18, I_KNW = 19, I_SINK = 20, I_RELB = 21, I_WOUT = 22, I_LN2 = 23, I_WFF1 = 24, I_WFF2 = 25 };

template <bool MAP>
__device__ __forceinline__ void p0_transpose_item(const float* W, int K, int Nsrc, int Ndst, bf16* WT, LAS float* scr, int item, int lane, const float* kscale = nullptr) {
    const int nblk = Ndst / 64, kb = item / nblk, nb = item % nblk, k0 = 64 * kb, n0 = 64 * nb;
    const int c4 = lane & 15, r = lane >> 4;
    const int nn = n0 + 4 * c4; const int src = MAP ? win_src_col(nn) : nn;
#pragma unroll 8
    for (int i = 0; i < 16; ++i) { const int kk = 4 * i + r;
        f32x4 v = {0.f, 0.f, 0.f, 0.f}; if (src >= 0) v = *(const GAS f32x4*)(W + (size_t)(k0 + kk) * Nsrc + src);
        const float sc = kscale ? kscale[k0 + kk] : 1.f;
        LAS float* d = scr + kk * 65 + 4 * c4; d[0] = v.x * sc; d[1] = v.y * sc; d[2] = v.z * sc; d[3] = v.w * sc; }
    LDS_WAIT(); asm volatile("" ::: "memory");
    const int c = lane & 7;
#pragma unroll
    for (int j = 0; j < 8; ++j) { const int n = (lane >> 3) + 8 * j; const LAS float* s = scr + (8 * c) * 65 + n;
        v4u o; o.x = pg8::cvt_pk_bf16(s[0 * 65], s[1 * 65]); o.y = pg8::cvt_pk_bf16(s[2 * 65], s[3 * 65]); o.z = pg8::cvt_pk_bf16(s[4 * 65], s[5 * 65]); o.w = pg8::cvt_pk_bf16(s[6 * 65], s[7 * 65]);
        const int nn_ = n0 + n, rb = nn_ & 127, v5 = rb & 31, R = (rb & ~31) + (((v5 >> 2) & 1) * 16 + ((v5 >> 3) << 2) + (v5 & 3));
        *(GAS v4u*)((GAS unsigned char*)WT + ((size_t)((nn_ >> 8) * (K / 64) + (k0 >> 6)) * 2 + ((nn_ >> 7) & 1)) * 16384 + pg8::lds_byte(R, 8 * c)) = o; }
    LDS_WAIT(); asm volatile("" ::: "memory");
}
__device__ __forceinline__ void cast_rows(Frame& F, const float* x, bf16* xn, float* rss) {
    const int lane = ltid() & 63;
    const int gw = F.vcu * NWAVES + F.wave, NGW = F.G * NWAVES;
    f32x4 nx[4];
    if (gw < M) { const GAS f32x4* xr = (const GAS f32x4*)(x + (size_t)gw * DM) + lane;
#pragma unroll
        for (int j = 0; j < 4; ++j) nx[j] = xr[64 * j]; }
    for (int m = gw; m < M; m += NGW) {
        f32x4 v[4]; float s = 0.f;
#pragma unroll
        for (int j = 0; j < 4; ++j) v[j] = nx[j];
        if (m + NGW < M) { const GAS f32x4* xr = (const GAS f32x4*)(x + (size_t)(m + NGW) * DM) + lane;
#pragma unroll
            for (int j = 0; j < 4; ++j) nx[j] = xr[64 * j]; }
#pragma unroll
        for (int j = 0; j < 4; ++j) s += (v[j].x * v[j].x + v[j].y * v[j].y) + (v[j].z * v[j].z + v[j].w * v[j].w);
        s = wave_allsum(s);
        if (lane < 16) rss[(size_t)m * 16 + lane] = (lane == 0) ? s : 0.f;
#pragma unroll
        for (int j = 0; j < 4; ++j) *(GAS unsigned long long*)((GAS unsigned char*)xn + pg8::tiled_byte(m, 4 * lane + 256 * j, DM / 64)) = (unsigned long long)pg8::cvt_pk_bf16(v[j].x, v[j].y) | ((unsigned long long)pg8::cvt_pk_bf16(v[j].z, v[j].w) << 32);
    }
}
__device__ __forceinline__ void p0_prologue(Frame& F) {
    const int lane_ = ltid() & 63;
    LAS float* scr = (LAS float*)(F.lds + RING_OFF + F.wave * 16640);
    const int gw = F.vcu * NWAVES + F.wave, NGW = F.G * NWAVES;
    constexpr int I_IN = (DM / 64) * (ZP / 64), I_O = (DM / 64) * (DM / 64), I_1 = (DM / 64) * (DFF / 64), I_2 = (DFF / 64) * (DM / 64);
    constexpr int PER_L = I_IN + I_O + I_1 + I_2, NITEMS = DEPTH * PER_L;
    for (int it = gw; it < NITEMS; it += NGW) {
        const int l = it / PER_L; int r = it % PER_L;
        if (r < I_IN) { p0_transpose_item<true>(INP(I_WIN) + (size_t)l * DM * DIN, DM, DIN, ZP, ((bf16*)WSP(WS_WIN)) + (size_t)l * ZP * DM, scr, r, lane_, INP(I_LN1) + (size_t)l * DM); continue; } r -= I_IN;
        if (r < I_O) { p0_transpose_item<false>(INP(I_WOUT) + (size_t)l * DM * DM, DM, DM, DM, ((bf16*)WSP(WS_WOUT)) + (size_t)l * DM * DM, scr, r, lane_); continue; } r -= I_O;
        if (r < I_1) { p0_transpose_item<false>(INP(I_WFF1) + (size_t)l * DM * DFF, DM, DFF, DFF, ((bf16*)WSP(WS_W1)) + (size_t)l * DFF * DM, scr, r, lane_, INP(I_LN2) + (size_t)l * DM); continue; } r -= I_1;
        p0_transpose_item<false>(INP(I_WFF2) + (size_t)l * DFF * DM, DFF, DM, DM, ((bf16*)WSP(WS_W2)) + (size_t)l * DM * DFF, scr, r, lane_);
    }
    cast_rows(F, INP(I_X), FXN, (float*)WSP(WS_RSS));
}

#define MX_DEV __device__ __forceinline__
#define MX_G __attribute__((address_space(1)))
#define MX_L __attribute__((address_space(3)))
#define MX_EXP(x) __expf(x)
#define MX_LOG1P(x) log1pf(x)
#define MXIN(i) ((const MX_G float*)INP(i))
#define MX_VMWAIT() asm volatile("s_waitcnt vmcnt(0)" ::: "memory")
#define MX_LDSWAIT() asm volatile("s_waitcnt lgkmcnt(0)" ::: "memory")
#define MX_SCHED() __builtin_amdgcn_sched_barrier(0)
#define MX_LAUNDER_S(p) asm volatile("" : "+s"(p))
#define MX_LAUNDER_V(p) asm volatile("" : "+v"(p))
#define MX_CONSUME(x) asm volatile("" :: "v"(x))
#define MX_FMAC(acc, a, b) asm("v_fmac_f32_e32 %0, %1, %2" : "+v"(acc) : "v"(a), "v"(b))
#define MX_RCP(x) __builtin_amdgcn_rcpf(x)
#define MX_RSQ(x) __builtin_amdgcn_rsqf(x)
#define MX_LOG(x) __logf(x)
typedef __bf16 mx_bf2_t __attribute__((ext_vector_type(2)));
typedef float mx_f2_t __attribute__((ext_vector_type(2)));
__device__ __forceinline__ unsigned mx_hwpk2(float lo, float hi) { mx_f2_t v = {lo, hi}; return __builtin_bit_cast(unsigned, __builtin_convertvector(v, mx_bf2_t)); }
#define MX_PK2(lo, hi) mx_hwpk2(lo, hi)
#define MX_UNIFORM(x) __builtin_amdgcn_readfirstlane(x)
#define MX_ROW_SHR(v, d) __builtin_bit_cast(float, __builtin_amdgcn_update_dpp(0, __builtin_bit_cast(int, (v)), 0x110 + (d), 0xF, 0xF, true))
#define MX_ROW_SHRU(v, d) ((unsigned)__builtin_amdgcn_update_dpp(0, (int)(v), 0x110 + (d), 0xF, 0xF, true))
#define MX_ROW_RORU(v, d) ((unsigned)__builtin_amdgcn_update_dpp(0, (int)(v), 0x120 + (d), 0xF, 0xF, true))
#define MX_ROW_LAST(v) __builtin_bit_cast(float, __builtin_amdgcn_update_dpp(0, __builtin_bit_cast(int, (v)), 0x15F, 0xF, 0xF, true))
#define MX_ROW_SHR(v, d) __builtin_bit_cast(float, __builtin_amdgcn_update_dpp(0, __builtin_bit_cast(int, (v)), 0x110 + (d), 0xF, 0xF, true))
#define MX_ROW_LAST(v) __builtin_bit_cast(float, __builtin_amdgcn_update_dpp(0, __builtin_bit_cast(int, (v)), 0x15F, 0xF, 0xF, true))
typedef unsigned mx_u2_t __attribute__((ext_vector_type(2)));
__device__ __forceinline__ float mx_hw_rowsum4(float v) {
    const mx_u2_t a = __builtin_amdgcn_permlane16_swap(__builtin_bit_cast(unsigned, v), __builtin_bit_cast(unsigned, v), false, false);
    const float s = __builtin_bit_cast(float, a.x) + __builtin_bit_cast(float, a.y);
    const mx_u2_t b = __builtin_amdgcn_permlane32_swap(__builtin_bit_cast(unsigned, s), __builtin_bit_cast(unsigned, s), false, false);
    return __builtin_bit_cast(float, b.x) + __builtin_bit_cast(float, b.y);
}
#define MX_ROWSUM4(v) mx_hw_rowsum4(v)
#define MX_FLAG_LOAD(p) __hip_atomic_load((p), __ATOMIC_RELAXED, __HIP_MEMORY_SCOPE_AGENT)
#define MX_FLAG_STORE(p, v) __hip_atomic_store((p), (v), __ATOMIC_RELAXED, __HIP_MEMORY_SCOPE_AGENT)
#define MX_FLAG_ADD(p, v) __hip_atomic_fetch_add((p), (v), __ATOMIC_RELAXED, __HIP_MEMORY_SCOPE_AGENT)
#define MX_SLEEP() __builtin_amdgcn_s_sleep(2)
#define MX_SC1_LOAD64(p) __hip_atomic_load((p), __ATOMIC_RELAXED, __HIP_MEMORY_SCOPE_AGENT)
#define MX_SC1_STORE64(p, v) __hip_atomic_store((p), (v), __ATOMIC_RELAXED, __HIP_MEMORY_SCOPE_AGENT)
__device__ __forceinline__ int mx_lane() { return ltid() & 63; }
__device__ __forceinline__ void mx_wgsync() { __syncthreads(); }
__device__ __forceinline__ float mx_shfl_xor(float v, int m) { return m == 16 ? xor16f(v) : xor32f(v); }
__device__ __forceinline__ float mx_shfl16l(float v, int src, int lane) { return __builtin_bit_cast(float, __builtin_amdgcn_ds_bpermute(((lane & 48) | src) << 2, __builtin_bit_cast(int, v))); }
typedef short mx_bf16x8_t __attribute__((ext_vector_type(8)));
typedef float mx_f32x4_t __attribute__((ext_vector_type(4)));
__device__ __forceinline__ mx_f32x4_t mx_mfma(mx_bf16x8_t a, mx_bf16x8_t b, mx_f32x4_t c) { return __builtin_amdgcn_mfma_f32_16x16x32_bf16(a, b, c, 0, 0, 0); }
typedef short mx_s16x4_t __attribute__((ext_vector_type(4)));
#define MX_MFMA16(a, b, c) __builtin_amdgcn_mfma_f32_16x16x16bf16_1k(__builtin_bit_cast(mx_s16x4_t, a), __builtin_bit_cast(mx_s16x4_t, b), c, 0, 0, 0)
typedef short mx_bf16x8 __attribute__((ext_vector_type(8)));
typedef float mx_f32x4 __attribute__((ext_vector_type(4)));
typedef unsigned mx_u32x4 __attribute__((ext_vector_type(4)));
typedef unsigned mx_u32x2 __attribute__((ext_vector_type(2)));

MX_DEV unsigned mx_bf(float f) { unsigned u = __builtin_bit_cast(unsigned, f); return (u + 0x7fffu + ((u >> 16) & 1u)) >> 16; }
MX_DEV unsigned mx_pk2(float lo, float hi) { return MX_PK2(lo, hi); }
MX_DEV float mx_lo(unsigned u) { return __builtin_bit_cast(float, u << 16); }
MX_DEV float mx_hi(unsigned u) { return __builtin_bit_cast(float, u & 0xffff0000u); }
MX_DEV mx_bf16x8 mx_frag8(const float* a, const float* b) {
    mx_u32x4 w; w.x = mx_pk2(a[0], a[1]); w.y = mx_pk2(a[2], a[3]); w.z = mx_pk2(b[0], b[1]); w.w = mx_pk2(b[2], b[3]); return __builtin_bit_cast(mx_bf16x8, w); }
MX_DEV mx_bf16x8 mx_frag8v(mx_f32x4 a, mx_f32x4 b) {
    mx_u32x4 w; w.x = mx_pk2(a.x, a.y); w.y = mx_pk2(a.z, a.w); w.z = mx_pk2(b.x, b.y); w.w = mx_pk2(b.z, b.w); return __builtin_bit_cast(mx_bf16x8, w); }
MX_DEV mx_u32x2 mx_frag4(mx_f32x4 a) { mx_u32x2 w; w.x = mx_pk2(a.x, a.y); w.y = mx_pk2(a.z, a.w); return w; }
MX_DEV mx_f32x4 mx_mfma(mx_u32x2 a, mx_u32x2 b, mx_f32x4 c) { return MX_MFMA16(a, b, c); }
typedef unsigned long long mx_u64x2 __attribute__((ext_vector_type(2)));
MX_DEV mx_u32x2 mx_frag4p(mx_u32x2 p) { return p; }
MX_DEV mx_u32x2 mx_pack4(mx_f32x4 a) { mx_u32x2 p; p.x = mx_pk2(a.x, a.y); p.y = mx_pk2(a.z, a.w); return p; }
MX_DEV mx_f32x4 mx_zero4() { mx_f32x4 z = {0.f, 0.f, 0.f, 0.f}; return z; }
MX_DEV float mx_sigmoid(float x) { return MX_RCP(1.f + MX_EXP(-x)); }
MX_DEV float mx_softplus(float x) { return fmaxf(x, 0.f) + MX_LOG(1.f + MX_EXP(-fabsf(x))); }
MX_DEV float mx_rowsum4(float v) { v += mx_shfl_xor(v, 16); v += mx_shfl_xor(v, 32); return v; }

constexpr int MX_HB_WA = 0, MX_HB_RT = 2048, MX_HB_ARB = 4096, MX_HB_ARK = 4608, MX_HB_BH = 5120, MX_HB_KH = 7168, MX_HB_VC = 9216, MX_HB_U0 = 11264, MX_HB_GAM = 13312, MX_HB_SLOT = 13568;
constexpr int MX_GB_GT = 0, MX_GB_EE = 2048, MX_GB_SLOT = 4096;
constexpr int MX_LDS_HB = 0, MX_LDS_WW = 108544, MX_LDS_WA = 117760, MX_LDS_WG = 126976, MX_LDS_PAR = 144384, MX_LDS_ST = 148480, MX_LDS_GAM = 152576  , MX_LDS_END = 156672, MX_RS64 = 144, MX_RS128 = 272;
constexpr int MX_P_MUR = 256, MX_P_MUK = 320, MX_P_MUV = 384, MX_P_W0 = 448, MX_P_A0 = 512, MX_P_KK = 576, MX_P_KA = 640, MX_P_RK = 704, MX_P_LNW = 768, MX_P_LNB = 832, MX_P_GNW = 768;

constexpr int MX_YS_PAR = 32768;
struct MxFin { bool on; int type; int wv  ; MX_G unsigned short* yb  ; int t0  , col0  ; const MX_G unsigned char* gbp; const MX_G unsigned char* ysp;
               const MX_G unsigned short* pf  ; int pfh; };
MX_DEV unsigned mx_zoff(int t, int col) { return (unsigned)(((t >> 4) * (ZP / 64) + (col >> 6)) * 1024 + ((col >> 5) & 1) * 512 + (t & 15) * 32 + (col & 31)); }
MX_DEV unsigned mx_yoff(int t, int col) { const int r = t & 127, c = col & 63, ob = (r & 15) * 64 + (c & 31) * 2;
    return (unsigned)((((t >> 8) * (DM / 64) + (col >> 6)) * 2 + ((t >> 7) & 1)) * 8192 + ((((r >> 4) * 2 + (c >> 5)) * 1024 + (ob ^ (((ob >> 9) & 1) << 5))) >> 1)); }
MX_DEV int mx_ch_off(int ct, int g);
MX_DEV void mx_finalize(const MxFin& f, int lane) {
    const int tk = lane & 15, g = lane >> 4;
#pragma unroll
    for (int cc = 0; cc < 2; ++cc) {
        const int c = 2 * f.wv + cc;
        mx_f32x4 y[4]; mx_u32x2 gt[4], ee[4];
#pragma unroll
        for (int q = 0; q < 4; ++q) {
            y[q] = *(const MX_G mx_f32x4*)(f.ysp + (unsigned)(((c * 4 + q) * 64 + lane) * 16));
            const MX_G unsigned char* sl = f.gbp + c * MX_GB_SLOT;
            if ((q & 1) == 0) { const mx_u32x4 g4 = *(const MX_G mx_u32x4*)(sl + (unsigned)(MX_GB_GT + (q >> 1) * 1024 + lane * 16)), e4 = f.type == 0 ? *(const MX_G mx_u32x4*)(sl + (unsigned)(MX_GB_EE + (q >> 1) * 1024 + lane * 16)) : mx_u32x4{0u, 0u, 0u, 0u};
                gt[q].x = g4.x; gt[q].y = g4.y; gt[q + 1].x = g4.z; gt[q + 1].y = g4.w; ee[q].x = e4.x; ee[q].y = e4.y; ee[q + 1].x = e4.z; ee[q + 1].y = e4.w; } }
        float s1 = 0.f, s2 = 0.f;
#pragma unroll
        for (int q = 0; q < 4; ++q) { s1 += (y[q].x + y[q].y) + (y[q].z + y[q].w); s2 += (y[q].x * y[q].x + y[q].y * y[q].y) + (y[q].z * y[q].z + y[q].w * y[q].w); }
        s1 = mx_rowsum4(s1); s2 = mx_rowsum4(s2);
        float mean, rstd;
        if (f.type == 0) { mean = s1 * (1.f / 64.f); const float var = fmaxf(s2 * (1.f / 64.f) - mean * mean, 0.f); rstd = MX_RSQ(var + 64e-5f); }
        else { mean = 0.f; rstd = MX_RSQ(s2 * (1.f / 64.f) + 1e-6f); }
        mx_u32x2 ov[4];
#pragma unroll
        for (int q = 0; q < 4; ++q) {
            const float o0 = (y[q].x - mean) * rstd * mx_lo(gt[q].x) + mx_lo(ee[q].x), o1 = (y[q].y - mean) * rstd * mx_hi(gt[q].x) + mx_hi(ee[q].x);
            const float o2 = (y[q].z - mean) * rstd * mx_lo(gt[q].y) + mx_lo(ee[q].y), o3 = (y[q].w - mean) * rstd * mx_hi(gt[q].y) + mx_hi(ee[q].y);
            ov[q].x = mx_pk2(o0, o1); ov[q].y = mx_pk2(o2, o3);
        }
#pragma unroll
        for (int qp = 0; qp < 2; ++qp) {
            mx_u32x4 o; o.x = ov[2 * qp].x; o.y = ov[2 * qp].y; o.z = ov[2 * qp + 1].x; o.w = ov[2 * qp + 1].y;
            *(MX_G mx_u32x4*)(f.yb + mx_yoff(f.t0 + 16 * c + tk, f.col0 + mx_ch_off(2 * qp, g))) = o;
        }
    }
}
MX_DEV void mx_prep_back(float (&lw)[16], float (&a)[16], float (&b)[16], float (&k2)[16], float (&r)[16], float (&v)[16], MX_L unsigned char* slot, MX_L unsigned char* gamp  , bool midbar, const MxFin& fin, int lane) {
    const int tk = lane & 15, g = lane >> 4;
    float G[16];
#pragma unroll
    for (int i = 0; i < 16; ++i) G[i] = lw[i];
#pragma unroll
    for (int i = 0; i < 16; ++i) { G[i] += MX_ROW_SHR(G[i], 1); G[i] += MX_ROW_SHR(G[i], 2); G[i] += MX_ROW_SHR(G[i], 4); G[i] += MX_ROW_SHR(G[i], 8); }
    MX_SCHED();
    mx_bf16x8 AtF[2], BtF[2], KtF[2], RtF[2], BhF[2], KhF[2], VF[2];
    {
        float x[16];
#pragma unroll
        for (int i = 0; i < 16; ++i) { x[i] = a[i] * MX_EXP(G[i] - lw[i]); }
        AtF[0] = mx_frag8(x, x + 4); AtF[1] = mx_frag8(x + 8, x + 12);
    }
    MX_SCHED();
    {
        float x[16];
#pragma unroll
        for (int i = 0; i < 16; ++i) { x[i] = r[i] * MX_EXP(G[i]); }
        RtF[0] = mx_frag8(x, x + 4); RtF[1] = mx_frag8(x + 8, x + 12);
        VF[0] = mx_frag8(v, v + 4); VF[1] = mx_frag8(v + 8, v + 12);
    }
    MX_SCHED();
    {
        float x[16], y[16];
#pragma unroll
        for (int i = 0; i < 16; ++i) { const float e = MX_EXP(-G[i]); x[i] = b[i] * e; y[i] = k2[i] * e; }
        BtF[0] = mx_frag8(x, x + 4); BtF[1] = mx_frag8(x + 8, x + 12); KtF[0] = mx_frag8(y, y + 4); KtF[1] = mx_frag8(y + 8, y + 12);
    }
    MX_SCHED();
    {
        float x[16], y[16], gam[16];
#pragma unroll
        for (int i = 0; i < 16; ++i) { const float gc = MX_ROW_LAST(G[i]); const float e = MX_EXP(gc - G[i]); x[i] = b[i] * e; y[i] = k2[i] * e; gam[i] = MX_EXP(gc); }
        BhF[0] = mx_frag8(x, x + 4); BhF[1] = mx_frag8(x + 8, x + 12); KhF[0] = mx_frag8(y, y + 4); KhF[1] = mx_frag8(y + 8, y + 12);
        if (tk == 0) {
#pragma unroll
            for (int ct = 0; ct < 4; ++ct) { mx_f32x4 q = {gam[4 * ct], gam[4 * ct + 1], gam[4 * ct + 2], gam[4 * ct + 3]}; *(MX_L mx_f32x4*)(gamp + (unsigned)((16 * ct + 4 * g) * 4)) = q; } }
    }
    MX_SCHED();
    const mx_f32x4 z4 = mx_zero4();
    mx_f32x4 L = mx_mfma(BtF[1], AtF[1], mx_mfma(BtF[0], AtF[0], z4));
    mx_f32x4 LT = mx_mfma(AtF[1], BtF[1], mx_mfma(AtF[0], BtF[0], z4));
    mx_f32x4 Lak = mx_mfma(KtF[1], AtF[1], mx_mfma(KtF[0], AtF[0], z4));
    mx_f32x4 Arb = mx_mfma(BtF[1], RtF[1], mx_mfma(BtF[0], RtF[0], z4));
    mx_f32x4 Ark = mx_mfma(KtF[1], RtF[1], mx_mfma(KtF[0], RtF[0], z4));
#pragma unroll
    for (int e = 0; e < 4; ++e) { const int s = 4 * g + e;
        L[e] = (s < tk) ? L[e] : 0.f; LT[e] = (s > tk) ? LT[e] : 0.f; Lak[e] = (s < tk) ? Lak[e] : 0.f; Arb[e] = (s <= tk) ? Arb[e] : 0.f; Ark[e] = (s <= tk) ? Ark[e] : 0.f; }
    unsigned pfv = 0u;
    if (midbar) { MX_LDSWAIT(); mx_wgsync(); if (fin.on) mx_finalize(fin, lane);
        if (fin.pf) {
            if (fin.type == 0) { pfv = *(const MX_G unsigned*)(fin.pf + ZC_RW_DW + 64 * g); if (g < 3) pfv ^= *(const MX_G unsigned*)(fin.pf + (g == 0 ? ZC_RW_R : (g == 1 ? ZC_RW_K : ZC_RW_V)) + 64 * fin.pfh); }
            else { pfv = *(const MX_G unsigned*)(fin.pf + (g == 0 ? ZC_GD_Q : (g == 1 ? ZC_GD_K : (g == 2 ? ZC_GD_V : ZC_GD_G))) + 64 * fin.pfh); if (g == 0) pfv ^= *(const MX_G unsigned*)(fin.pf + ZC_GD_B); } }
        MX_SCHED(); }
    *(MX_L mx_bf16x8*)(slot + (unsigned)(MX_HB_RT + lane * 16)) = RtF[0]; *(MX_L mx_bf16x8*)(slot + (unsigned)(MX_HB_RT + 1024 + lane * 16)) = RtF[1];
    *(MX_L mx_u32x2*)(slot + (unsigned)(MX_HB_ARB + lane * 8)) = mx_pack4(Arb); *(MX_L mx_u32x2*)(slot + (unsigned)(MX_HB_ARK + lane * 8)) = mx_pack4(Ark);
    mx_f32x4 T = L;
#pragma unroll
    for (int e = 0; e < 4; ++e) T[e] += (4 * g + e == tk) ? 1.f : 0.f;
    {
        const mx_u32x2 fL = mx_frag4(L), fLT = mx_frag4(LT);
        const mx_f32x4 L2 = mx_mfma(fLT, fL, z4), L2T = mx_mfma(fL, fLT, z4);
        const mx_u32x2 fL2 = mx_frag4(L2), fL2T = mx_frag4(L2T);
        T = mx_mfma(fL2T, mx_frag4(T), T);
        const mx_f32x4 L4 = mx_mfma(fL2T, fL2, z4), L4T = mx_mfma(fL2, fL2T, z4);
        const mx_u32x2 fL4 = mx_frag4(L4), fL4T = mx_frag4(L4T);
        T = mx_mfma(fL4T, mx_frag4(T), T);
        const mx_f32x4 L8T = mx_mfma(fL4, fL4T, z4);
        T = mx_mfma(mx_frag4(L8T), mx_frag4(T), T);
    }
    const mx_u32x2 fT = mx_frag4(T), fLak = mx_frag4(Lak);
    mx_bf16x8 Sel[2];
#pragma unroll
    for (int p = 0; p < 2; ++p) { mx_u32x4 w = {0u, 0u, 0u, 0u};
        if ((tk >> 2) == g) { const unsigned one = (tk & 1) ? 0x3F800000u : 0x00003F80u; const int q = 2 * p + ((tk & 3) >> 1); w.x = (q == 0) ? one : 0u; w.y = (q == 1) ? one : 0u; w.z = (q == 2) ? one : 0u; w.w = (q == 3) ? one : 0u; }
        Sel[p] = __builtin_bit_cast(mx_bf16x8, w); }
#pragma unroll
    for (int ks = 0; ks < 2; ++ks) {
        mx_f32x4 w0 = mx_mfma(mx_frag4(mx_mfma(AtF[ks], Sel[0], z4)), fT, z4);
        mx_f32x4 w1 = mx_mfma(mx_frag4(mx_mfma(AtF[ks], Sel[1], z4)), fT, z4);
        *(MX_L mx_bf16x8*)(slot + (unsigned)(MX_HB_WA + ks * 1024 + lane * 16)) = mx_frag8v(w0, w1);
    }
#pragma unroll
    for (int ct = 0; ct < 4; ++ct) {
        const mx_f32x4 vc = mx_mfma(VF[ct >> 1], Sel[ct & 1], z4);
        const mx_u32x2 vp = mx_pack4(vc);
        *(MX_L mx_u32x2*)(slot + (unsigned)(MX_HB_VC + ct * 512 + lane * 8)) = vp;
        const mx_f32x4 X = mx_mfma(fLak, mx_frag4p(vp), z4);
        const mx_f32x4 U0 = mx_mfma(fT, mx_frag4(X), z4);
        *(MX_L mx_u32x2*)(slot + (unsigned)(MX_HB_U0 + ct * 512 + lane * 8)) = mx_pack4(U0);
        *(MX_L mx_u32x2*)(slot + (unsigned)(MX_HB_BH + ct * 512 + lane * 8)) = mx_pack4(mx_mfma(BhF[ct >> 1], Sel[ct & 1], z4));
        *(MX_L mx_u32x2*)(slot + (unsigned)(MX_HB_KH + ct * 512 + lane * 8)) = mx_pack4(mx_mfma(KhF[ct >> 1], Sel[ct & 1], z4));
    }
    MX_CONSUME(pfv);
}
MX_DEV int mx_ch_off(int ct, int g);
MX_DEV void mx_load_t16(const MX_G unsigned short* p, bool ok, int g, float (&x)[16]) {
#pragma unroll
    for (int ct = 0; ct < 4; ++ct) { mx_u32x2 w = {0u, 0u}; if (ok) w = *(const MX_G mx_u32x2*)(p + mx_ch_off(ct, g));
        x[4 * ct] = mx_lo(w.x); x[4 * ct + 1] = mx_hi(w.x); x[4 * ct + 2] = mx_lo(w.y); x[4 * ct + 3] = mx_hi(w.y); }
}
MX_DEV void mx_load_par(const MX_G float* p, int g, float (&x)[16]) {
#pragma unroll
    for (int ct = 0; ct < 4; ++ct) { const mx_f32x4 w = *(const MX_G mx_f32x4*)(p + mx_ch_off(ct, g)); x[4 * ct] = w.x; x[4 * ct + 1] = w.y; x[4 * ct + 2] = w.z; x[4 * ct + 3] = w.w; }
}
MX_DEV void mx_store_t16(MX_G unsigned char* p, int lane, const float (&x)[16]) {
#pragma unroll
    for (int cp = 0; cp < 2; ++cp) { mx_u32x4 w; w.x = mx_pk2(x[8 * cp], x[8 * cp + 1]); w.y = mx_pk2(x[8 * cp + 2], x[8 * cp + 3]); w.z = mx_pk2(x[8 * cp + 4], x[8 * cp + 5]); w.w = mx_pk2(x[8 * cp + 6], x[8 * cp + 7]); *(MX_G mx_u32x4*)(p + cp * 1024 + lane * 16) = w; }
}

MX_DEV int mx_ch_off(int ct, int g) { return 32 * (ct >> 1) + 8 * g + 4 * (ct & 1); }
MX_DEV int mx_slot_of_ch(int ch) { return 16 * (2 * (ch >> 5) + ((ch >> 2) & 1)) + 4 * ((ch >> 3) & 3) + (ch & 3); }
MX_DEV void mx_load_parL(const MX_L float* p, int g, float (&x)[16]) {
#pragma unroll
    for (int ct = 0; ct < 4; ++ct) { const mx_f32x4 w = *(const MX_L mx_f32x4*)(p + mx_ch_off(ct, g)); x[4 * ct] = w.x; x[4 * ct + 1] = w.y; x[4 * ct + 2] = w.z; x[4 * ct + 3] = w.w; }
}
struct MxRaw16 { mx_u32x2 w[4]; };
MX_DEV MxRaw16 mx_raw_t16(const MX_G unsigned short* zseq, int t, int col, bool ok, int g) { MxRaw16 r;
    mx_u32x4 a = {0u, 0u, 0u, 0u}, b = {0u, 0u, 0u, 0u};
    if (ok) { a = *(const MX_G mx_u32x4*)(zseq + mx_zoff(t, col + 8 * g)); b = *(const MX_G mx_u32x4*)(zseq + mx_zoff(t, col + 32 + 8 * g)); }
    r.w[0].x = a.x; r.w[0].y = a.y; r.w[1].x = a.z; r.w[1].y = a.w; r.w[2].x = b.x; r.w[2].y = b.y; r.w[3].x = b.z; r.w[3].y = b.w;
    return r; }
MX_DEV void mx_unpack16(const MxRaw16& r, float (&x)[16]) {
#pragma unroll
    for (int ct = 0; ct < 4; ++ct) { x[4 * ct] = mx_lo(r.w[ct].x); x[4 * ct + 1] = mx_hi(r.w[ct].x); x[4 * ct + 2] = mx_lo(r.w[ct].y); x[4 * ct + 3] = mx_hi(r.w[ct].y); }
}
MX_DEV unsigned mx_shr_u(unsigned v, int d) { return d == 1 ? MX_ROW_SHRU(v, 1) : (d == 2 ? MX_ROW_SHRU(v, 2) : MX_ROW_SHRU(v, 3)); }
MX_DEV unsigned mx_ror8(unsigned v, int d) { return d == 1 ? MX_ROW_RORU(v, 1) : d == 2 ? MX_ROW_RORU(v, 2) : d == 3 ? MX_ROW_RORU(v, 3) : d == 4 ? MX_ROW_RORU(v, 4) : d == 5 ? MX_ROW_RORU(v, 5) : d == 6 ? MX_ROW_RORU(v, 6) : d == 7 ? MX_ROW_RORU(v, 7) : MX_ROW_RORU(v, 8); }
MX_DEV unsigned mx_ror_u(unsigned v, int d) { return d == 1 ? MX_ROW_RORU(v, 1) : (d == 2 ? MX_ROW_RORU(v, 2) : MX_ROW_RORU(v, 3)); }
MX_DEV MxRaw16 mx_raw_tail(const MX_G unsigned short* zseq, int col, int t0, int tk, int g) {
    return mx_raw_t16(zseq, t0 - 16 + tk, col, tk >= 13 && t0 - 16 + tk >= 0, g); }
MX_DEV MxRaw16 mx_raw_prev(const MxRaw16& cur, const MxRaw16& tail, int tk, int d) {
    MxRaw16 r;
#pragma unroll
    for (int ct = 0; ct < 4; ++ct) {
        const unsigned sx = mx_shr_u(cur.w[ct].x, d), sy = mx_shr_u(cur.w[ct].y, d), tx = mx_ror_u(tail.w[ct].x, d), ty = mx_ror_u(tail.w[ct].y, d);
        r.w[ct].x = (tk >= d) ? sx : tx; r.w[ct].y = (tk >= d) ? sy : ty; }
    return r;
}
MX_DEV MxRaw16 mx_raw_prev1(const MxRaw16& cur, const MxRaw16& tail, int tk, int rot) {
    MxRaw16 r;
#pragma unroll
    for (int ct = 0; ct < 4; ++ct) {
        const unsigned sx = MX_ROW_SHRU(cur.w[ct].x, 1), sy = MX_ROW_SHRU(cur.w[ct].y, 1), tx = mx_ror8(tail.w[ct].x, rot), ty = mx_ror8(tail.w[ct].y, rot);
        r.w[ct].x = (tk >= 1) ? sx : tx; r.w[ct].y = (tk >= 1) ? sy : ty; }
    return r;
}
MX_DEV void mx_prep_rwkv(int l, int h, const MX_G unsigned short* zseq  , int chunk, MX_L unsigned char* slot, MX_G unsigned char* gslot, MX_L unsigned char* gamp, bool midbar, const MxFin& fin, const MX_L unsigned char* lds, int lane) {
    const int tk = lane & 15, g = lane >> 4, t = 16 * chunk + tk;
    const MX_L float* par = (const MX_L float*)(lds + MX_LDS_PAR);
    const mx_f32x4 z4 = mx_zero4();
    mx_u32x4 cwv[8];
    const int tlast = 16 * chunk - 1;
    mx_u32x4 pwi = {0u, 0u, 0u, 0u}; if (tk >= 8 && chunk > 0) pwi = *(const MX_G mx_u32x4*)(zseq + mx_zoff(tlast, ZC_RW_DW + 32 * (tk - 8) + 8 * g));
#pragma unroll
    for (int ks = 0; ks < 8; ++ks) { const int col = ZC_RW_DW + 32 * ks + 8 * g; cwv[ks] = *(const MX_G mx_u32x4*)(zseq + mx_zoff(t, col)); }
    MxRaw16 kc, rc, vc_, tl;
    MX_SCHED();
    mx_f32x4 accw[4], acca[4], accg[4];
#pragma unroll
    for (int ct = 0; ct < 4; ++ct) { accw[ct] = z4; acca[ct] = z4; accg[ct] = z4; }
#pragma unroll
    for (int ks = 0; ks < 8; ++ks) {
        const mx_u32x4 cw = cwv[ks]; mx_u32x4 pw = pwi;
        { const unsigned sx = MX_ROW_SHRU(cw.x, 1), sy = MX_ROW_SHRU(cw.y, 1), sz = MX_ROW_SHRU(cw.z, 1), sw = MX_ROW_SHRU(cw.w, 1), tx = mx_ror8(pw.x, 8 - ks), ty = mx_ror8(pw.y, 8 - ks), tz = mx_ror8(pw.z, 8 - ks), tw = mx_ror8(pw.w, 8 - ks);
          pw.x = tk ? sx : tx; pw.y = tk ? sy : ty; pw.z = tk ? sz : tz; pw.w = tk ? sw : tw; }
        const mx_f32x4 m0 = *(const MX_L mx_f32x4*)(par + 32 * ks + 8 * g), m1 = *(const MX_L mx_f32x4*)(par + 32 * ks + 8 * g + 4);
        float x[8];
        x[0] = mx_lo(cw.x) + (mx_lo(pw.x) - mx_lo(cw.x)) * m0.x; x[1] = mx_hi(cw.x) + (mx_hi(pw.x) - mx_hi(cw.x)) * m0.y; x[2] = mx_lo(cw.y) + (mx_lo(pw.y) - mx_lo(cw.y)) * m0.z; x[3] = mx_hi(cw.y) + (mx_hi(pw.y) - mx_hi(cw.y)) * m0.w;
        x[4] = mx_lo(cw.z) + (mx_lo(pw.z) - mx_lo(cw.z)) * m1.x; x[5] = mx_hi(cw.z) + (mx_hi(pw.z) - mx_hi(cw.z)) * m1.y; x[6] = mx_lo(cw.w) + (mx_lo(pw.w) - mx_lo(cw.w)) * m1.z; x[7] = mx_hi(cw.w) + (mx_hi(pw.w) - mx_hi(cw.w)) * m1.w;
#pragma unroll
        for (int e = 0; e < 8; ++e) { if (ks < 2) x[e] = 2.f * MX_RCP(1.f + MX_EXP(-2.f * x[e])) - 1.f; else if (ks >= 4) x[e] = mx_sigmoid(x[e]); }
        const mx_bf16x8 bf = mx_frag8(x, x + 4);
#pragma unroll
        for (int ct = 0; ct < 4; ++ct) {
            if (ks < 2) accw[ct] = mx_mfma(*(const MX_L mx_bf16x8*)(lds + MX_LDS_WW + (16 * ct + tk) * MX_RS64 + (32 * ks + 8 * g) * 2), bf, accw[ct]);
            else if (ks < 4) acca[ct] = mx_mfma(*(const MX_L mx_bf16x8*)(lds + MX_LDS_WA + (16 * ct + tk) * MX_RS64 + (32 * (ks - 2) + 8 * g) * 2), bf, acca[ct]);
            else accg[ct] = mx_mfma(*(const MX_L mx_bf16x8*)(lds + MX_LDS_WG + (16 * ct + tk) * MX_RS128 + (32 * (ks - 4) + 8 * g) * 2), bf, accg[ct]);
        }
        if (ks == 0) { kc = mx_raw_t16(zseq, t, ZC_RW_K + 64 * h, true, g); tl = mx_raw_t16(zseq, tlast, (tk == 13 ? ZC_RW_R : (tk == 14 ? ZC_RW_K : ZC_RW_V)) + 64 * h, tk >= 13 && chunk > 0, g); }
        if (ks == 1) rc = mx_raw_t16(zseq, t, ZC_RW_R + 64 * h, true, g);
        if (ks == 2) vc_ = mx_raw_t16(zseq, t, ZC_RW_V + 64 * h, true, g);
        MX_SCHED();
    }
    float lw[16], a[16], b[16], k2[16], r[16], v[16];
    {
        float zc[16], zp[16], pr[16];
        mx_load_parL(par + MX_P_A0, g, pr);
#pragma unroll
        for (int i = 0; i < 16; ++i) b[i] = mx_sigmoid(pr[i] + acca[i >> 2][i & 3]);
        mx_unpack16(kc, zc); mx_unpack16(mx_raw_prev1(kc, tl, tk, 2), zp); mx_load_parL(par + MX_P_MUK, g, pr);
#pragma unroll
        for (int i = 0; i < 16; ++i) k2[i] = zc[i] + (zp[i] - zc[i]) * pr[i];
        mx_load_parL(par + MX_P_KK, g, pr);
        float ss = 0.f;
#pragma unroll
        for (int i = 0; i < 16; ++i) { a[i] = k2[i] * pr[i]; ss += a[i] * a[i]; }
        ss = mx_rowsum4(ss);
        const float rn = MX_RSQ(ss + 1e-6f);
        mx_load_parL(par + MX_P_KA, g, pr);
#pragma unroll
        for (int i = 0; i < 16; ++i) { const float kk = a[i] * rn, ic = b[i]; b[i] = kk * ic; a[i] = -kk; k2[i] = k2[i] * (1.f + (ic - 1.f) * pr[i]); }
    }
    MX_SCHED();
    float bs = 0.f;
    {
        float zc[16], zp[16], pr[16];
        mx_unpack16(rc, zc); mx_unpack16(mx_raw_prev1(rc, tl, tk, 3), zp); mx_load_parL(par + MX_P_MUR, g, pr);
#pragma unroll
        for (int i = 0; i < 16; ++i) r[i] = zc[i] + (zp[i] - zc[i]) * pr[i];
        mx_load_parL(par + MX_P_RK, g, pr);
#pragma unroll
        for (int i = 0; i < 16; ++i) bs += r[i] * k2[i] * pr[i];
        bs = mx_rowsum4(bs);
    }
    MX_SCHED();
    {
        float zc[16], zp[16], pr[16];
        mx_unpack16(vc_, zc); mx_unpack16(mx_raw_prev1(vc_, tl, tk, 1), zp); mx_load_parL(par + MX_P_MUV, g, pr);
#pragma unroll
        for (int i = 0; i < 16; ++i) v[i] = zc[i] + (zp[i] - zc[i]) * pr[i];
        mx_load_parL(par + MX_P_LNW, g, pr);
#pragma unroll
        for (int i = 0; i < 16; ++i) zc[i] = accg[i >> 2][i & 3] * pr[i];
        mx_store_t16(gslot + MX_GB_GT, lane, zc);
        mx_load_parL(par + MX_P_LNB, g, pr);
#pragma unroll
        for (int i = 0; i < 16; ++i) zp[i] = (pr[i] + bs * v[i]) * accg[i >> 2][i & 3];
        mx_store_t16(gslot + MX_GB_EE, lane, zp);
    }
    MX_SCHED();
    {
        float pr[16];
        mx_load_parL(par + MX_P_W0, g, pr);
#pragma unroll
        for (int i = 0; i < 16; ++i) { const float u = pr[i] + accw[i >> 2][i & 3]; lw[i] = -0.60653065971263342f * mx_sigmoid(u); }
    }
    MX_SCHED();
    mx_prep_back(lw, a, b, k2, r, v, slot, gamp, midbar, fin, lane);
}
MX_DEV void mx_prep_gdn(int l, int h, const MX_G unsigned short* zseq, int chunk, MX_L unsigned char* slot, MX_G unsigned char* gslot, MX_L unsigned char* gamp, bool midbar, const MxFin& fin, const MX_L unsigned char* lds, int lane) {
    const int tk = lane & 15, g = lane >> 4, t = 16 * chunk + tk;
    const MX_L float* par = (const MX_L float*)(lds + MX_LDS_PAR);
    const MxRaw16 cq = mx_raw_t16(zseq, t, ZC_GD_Q + 64 * h, true, g), tq = mx_raw_tail(zseq, ZC_GD_Q + 64 * h, 16 * chunk, tk, g);
    const MxRaw16 ck = mx_raw_t16(zseq, t, ZC_GD_K + 64 * h, true, g), tk_ = mx_raw_tail(zseq, ZC_GD_K + 64 * h, 16 * chunk, tk, g);
    MX_SCHED();
    float q[16], k[16], v[16];
#pragma unroll
    for (int i = 0; i < 16; ++i) { q[i] = 0.f; k[i] = 0.f; v[i] = 0.f; }
#pragma unroll
    for (int d = 0; d < 4; ++d) {
        float x[16], w[16];
        if (d == 3) mx_unpack16(cq, x); else mx_unpack16(mx_raw_prev(cq, tq, tk, 3 - d), x);
        mx_load_parL(par + d * 192, g, w);
#pragma unroll
        for (int i = 0; i < 16; ++i) MX_FMAC(q[i], w[i], x[i]);
    }
    const MxRaw16 cv = mx_raw_t16(zseq, t, ZC_GD_V + 64 * h, true, g), tv = mx_raw_tail(zseq, ZC_GD_V + 64 * h, 16 * chunk, tk, g);
    const MxRaw16 rg = mx_raw_t16(zseq, t, ZC_GD_G + 64 * h, true, g);
    const float bl = mx_lo((unsigned)zseq[mx_zoff(t, ZC_GD_B + h)]), al = mx_lo((unsigned)zseq[mx_zoff(t, ZC_GD_A + h)]);
    MX_SCHED();
#pragma unroll
    for (int d = 0; d < 4; ++d) {
        float x[16], w[16];
        if (d == 3) mx_unpack16(ck, x); else mx_unpack16(mx_raw_prev(ck, tk_, tk, 3 - d), x);
        mx_load_parL(par + d * 192 + 64, g, w);
#pragma unroll
        for (int i = 0; i < 16; ++i) MX_FMAC(k[i], w[i], x[i]);
    }
    MX_SCHED();
#pragma unroll
    for (int d = 0; d < 4; ++d) {
        float x[16], w[16];
        if (d == 3) mx_unpack16(cv, x); else mx_unpack16(mx_raw_prev(cv, tv, tk, 3 - d), x);
        mx_load_parL(par + d * 192 + 128, g, w);
#pragma unroll
        for (int i = 0; i < 16; ++i) MX_FMAC(v[i], w[i], x[i]);
    }
    MX_SCHED();
    float sq = 0.f, sk = 0.f;
#pragma unroll
    for (int i = 0; i < 16; ++i) { q[i] = q[i] * mx_sigmoid(q[i]); k[i] = k[i] * mx_sigmoid(k[i]); v[i] = v[i] * mx_sigmoid(v[i]); sq += q[i] * q[i]; sk += k[i] * k[i]; }
    sq = mx_rowsum4(sq); sk = mx_rowsum4(sk);
    const float rqn = 0.125f * MX_RSQ(sq + 1e-6f), rkn = MX_RSQ(sk + 1e-6f);
    const float beta = mx_sigmoid(bl);
    const float gl = -MX_EXP(MXIN(I_ALOG)[l * 4 + h]) * mx_softplus(al + MXIN(I_DTB)[l * 4 + h]);
    const float wb = -MX_EXP(gl) * beta;
    float lw[16], a[16], b[16];
#pragma unroll
    for (int i = 0; i < 16; ++i) { const float kn = k[i] * rkn; lw[i] = gl; a[i] = kn; b[i] = wb * kn; k[i] = kn; q[i] = q[i] * rqn; v[i] = beta * v[i]; }
    {
        float zg[16], pr[16], ee[16];
        mx_unpack16(rg, zg); mx_load_parL(par + MX_P_GNW, g, pr);
#pragma unroll
        for (int i = 0; i < 16; ++i) { zg[i] = pr[i] * (zg[i] * mx_sigmoid(zg[i])); ee[i] = 0.f; }
        mx_store_t16(gslot + MX_GB_GT, lane, zg);
    }
    MX_SCHED();
    mx_prep_back(lw, a, b, k, q, v, slot, gamp, midbar, fin, lane);
}
struct MxOps { mx_bf16x8 wa0, wa1, rt0, rt1; mx_u32x2 arb, ark, vc; mx_f32x4 u0; mx_f32x4 gm0, gm1, gm2, gm3; mx_u32x2 bh0, bh1, bh2, bh3, kh0, kh1, kh2, kh3; };
MX_DEV MxOps mx_scan_load(const MX_L unsigned char* slot, const MX_L unsigned char* gamp, int it, int lane) {
    const int g = lane >> 4;
    MxOps o;
    o.wa0 = *(const MX_L mx_bf16x8*)(slot + (unsigned)(MX_HB_WA + lane * 16)); o.wa1 = *(const MX_L mx_bf16x8*)(slot + (unsigned)(MX_HB_WA + 1024 + lane * 16));
    o.rt0 = *(const MX_L mx_bf16x8*)(slot + (unsigned)(MX_HB_RT + lane * 16)); o.rt1 = *(const MX_L mx_bf16x8*)(slot + (unsigned)(MX_HB_RT + 1024 + lane * 16));
    o.arb = *(const MX_L mx_u32x2*)(slot + (unsigned)(MX_HB_ARB + lane * 8)); o.ark = *(const MX_L mx_u32x2*)(slot + (unsigned)(MX_HB_ARK + lane * 8));
    o.vc = *(const MX_L mx_u32x2*)(slot + (unsigned)(MX_HB_VC + it * 512 + lane * 8));
    { const mx_u32x2 u = *(const MX_L mx_u32x2*)(slot + (unsigned)(MX_HB_U0 + it * 512 + lane * 8)); o.u0.x = mx_lo(u.x); o.u0.y = mx_hi(u.x); o.u0.z = mx_lo(u.y); o.u0.w = mx_hi(u.y); }
#define MX_LDJ(jt) do { o.gm##jt = *(const MX_L mx_f32x4*)(gamp + (unsigned)((16 * jt + 4 * g) * 4)); \
        o.bh##jt = *(const MX_L mx_u32x2*)(slot + (unsigned)(MX_HB_BH + jt * 512 + lane * 8)); o.kh##jt = *(const MX_L mx_u32x2*)(slot + (unsigned)(MX_HB_KH + jt * 512 + lane * 8)); } while (0)
    MX_LDJ(0); MX_LDJ(1); MX_LDJ(2); MX_LDJ(3);
#undef MX_LDJ
    return o;
}
MX_DEV mx_f32x4 mx_scan_compute(mx_f32x4 (&S)[4], const MxOps& o, int lane) {
    const int tk = lane & 15, g = lane >> 4;
    const mx_f32x4 z4 = mx_zero4();
    const mx_bf16x8 sb0 = mx_frag8v(S[0], S[1]), sb1 = mx_frag8v(S[2], S[3]);
    const mx_f32x4 U = mx_mfma(o.wa1, sb1, mx_mfma(o.wa0, sb0, o.u0));
    const mx_u32x2 ub = mx_frag4(U), vb = mx_frag4p(o.vc);
    mx_f32x4 Y = mx_mfma(o.rt1, sb1, mx_mfma(o.rt0, sb0, z4));
    Y = mx_mfma(mx_frag4p(o.ark), vb, mx_mfma(mx_frag4p(o.arb), ub, Y));
    S[0] = mx_mfma(mx_frag4p(o.kh0), vb, mx_mfma(mx_frag4p(o.bh0), ub, S[0] * o.gm0)); S[1] = mx_mfma(mx_frag4p(o.kh1), vb, mx_mfma(mx_frag4p(o.bh1), ub, S[1] * o.gm1));
    S[2] = mx_mfma(mx_frag4p(o.kh2), vb, mx_mfma(mx_frag4p(o.bh2), ub, S[2] * o.gm2)); S[3] = mx_mfma(mx_frag4p(o.kh3), vb, mx_mfma(mx_frag4p(o.bh3), ub, S[3] * o.gm3));
    mx_u32x2 selI = {0u, 0u};
    if ((tk >> 2) == g) { const unsigned one = (tk & 1) ? 0x3F800000u : 0x00003F80u; if ((tk & 3) >> 1) selI.y = one; else selI.x = one; }
    mx_f32x4 Yh, Yl;
#pragma unroll
    for (int e = 0; e < 4; ++e) { Yh[e] = __builtin_bit_cast(float, mx_bf(Y[e]) << 16); Yl[e] = Y[e] - Yh[e]; }
    return mx_mfma(mx_frag4(Yl), selI, mx_mfma(mx_frag4(Yh), selI, z4));
}
MX_DEV void mx_sequence(int l, int type, int h, const MX_G unsigned short* zseq, MX_G unsigned short* yseq  , int nchunks, MX_G unsigned char* gb  , MX_L unsigned char* lds, int wave,
                        int role, MX_G unsigned long long* xs, MX_G unsigned* flag, MX_G unsigned* tmo, MX_G unsigned char* ys  ) {
    const int lane0 = mx_lane();
    {
        const int tid = wave * 64 + lane0;
        MX_L float* par = (MX_L float*)(lds + MX_LDS_PAR);
        if (type == 0) {
            const MX_G float* wup = MXIN(I_WUP) + l * 64 * 256 + 64 * h; const MX_G float* aup = MXIN(I_AUP) + l * 64 * 256 + 64 * h; const MX_G float* gup = MXIN(I_GUP) + l * 128 * 256 + 64 * h;
            {
                const int ch = tid & 63, k0 = tid >> 6, sl = mx_slot_of_ch(ch);
                float vw[8], va[8], vg[16];
#pragma unroll
                for (int i = 0; i < 8; ++i) { vw[i] = wup[(k0 + 8 * i) * 256 + ch]; va[i] = aup[(k0 + 8 * i) * 256 + ch]; }
#pragma unroll
                for (int i = 0; i < 16; ++i) vg[i] = gup[(k0 + 8 * i) * 256 + ch];
#pragma unroll
                for (int i = 0; i < 8; ++i) { *(MX_L unsigned short*)(lds + MX_LDS_WW + sl * MX_RS64 + (k0 + 8 * i) * 2) = (unsigned short)mx_bf(vw[i]); *(MX_L unsigned short*)(lds + MX_LDS_WA + sl * MX_RS64 + (k0 + 8 * i) * 2) = (unsigned short)mx_bf(va[i]); }
#pragma unroll
                for (int i = 0; i < 16; ++i) *(MX_L unsigned short*)(lds + MX_LDS_WG + sl * MX_RS128 + (k0 + 8 * i) * 2) = (unsigned short)mx_bf(vg[i]);
            }
            const MX_G float* mu = MXIN(I_MU) + l * 1024;
            if (tid < 256) par[tid] = mu[ZC_RW_DW + tid];
            else if (tid < 448) { const int a = (tid - 256) >> 6, c = (tid - 256) & 63; par[tid] = mu[(a == 0 ? ZC_RW_R : (a == 1 ? ZC_RW_K : ZC_RW_V)) + 64 * h + c]; }
            if (tid < 448) { const int a = tid >> 6, c = tid & 63;
                const MX_G float* src = a == 0 ? MXIN(I_W0) : a == 1 ? MXIN(I_A0) : a == 2 ? MXIN(I_KK) : a == 3 ? MXIN(I_KA) : a == 4 ? MXIN(I_RK) : a == 5 ? MXIN(I_LNXW) : MXIN(I_LNXB);
                par[MX_P_W0 + tid] = src[l * 256 + 64 * h + c]; }
        } else {
            const MX_G float* cw = MXIN(I_CONV) + l * 4 * 768;
            for (int idx = tid; idx < 768; idx += 512) { const int d = idx / 192, a = (idx % 192) >> 6, c = idx & 63; par[idx] = cw[d * 768 + a * 256 + 64 * h + c]; }
            if (tid < 64) par[MX_P_GNW + tid] = MXIN(I_GNW)[l * 64 + tid];
        }
    }
    mx_wgsync();
    mx_f32x4 S[4];
#pragma unroll
    for (int jt = 0; jt < 4; ++jt) S[jt] = mx_zero4();
    MX_L float* st = (MX_L float*)(lds + MX_LDS_ST);
    typedef float mx_f32x2 __attribute__((ext_vector_type(2)));
    const int ngroups = nchunks / 8;
    for (int itr = role - 2; itr < ngroups; itr += 2) {
        int lane = lane0; MX_LAUNDER_V(lane);
        const int tk = lane & 15, g = lane >> 4;
        const bool scan_now = itr >= 0, more = itr + 2 < ngroups;
        const int par_c = (itr >> 1) & 1, par_n = ((itr + 2) >> 1) & 1;
        if (wave < 4 && scan_now) {
            const MX_L unsigned char* gamc = lds + MX_LDS_GAM + par_c * 2048;
            MX_G unsigned char* ysc = ys + par_c * MX_YS_PAR; MX_LAUNDER_S(ysc);
            if (itr > 0) {
                const unsigned want = 4u * (unsigned)itr;
                for (unsigned spins = 0;;) {
                    if ((unsigned)MX_UNIFORM(MX_FLAG_LOAD(flag)) >= want) break;
                    MX_SLEEP();
                    if (++spins > (1u << 20)) { if (lane == 0) MX_FLAG_STORE(tmo, 1u); break; }
                }
#pragma unroll
                for (int jt = 0; jt < 4; ++jt) { const MX_G unsigned long long* p = xs + (unsigned)(((wave * 4 + jt) * 64 + lane) * 2);
                    const unsigned long long a = MX_SC1_LOAD64(p), b = MX_SC1_LOAD64(p + 1);
                    mx_u32x4 w; w.x = (unsigned)a; w.y = (unsigned)(a >> 32); w.z = (unsigned)b; w.w = (unsigned)(b >> 32); S[jt] = __builtin_bit_cast(mx_f32x4, w); }
            }
#pragma unroll
            for (int c = 0; c < 8; ++c) {
                const MxOps o = mx_scan_load(lds + MX_LDS_HB + c * MX_HB_SLOT, gamc + c * 256, wave, lane);
                const mx_f32x4 yk = mx_scan_compute(S, o, lane);
                *(MX_G mx_f32x4*)(ysc + (unsigned)(((c * 4 + wave) * 64 + lane) * 16)) = yk;
                MX_SCHED();
            }
            if (itr + 1 < ngroups) {
#pragma unroll
                for (int jt = 0; jt < 4; ++jt) { MX_G unsigned long long* p = xs + (unsigned)(((wave * 4 + jt) * 64 + lane) * 2);
                    const mx_u32x4 w = __builtin_bit_cast(mx_u32x4, S[jt]);
                    MX_SC1_STORE64(p, (unsigned long long)w.x | ((unsigned long long)w.y << 32)); MX_SC1_STORE64(p + 1, (unsigned long long)w.z | ((unsigned long long)w.w << 32)); }
            }
            MX_VMWAIT();
            if (itr + 1 < ngroups) { if (lane == 0) MX_FLAG_ADD(flag, 1u); }
            unsigned pfw = 0u;
            if (more) {
                const int pc = 8 * (itr + 2) + 4 + wave;
                const MX_G unsigned short* zb = zseq + (size_t)pc * (ZP / 64) * 1024 + (lane & 15) * 64;
                if (type == 0) { pfw = *(const MX_G unsigned*)(zb + (ZC_RW_DW / 64 + g) * 1024); if (g < 3) pfw ^= *(const MX_G unsigned*)(zb + ((g == 0 ? ZC_RW_R : (g == 1 ? ZC_RW_K : ZC_RW_V)) / 64 + h) * 1024); }
                else { pfw = *(const MX_G unsigned*)(zb + ((g == 0 ? ZC_GD_Q : (g == 1 ? ZC_GD_K : (g == 2 ? ZC_GD_V : ZC_GD_G))) / 64 + h) * 1024); if (lane < 8) pfw ^= *(const MX_G unsigned*)(zb + (ZC_GD_B / 64) * 1024); }
            }
            MX_LDSWAIT(); mx_wgsync();
            MX_CONSUME(pfw);
        } else if (wave < 4) { mx_wgsync(); }
        MX_SCHED();
        MxFin fin; fin.on = scan_now && wave >= 4; fin.type = type; fin.wv = wave - 4; fin.yb = yseq; fin.t0 = 16 * 8 * (itr < 0 ? 0 : itr); fin.col0 = type * 256 + 64 * h; fin.gbp = gb + par_c * (8 * MX_GB_SLOT); fin.ysp = ys + par_c * MX_YS_PAR;
        fin.pf = (const MX_G unsigned short*)nullptr; fin.pfh = h;
        if (more) {
            const int c = (wave < 4) ? wave + 4 : wave - 4;
            MX_G unsigned char* gbn = gb + par_n * (8 * MX_GB_SLOT) + c * MX_GB_SLOT; MX_LAUNDER_S(gbn);
            MX_L unsigned char* slot = lds + MX_LDS_HB + c * MX_HB_SLOT; MX_L unsigned char* gamn = lds + MX_LDS_GAM + par_n * 2048 + c * 256;
            if (type == 0) mx_prep_rwkv(l, h, zseq, 8 * (itr + 2) + c, slot, gbn, gamn, wave >= 4, fin, lds, lane); else mx_prep_gdn(l, h, zseq, 8 * (itr + 2) + c, slot, gbn, gamn, wave >= 4, fin, lds, lane);
        } else if (wave >= 4) { mx_wgsync(); if (fin.on) mx_finalize(fin, lane); }
        MX_VMWAIT(); MX_LDSWAIT(); mx_wgsync();
    }
}

MX_DEV void mx_attn_unit4(int kvh, int q0, const MX_G unsigned short* zseq  , MX_G unsigned short* yatt  ,
                          const MX_L float* btab_all  , float Mb, const float (&esink)[4]  , const float (&qkw)[16], MX_L unsigned char* vts  , int lane) {
    const int tk = lane & 15, g = lane >> 4;
    const mx_f32x4 z4 = mx_zero4();
    const MX_G unsigned short* qrow = zseq + mx_zoff(q0 + tk, ZC_AT_Q + 256 * kvh + 8 * g);
    mx_u32x4 qa = *(const MX_G mx_u32x4*)(qrow), qb = *(const MX_G mx_u32x4*)(qrow + 512);
    mx_u32x4 kA[9], kB[9], vA[9], vB[9];
#pragma unroll
    for (int kt = 0; kt < 9; ++kt) {
        const int key0 = q0 - 128 + 16 * kt;
        if (key0 >= 0) {
            const MX_G unsigned short* krow = zseq + mx_zoff(key0 + tk, ZC_AT_K + 64 * kvh + 8 * g); const MX_G unsigned short* vrow = zseq + mx_zoff(key0 + tk, ZC_AT_V + 64 * kvh + 8 * g);
            kA[kt] = *(const MX_G mx_u32x4*)(krow); kB[kt] = *(const MX_G mx_u32x4*)(krow + 512);
            vA[kt] = *(const MX_G mx_u32x4*)(vrow); vB[kt] = *(const MX_G mx_u32x4*)(vrow + 512);
        } else { const mx_u32x4 z_ = {0u, 0u, 0u, 0u}; kA[kt] = z_; kB[kt] = z_; vA[kt] = z_; vB[kt] = z_; }
    }
    MX_SCHED();
    mx_bf16x8 Sel[2];
#pragma unroll
    for (int p = 0; p < 2; ++p) { mx_u32x4 w = {0u, 0u, 0u, 0u};
        if ((tk >> 2) == g) { const unsigned one = (tk & 1) ? 0x3F800000u : 0x00003F80u; const int q = 2 * p + ((tk & 3) >> 1); w.x = (q == 0) ? one : 0u; w.y = (q == 1) ? one : 0u; w.z = (q == 2) ? one : 0u; w.w = (q == 3) ? one : 0u; }
        Sel[p] = __builtin_bit_cast(mx_bf16x8, w); }
    float rk[9];
#pragma unroll
    for (int kt = 0; kt < 9; ++kt) {
        float ssk = 0.f;
        { const unsigned kk[8] = {kA[kt].x, kA[kt].y, kA[kt].z, kA[kt].w, kB[kt].x, kB[kt].y, kB[kt].z, kB[kt].w};
#pragma unroll
          for (int i = 0; i < 8; ++i) { const float a = mx_lo(kk[i]), b = mx_hi(kk[i]); ssk += a * a + b * b; } }
        rk[kt] = MX_RSQ(mx_rowsum4(ssk) * (1.f / 64.f) + 1e-6f);
#pragma unroll
        for (int dt = 0; dt < 4; ++dt) *(MX_L mx_u32x2*)(vts + (unsigned)(((kt * 4 + dt) * 64 + lane) * 8)) = mx_pack4(mx_mfma(__builtin_bit_cast(mx_bf16x8, (dt >> 1) ? vB[kt] : vA[kt]), Sel[dt & 1], z4));
    }
    MX_LDSWAIT(); MX_SCHED();
    for (int hh = 0; hh < 4; ++hh) {
        const int h = 4 * kvh + hh;
        const mx_u32x4 cqa = qa, cqb = qb;
        if (hh < 3) { qa = *(const MX_G mx_u32x4*)(qrow + 1024 * (hh + 1)); qb = *(const MX_G mx_u32x4*)(qrow + 1024 * (hh + 1) + 512); }
        const MX_L float* btab = btab_all + 128 * h;
        mx_bf16x8 QF[2];
        {
            float q[16]; float ss = 0.f;
            q[0] = mx_lo(cqa.x); q[1] = mx_hi(cqa.x); q[2] = mx_lo(cqa.y); q[3] = mx_hi(cqa.y); q[4] = mx_lo(cqa.z); q[5] = mx_hi(cqa.z); q[6] = mx_lo(cqa.w); q[7] = mx_hi(cqa.w);
            q[8] = mx_lo(cqb.x); q[9] = mx_hi(cqb.x); q[10] = mx_lo(cqb.y); q[11] = mx_hi(cqb.y); q[12] = mx_lo(cqb.z); q[13] = mx_hi(cqb.z); q[14] = mx_lo(cqb.w); q[15] = mx_hi(cqb.w);
#pragma unroll
            for (int i = 0; i < 16; ++i) ss += q[i] * q[i];
            ss = mx_rowsum4(ss);
            const float rs = MX_RSQ(ss * (1.f / 64.f) + 1e-6f);
#pragma unroll
            for (int i = 0; i < 16; ++i) q[i] = q[i] * rs * qkw[i];
            QF[0] = mx_frag8(q, q + 4); QF[1] = mx_frag8(q + 8, q + 12);
        }
        mx_f32x4 O[4];
#pragma unroll
        for (int dt = 0; dt < 4; ++dt) O[dt] = z4;
        float lsum = 0.f;
#pragma unroll
        for (int kt = 0; kt < 9; ++kt) {
            const int key0 = q0 - 128 + 16 * kt;
            const mx_f32x4 S = mx_mfma(__builtin_bit_cast(mx_bf16x8, kB[kt]), QF[1], mx_mfma(__builtin_bit_cast(mx_bf16x8, kA[kt]), QF[0], z4));
            mx_f32x4 P;
#pragma unroll
            for (int e = 0; e < 4; ++e) {
                const float rke = mx_shfl16l(rk[kt], 4 * g + e, lane);
                const int dist = (q0 + tk) - (key0 + 4 * g + e); const bool valid = (dist >= 0) && (dist < 128) && (key0 >= 0);
                float ex = MX_EXP(S[e] * rke + btab[dist & 127] - Mb); MX_LAUNDER_V(ex);
                P[e] = valid ? ex : 0.f; lsum += P[e];
            }
            const mx_u32x2 pf = mx_frag4(P);
#pragma unroll
            for (int dt = 0; dt < 4; ++dt) O[dt] = mx_mfma(mx_frag4p(*(const MX_L mx_u32x2*)(vts + (unsigned)(((kt * 4 + dt) * 64 + lane) * 8))), pf, O[dt]);
        }
        lsum = mx_rowsum4(lsum);
        const float inv = MX_RCP(lsum + esink[hh]);
        const int ycol = 512 + 64 * h;
#pragma unroll
        for (int dp = 0; dp < 2; ++dp) { mx_u32x4 o; o.x = mx_pk2(O[2 * dp].x * inv, O[2 * dp].y * inv); o.y = mx_pk2(O[2 * dp].z * inv, O[2 * dp].w * inv); o.z = mx_pk2(O[2 * dp + 1].x * inv, O[2 * dp + 1].y * inv); o.w = mx_pk2(O[2 * dp + 1].z * inv, O[2 * dp + 1].w * inv);
            *(MX_G mx_u32x4*)(yatt + mx_yoff(q0 + tk, ycol + mx_ch_off(2 * dp, g))) = o; }
    }
}

__device__ __forceinline__ float wave_allmax(float v) {
    v = fmaxf(v, dppf(v, 0)); v = fmaxf(v, dppf(v, 1)); v = fmaxf(v, dppf(v, 2)); v = fmaxf(v, dppf(v, 3));
    const float a = __builtin_bit_cast(float, __builtin_amdgcn_readlane(__builtin_bit_cast(int, v), 0)), b = __builtin_bit_cast(float, __builtin_amdgcn_readlane(__builtin_bit_cast(int, v), 16));
    const float c = __builtin_bit_cast(float, __builtin_amdgcn_readlane(__builtin_bit_cast(int, v), 32)), d = __builtin_bit_cast(float, __builtin_amdgcn_readlane(__builtin_bit_cast(int, v), 48));
    return fmaxf(fmaxf(a, b), fmaxf(c, d));
}
__device__ __forceinline__ void mixer_phase(Frame& F, int l) {
    const int blk = blockIdx.x;
    {
        const int lane = ltid() & 63;
        const LAS float* btab_all = (const LAS float*)(F.lds + BIAS_OFF);
        float mb = 0.f;
#pragma unroll
        for (int i = 0; i < 16; ++i) mb = fmaxf(mb, fabsf(btab_all[lane + 64 * i]));
        const int pair = blk >> 3, seg = blk & 7, b = pair >> 1, kvh = pair & 1;
        const MX_G float* qnw = MXIN(I_QNW) + l * 64; const MX_G float* knw = MXIN(I_KNW) + l * 64; const MX_G float* snk = MXIN(I_SINK) + l * 8 + 4 * kvh;
        float sk[4]; mx_f32x4 qkw4[4]; const float qn_l = qnw[lane], kn_l = knw[lane];
#pragma unroll
        for (int j = 0; j < 4; ++j) { const mx_f32x4 q4 = *(const MX_G mx_f32x4*)(qnw + 32 * (j >> 1) + 8 * (lane >> 4) + 4 * (j & 1)), k4 = *(const MX_G mx_f32x4*)(knw + 32 * (j >> 1) + 8 * (lane >> 4) + 4 * (j & 1));
            sk[j] = snk[j];
            qkw4[j] = q4 * k4; }
        const float Mb = 8.f * wave_allmax(fabsf(qn_l)) * wave_allmax(fabsf(kn_l)) + wave_allmax(mb);
        float esink[4];
#pragma unroll
        for (int hh = 0; hh < 4; ++hh) esink[hh] = __expf(sk[hh] - Mb);
        float qkw[16];
#pragma unroll
        for (int i = 0; i < 16; ++i) qkw[i] = 0.125f * qkw4[i >> 2][i & 3];
        const MX_G unsigned short* zseq = (const MX_G unsigned short*)FZ + (size_t)b * SEQ * ZP;
        MX_G unsigned short* yatt = (MX_G unsigned short*)FY + (size_t)b * SEQ * DM;
        for (int i = 0; i < 2; ++i) {
            const int qt = 16 * seg + F.wave + 8 * i;
            int ln = lane; MX_LAUNDER_V(ln);
            mx_attn_unit4(kvh, 16 * qt, zseq, yatt, btab_all, Mb, esink, qkw, F.lds + RING_OFF + F.wave * 18432, ln);
        }
    }
    __syncthreads();
    {
        const int seq = blk & 127, role = blk >> 7, type = seq >> 6, bh = seq & 63, b = bh >> 2, h = bh & 3;
        const MX_G unsigned short* zseq = (const MX_G unsigned short*)FZ + (size_t)b * SEQ * ZP;
        MX_G unsigned short* yseq = (MX_G unsigned short*)FY + (size_t)b * SEQ * DM;
        MX_G unsigned* ctlw = (MX_G unsigned*)WSP(WS_CTL);
        mx_sequence(l, type, h, zseq, yseq, SEQ / 16, (MX_G unsigned char*)WSP(WS_HB) + (size_t)blk * (2 * 8 * MX_GB_SLOT), F.lds + RING_OFF, F.wave,
                    role, (MX_G unsigned long long*)WSP(WS_XS) + (size_t)seq * 2048, ctlw + CW_SEQ + (l * 128 + seq) * 64, ctlw + CW_TMO,
                    (MX_G unsigned char*)WSP(WS_HB) + (size_t)256 * (2 * 8 * MX_GB_SLOT) + (size_t)blk * (2 * MX_YS_PAR));
    }
}
constexpr int PH_PER_L = 5, NPH = 1 + DEPTH * PH_PER_L;
struct Args { const float* in[26]; float* out; unsigned char* ws; int ph_lo, ph_hi; };
__global__ void __launch_bounds__(NWAVES * 64, 2) fwd(Args args) {
    extern __shared__ __attribute__((aligned(16))) unsigned char lds[];
    Frame F;
    F.lds = (LAS unsigned char*)lds;
    const int tid0 = threadIdx.x; F.wave = __builtin_amdgcn_readfirstlane(tid0 >> 6);
    F.G = gridDim.x; { const int bx = blockIdx.x; F.vcu = (F.G % 8 == 0) ? (bx % 8) * (F.G / 8) + bx / 8 : bx; }
    F.ws = args.ws; F.out = args.out;
    for (int u = tid0; u < (BIAS_OFF - LDSCTL_OFF) / 4; u += NWAVES * 64) ((LAS unsigned*)(F.lds + LDSCTL_OFF))[u] = 0u;
    for (int u = tid0; u < 8 * 128; u += NWAVES * 64) {
        const int h = u >> 7, d = u & 127;
        int bucket;
        if (d < 16) bucket = d;
        else { int lg = 16 + (int)(logf((float)d / 16.f) / logf(8.f) * 16.f); bucket = lg < 31 ? lg : 31; }
        ((LAS float*)(F.lds + BIAS_OFF))[u] = INP(I_RELB)[bucket * 8 + h];
    }
    __syncthreads();
    const int lo = args.ph_lo, hi = args.ph_hi;
    const bool one = (hi - lo) > 1;
    XcdBarrier bar; bar.bar = (unsigned*)(F.ws + WS_CTL) + CW_BAR; bar.x = 0; bar.st = nullptr;
    if (one) bar = xcd_barrier_post((unsigned*)(F.ws + WS_CTL) + CW_BAR, (volatile LAS unsigned*)(F.lds + MISC_OFF) + 8, tid0 == 0);
#define IN(k) (lo <= (k) && (k) < hi)
#define SEAM(k) do { if (IN(k) && IN((k) + 1)) { XcdBarrier b2_ = bar; asm volatile("" : "+s"(b2_.bar)); xcd_barrier(b2_, F.wave == 0 && hw_lane() == 0); } } while (0)

    #ifndef DIS_PRO
    if (IN(0)) { p0_prologue(F); SEAM(0); }
#endif
    for (int l = 0; l < DEPTH; ++l) {
        const int pb = 1 + PH_PER_L * l;
        if (IN(pb + 0)) {
            pg8::Gemm g{FXN, ((bf16*)WSP(WS_WIN)) + (size_t)l * ZP * DM, M, ZP, DM}; pg8::StaticOrder S; S.init(M, ZP, F.G, (int)blockIdx.x);
            pg8::EpiBf16<0, true> E{FZ, ZP, (const float*)WSP(WS_RSS) + (size_t)(2 * l) * M * 16};
            pg8::gemm_phase<pg8::EpiBf16<0, true>, pg8::StaticOrder, true, true>(F.lds + RING_OFF, g, S, E, F.wave);
            SEAM(pb + 0);
        }
        if (IN(pb + 1)) { mixer_phase(F, l); SEAM(pb + 1); }
        if (IN(pb + 2)) {
            pg8::Gemm g{FY, ((bf16*)WSP(WS_WOUT)) + (size_t)l * DM * DM, M, DM, DM}; pg8::StaticOrder S; S.init(M, DM, F.G, (int)blockIdx.x);
            pg8::EpiResBf16 E{FXN, DM, (float*)nullptr, (float*)WSP(WS_RSS) + (size_t)(2 * l + 1) * M * 16};
            pg8::gemm_phase<pg8::EpiResBf16, pg8::StaticOrder, true, true>(F.lds + RING_OFF, g, S, E, F.wave);
            SEAM(pb + 2);
        }
        if (IN(pb + 3)) {
            pg8::Gemm g{FXN, ((bf16*)WSP(WS_W1)) + (size_t)l * DFF * DM, M, DFF, DM}; pg8::StaticOrder S; S.init(M, DFF, F.G, (int)blockIdx.x);
            pg8::EpiBf16<2> E{FH, DFF, (const float*)WSP(WS_RSS) + (size_t)(2 * l + 1) * M * 16};
            pg8::gemm_phase<pg8::EpiBf16<2>, pg8::StaticOrder, true, true>(F.lds + RING_OFF, g, S, E, F.wave);
            SEAM(pb + 3);
        }
        if (IN(pb + 4)) {
            pg8::Gemm g{FH, ((bf16*)WSP(WS_W2)) + (size_t)l * DM * DFF, M, DM, DFF}; pg8::StaticOrder S; S.init(M, DM, F.G, (int)blockIdx.x);
            pg8::EpiResBf16 E{FXN, DM, l + 1 < DEPTH ? (float*)nullptr : F.out, l + 1 < DEPTH ? (float*)WSP(WS_RSS) + (size_t)(2 * l + 2) * M * 16 : (float*)nullptr};
            pg8::gemm_phase<pg8::EpiResBf16, pg8::StaticOrder, true, true>(F.lds + RING_OFF, g, S, E, F.wave);
            SEAM(pb + 4);
        }
    }
#undef IN
#undef SEAM
}

#ifndef MK_ONE_LAUNCH
#define MK_ONE_LAUNCH 1
#endif
extern "C" void kernel_launch(void* const* d_in, const int* in_sizes, int n_in, void* d_out, int out_size, void* d_ws, size_t ws_size, hipStream_t stream) {
    static int grid = 0;
    if (grid == 0) {
        if (n_in != 26 || in_sizes[0] != M * DM || out_size != M * DM || ws_size < WS_END) { fprintf(stderr, "kernel_launch: unexpected shapes (n_in %d, in0 %d, out %d, ws %zu, need %zu)\n", n_in, n_in > 0 ? in_sizes[0] : -1, out_size, ws_size, (size_t)WS_END); grid = -1; return; }
        int dev = 0, cus = 0, per_cu = 0;
        if (hipGetDevice(&dev) != hipSuccess || hipDeviceGetAttribute(&cus, hipDeviceAttributeMultiprocessorCount, dev) != hipSuccess) { grid = -1; return; }
        if (hipFuncSetAttribute((const void*)fwd, hipFuncAttributeMaxDynamicSharedMemorySize, LDS_BYTES) != hipSuccess) { fprintf(stderr, "kernel_launch: hipFuncSetAttribute failed\n"); grid = -1; return; }
        if (hipOccupancyMaxActiveBlocksPerMultiprocessor(&per_cu, (const void*)fwd, NWAVES * 64, LDS_BYTES) != hipSuccess || per_cu < 1) fprintf(stderr, "kernel_launch: occupancy query reports %d\n", per_cu);
        (void)hipGetLastError();
        grid = cus;
    }
    if (grid < 0) return;
    if (hipMemsetAsync((char*)d_ws + WS_CTL, 0, CTL_ZERO_BYTES, stream) != hipSuccess) return;
    Args a{};
    for (int i = 0; i < 26; ++i) a.in[i] = (const float*)d_in[i];
    a.out = (float*)d_out; a.ws = (unsigned char*)d_ws;
#if MK_ONE_LAUNCH
    a.ph_lo = 0; a.ph_hi = NPH;
    hipLaunchKernelGGL(fwd, dim3(grid), dim3(NWAVES * 64), LDS_BYTES, stream, a);
#else
    for (int ph = 0; ph < NPH; ++ph) {
        a.ph_lo = ph; a.ph_hi = ph + 1;
        hipLaunchKernelGGL(fwd, dim3(grid), dim3(NWAVES * 64), LDS_BYTES, stream, a);
    }
#endif
}
```

```cpp
#include <hip/hip_runtime.h>
#include <cstdio>
#include <cstdint>
#include <cmath>
#include <type_traits>
__device__ __forceinline__ int hwl_() { int t; asm volatile("v_mbcnt_lo_u32_b32 %0, -1, 0\n\tv_mbcnt_hi_u32_b32 %0, -1, %0" : "=v"(t)); return t; }
__device__ __forceinline__ float xor16f(float v) { return __builtin_bit_cast(float, __builtin_amdgcn_ds_swizzle(__builtin_bit_cast(int, v), 0x401F)); }
__device__ __forceinline__ float xor32f(float v) { return __builtin_bit_cast(float, __builtin_amdgcn_ds_bpermute((hwl_() ^ 32) << 2, __builtin_bit_cast(int, v))); }
namespace pg8 {
#define PG8_LAS __attribute__((address_space(3)))
typedef unsigned short bf16_t;
typedef short bf16x8 __attribute__((ext_vector_type(8)));
typedef float f32x4 __attribute__((ext_vector_type(4)));
typedef unsigned u32x4 __attribute__((ext_vector_type(4)));
constexpr int BM = 256, BK = 64, HALF = 128, HTB = HALF * BK * 2  , STAGE_BYTES = 8 * HTB, NXCD = 8, WGM = 8;

__host__ __device__ __forceinline__ int lds_byte(int r, int c) { const int st = (r >> 4) * 2 + (c >> 5), rr = r & 15, cc = c & 31, ob = rr * 64 + cc * 2; return st * 1024 + (ob ^ (((ob >> 9) & 1) << 5)); }
__host__ __device__ __forceinline__ size_t tiled_byte(int row, int col, int nt) { return ((size_t)((row >> 8) * nt + (col >> 6)) * 2 + ((row >> 7) & 1)) * 16384 + lds_byte(row & 127, col & 63); }
__host__ __device__ __forceinline__ void stage_rc(int b, int& R, int& C) { const int st = b / 1024, sb = b % 1024, swz = sb ^ (((sb >> 9) & 1) << 5); R = (st >> 1) * 16 + swz / 64; C = (st & 1) * 32 + (swz % 64) / 2; }
__host__ __device__ __forceinline__ int perm32(int rho) { const int n = rho >> 4, i = rho & 15; return 8 * (i >> 2) + 4 * n + (i & 3); }

struct Unit { int pm, pn; };
struct Gemm { const bf16_t* A; const bf16_t* Bt; int M, N, K; };

struct StaticOrder {
    int nM, nN, nwg, G, c;
    __host__ __device__ void init(int M, int N, int G_, int c_) { nM = M / BM; nN = N / BM; nwg = nM * nN; G = G_; c = c_; }
    __host__ __device__ bool next(int i, Unit& u) const {
        const long L = (long)i * G + c; if (L >= nwg) return false;
        int wgid = (int)L; { const int q = nwg / NXCD, r = nwg % NXCD, xcd = wgid % NXCD, off = wgid / NXCD; wgid = (xcd < r ? xcd * (q + 1) : r * (q + 1) + (xcd - r) * q) + off; }
        const int nig = WGM * nN, gid = wgid / nig, fm = gid * WGM, gsz = (nM - fm) < WGM ? (nM - fm) : WGM;
        u.pm = fm + ((wgid % nig) % gsz); u.pn = (wgid % nig) / gsz; return true;
    }
    __device__ __forceinline__ void a_ready(const Unit&) const {}
    __device__ __forceinline__ void done(const Unit&) const {}
};

__device__ __forceinline__ unsigned cvt_pk_bf16(float lo, float hi) { unsigned r; asm volatile("v_cvt_pk_bf16_f32 %0, %1, %2" : "=v"(r) : "v"(lo), "v"(hi)); return r; }
#define PG8_GAS __attribute__((address_space(1)))
template <int ACT  , bool ZB = false  > struct EpiBf16 {
    static constexpr bool PERM = true, AFTER_DRAIN = false;
    static constexpr int NST = 16;
    static constexpr bool INIT = false;
    bf16_t* O; int ldc; const float* rss;
    __device__ __forceinline__ void operator()(const f32x4 (&acc)[2][2][4][2], const Unit& u, int wr, int wc, int fr, int fq) const {
        const int row0 = u.pm * BM + wr * 64 + fr, col0 = u.pn * BM + wc * 32 + 8 * fq;
        float rs[8];
        { f32x4 pr[8];
#pragma unroll
          for (int r = 0; r < 8; ++r) pr[r] = *(const PG8_GAS f32x4*)(rss + (size_t)(row0 + (r >> 2) * HALF + (r & 3) * 16) * 16 + 4 * fq);
          __builtin_amdgcn_sched_barrier(0);
#pragma unroll
          for (int r = 0; r < 8; ++r) { float ssum = (pr[r][0] + pr[r][1]) + (pr[r][2] + pr[r][3]); ssum += ::xor16f(ssum); ssum += ::xor32f(ssum); rs[r] = __builtin_amdgcn_rsqf(ssum * (1.f / 1024.f) + 1e-6f); } }
#pragma unroll
        for (int ai = 0; ai < 2; ++ai)
#pragma unroll
            for (int m = 0; m < 4; ++m) { const int row = row0 + ai * HALF + m * 16; const float rsr = rs[ai * 4 + m];
                bf16_t* rowp = ZB ? O + ((size_t)(row >> 4) * (ldc / 64) + (col0 >> 6)) * 1024 + ((col0 >> 5) & 1) * 512 + (row & 15) * 32 + (col0 & 31) : (bf16_t*)((char*)O + tiled_byte(row, col0, ldc >> 6));
#pragma unroll
                for (int bj = 0; bj < 2; ++bj) { f32x4 v0 = acc[ai][bj][m][0] * rsr, v1 = acc[ai][bj][m][1] * rsr;
                    if (ACT == 2) {
#pragma unroll
                        for (int e = 0; e < 4; ++e) { const float a = v0[e] > 0.f ? v0[e] : 0.f, b = v1[e] > 0.f ? v1[e] : 0.f; v0[e] = a * a; v1[e] = b * b; } }
                    u32x4 w; w.x = cvt_pk_bf16(v0[0], v0[1]); w.y = cvt_pk_bf16(v0[2], v0[3]); w.z = cvt_pk_bf16(v1[0], v1[1]); w.w = cvt_pk_bf16(v1[2], v1[3]);
                    *(PG8_GAS u32x4*)(rowp + (ZB ? bj * (HALF / 64) * 1024 : bj * (HALF / 64) * 2 * 8192)) = w; } }
    }
};
struct EpiResF32 {
    static constexpr bool INIT = false;
    static constexpr bool PERM = true, AFTER_DRAIN = false;
    static constexpr int NST = 16;
    const float* base; float* out; int ldc; bf16_t* xn; float* rss;
    __device__ __forceinline__ void operator()(const f32x4 (&acc)[2][2][4][2], const Unit& u, int wr, int wc, int fr, int fq) const {
        const int row0 = u.pm * BM + wr * 64 + fr, col0 = u.pn * BM + wc * 32 + 8 * fq;
#pragma unroll
        for (int ai = 0; ai < 2; ++ai)
#pragma unroll
            for (int m = 0; m < 4; ++m) { const int row = row0 + ai * HALF + m * 16; const size_t off = (size_t)row * ldc + col0; float ss = 0.f;
#pragma unroll
                for (int bj = 0; bj < 2; ++bj) {
                    const f32x4 b0 = *(const PG8_GAS f32x4*)(base + off + bj * HALF), b1 = *(const PG8_GAS f32x4*)(base + off + bj * HALF + 4);
                    const f32x4 o0 = b0 + acc[ai][bj][m][0], o1 = b1 + acc[ai][bj][m][1];
                    *(PG8_GAS f32x4*)(out + off + bj * HALF) = o0; *(PG8_GAS f32x4*)(out + off + bj * HALF + 4) = o1;
                    if (xn) { u32x4 w; w.x = cvt_pk_bf16(o0[0], o0[1]); w.y = cvt_pk_bf16(o0[2], o0[3]); w.z = cvt_pk_bf16(o1[0], o1[1]); w.w = cvt_pk_bf16(o1[2], o1[3]); *(PG8_GAS u32x4*)(xn + off + bj * HALF) = w;
                        ss += ((o0[0] * o0[0] + o0[1] * o0[1]) + (o0[2] * o0[2] + o0[3] * o0[3])) + ((o1[0] * o1[0] + o1[1] * o1[1]) + (o1[2] * o1[2] + o1[3] * o1[3])); } }
                if (xn) { ss += ::xor16f(ss); ss += ::xor32f(ss); if (fq == 0) *(PG8_GAS float*)(rss + (size_t)row * 16 + 4 * u.pn + wc) = ss; } }
    }
};

struct EpiResBf16 {
    static constexpr bool PERM = true, AFTER_DRAIN = false;
    static constexpr bool INIT = true;
    static constexpr int NST = 16;
    bf16_t* x; int ldc; float* outf; float* rss;
    __device__ __forceinline__ void init(f32x4 (&acc)[2][2][4][2], const Unit& u, int wr, int wc, int fr, int fq) const {
        const int row0 = u.pm * BM + wr * 64 + fr, col0 = u.pn * BM + wc * 32 + 8 * fq, ntx = ldc >> 6; constexpr size_t XH = (size_t)(HALF / 64) * 2 * 8192;
        u32x4 bv[8][2];
#pragma unroll
        for (int r = 0; r < 8; ++r) { const char* bp_ = (const char*)x + tiled_byte(row0 + (r >> 2) * HALF + (r & 3) * 16, col0, ntx); bv[r][0] = *(const PG8_GAS u32x4*)(bp_); bv[r][1] = *(const PG8_GAS u32x4*)(bp_ + 2 * XH); }
#pragma unroll
        for (int r = 0; r < 8; ++r)
#pragma unroll
            for (int bj = 0; bj < 2; ++bj) { const u32x4 b = bv[r][bj]; const int ai = r >> 2, m = r & 3;
                acc[ai][bj][m][0] = (f32x4){__builtin_bit_cast(float, b.x << 16), __builtin_bit_cast(float, b.x & 0xffff0000u), __builtin_bit_cast(float, b.y << 16), __builtin_bit_cast(float, b.y & 0xffff0000u)};
                acc[ai][bj][m][1] = (f32x4){__builtin_bit_cast(float, b.z << 16), __builtin_bit_cast(float, b.z & 0xffff0000u), __builtin_bit_cast(float, b.w << 16), __builtin_bit_cast(float, b.w & 0xffff0000u)}; }
    }
    __device__ __forceinline__ void operator()(const f32x4 (&acc)[2][2][4][2], const Unit& u, int wr, int wc, int fr, int fq) const {
        const int row0 = u.pm * BM + wr * 64 + fr, col0 = u.pn * BM + wc * 32 + 8 * fq, ntx = ldc >> 6; constexpr size_t XH = (size_t)(HALF / 64) * 2 * 8192;
#pragma unroll
        for (int r = 0; r < 8; ++r) { const int ai = r >> 2, m = r & 3; const int row = row0 + ai * HALF + m * 16; const size_t off = (size_t)row * ldc + col0; float ss = 0.f;
#pragma unroll
            for (int bj = 0; bj < 2; ++bj) {
                const f32x4 o0 = acc[ai][bj][m][0], o1 = acc[ai][bj][m][1];
                if (outf) { *(PG8_GAS f32x4*)(outf + off + bj * HALF) = o0; *(PG8_GAS f32x4*)(outf + off + bj * HALF + 4) = o1; }
                else { u32x4 w; w.x = cvt_pk_bf16(o0[0], o0[1]); w.y = cvt_pk_bf16(o0[2], o0[3]); w.z = cvt_pk_bf16(o1[0], o1[1]); w.w = cvt_pk_bf16(o1[2], o1[3]); *(PG8_GAS u32x4*)((char*)x + tiled_byte(row, col0, ntx) + bj * 2 * XH) = w;
                    ss += ((o0[0] * o0[0] + o0[1] * o0[1]) + (o0[2] * o0[2] + o0[3] * o0[3])) + ((o1[0] * o1[0] + o1[1] * o1[1]) + (o1[2] * o1[2] + o1[3] * o1[3])); } }
            if (!outf) { ss += ::xor16f(ss); ss += ::xor32f(ss); if (fq == 0) *(PG8_GAS float*)(rss + (size_t)row * 16 + 4 * u.pn + wc) = ss; } }
    }
};
template <int N> __device__ __forceinline__ void wait_v8_or(int relaxed) { static_assert(N > 8 && N <= 63, "vmcnt is 6 bits");
    asm volatile("s_cmp_lg_u32 %0, 0\n\ts_cbranch_scc1 .Lpg8wv%=\n\ts_waitcnt vmcnt(8)\n.Lpg8wv%=:\n\ts_waitcnt vmcnt(%1)" :: "s"(relaxed), "n"(N) : "memory", "scc"); }
template <class Epi, class Sched, bool ALIGN_EPI = false, bool SP2 = false>
__device__ __forceinline__ void gemm_phase(PG8_LAS unsigned char* lds, const Gemm g, const Sched& S, const Epi& E, const int wave_id  ) {
    int tid_l = wave_id * 64 + ::hwl_();
    const int tid = tid_l, wid = __builtin_amdgcn_readfirstlane(tid >> 6), lane = tid & 63, wr = wid >> 2, wc = wid & 3, fr = lane & 15, fq = lane >> 4;
    const int K = g.K, nt = K / BK;
    unsigned voffA[2], voffB[2];
#pragma unroll
    for (int i = 0; i < 2; ++i) { int R, C; stage_rc(tid * 16 + i * 8192, R, C); const int Rb = Epi::PERM ? ((R & ~31) + perm32(R & 31)) : R;
        voffA[i] = (unsigned)(tid * 16 + i * 8192); voffB[i] = voffA[i]; (void)Rb; (void)R; (void)C; }
    const size_t kstep = 2 * HTB;
    const size_t hstep = HTB;
    const size_t tstep = (size_t)nt * 2 * HTB;
    const size_t kstepB = 2 * HTB, hstepB = HTB, tstepB = (size_t)nt * 2 * HTB;
    const unsigned ldsw = (unsigned)wid * 1024u;
    const int aoff = lds_byte(wr * 64 + fr, fq * 8), boff = lds_byte(wc * 32 + fr, fq * 8);
#define PG8_SA(b, h) (((b) * 2 + (h)) * HTB)
#define PG8_SB(b, h) ((4 + (b) * 2 + (h)) * HTB)
#define PG8_STAGE(bufoff, gbase, voff) do { _Pragma("unroll") for (int _i = 0; _i < 2; ++_i) \
        __builtin_amdgcn_global_load_lds((const unsigned*)((const char*)(gbase) + (voff)[_i]), (PG8_LAS unsigned*)(lds + (bufoff) + ldsw + _i * 8192), 16, 0, 0); } while (0)
#define PG8_LDA(dst, b, h) do { _Pragma("unroll") for (int m = 0; m < 4; ++m) _Pragma("unroll") for (int k = 0; k < 2; ++k) dst[m][k] = *(const PG8_LAS bf16x8*)(lds + PG8_SA(b, h) + aoff + m * 2048 + k * 1024); } while (0)
#define PG8_LDB(dst, b, h) do { _Pragma("unroll") for (int n = 0; n < 2; ++n) _Pragma("unroll") for (int k = 0; k < 2; ++k) dst[n][k] = *(const PG8_LAS bf16x8*)(lds + PG8_SB(b, h) + boff + n * 2048 + k * 1024); } while (0)
#define PG8_MMA(ai, bj, At, Bt) do { __builtin_amdgcn_s_setprio(1); _Pragma("unroll") for (int m = 0; m < 4; ++m) _Pragma("unroll") for (int n = 0; n < 2; ++n) _Pragma("unroll") for (int k = 0; k < 2; ++k) \
        acc[ai][bj][m][n] = __builtin_amdgcn_mfma_f32_16x16x32_bf16(Bt[n][k], At[m][k], acc[ai][bj][m][n], 0, 0, 0); __builtin_amdgcn_s_setprio(0); } while (0)
#define PG8_WAIT_V(n) asm volatile("s_waitcnt vmcnt(" #n ")" ::: "memory")
#define PG8_WAIT_L(n) asm volatile("s_waitcnt lgkmcnt(" #n ")" ::: "memory")
#define PG8_BAR __builtin_amdgcn_s_barrier()
#define PG8_SCHED __builtin_amdgcn_sched_barrier(0)
    Unit cur, nxt; int ui = 0;
    if (!S.next(0, cur)) return;
    f32x4 acc[2][2][4][2];
#pragma unroll
    for (int a = 0; a < 2; ++a)
#pragma unroll
        for (int b = 0; b < 2; ++b)
#pragma unroll
            for (int m = 0; m < 4; ++m)
#pragma unroll
                for (int n = 0; n < 2; ++n) acc[a][b][m][n] = (f32x4){0.f, 0.f, 0.f, 0.f};
    bf16x8 At[4][2], B0[2][2], B1[2][2];
    const char* cA = (const char*)g.A + (size_t)cur.pm * tstep; const char* cB = (const char*)g.Bt + (size_t)cur.pn * tstepB;
    S.a_ready(cur);
    if constexpr (Epi::INIT) E.init(acc, cur, wr, wc, fr, fq);
    if constexpr (SP2) {
        PG8_STAGE(PG8_SB(0, 0), cB, voffB); PG8_STAGE(PG8_SB(0, 1), cB + hstepB, voffB); PG8_STAGE(PG8_SA(0, 0), cA, voffA); PG8_STAGE(PG8_SA(0, 1), cA + hstep, voffA);
        if (wr == 1) PG8_BAR;
        PG8_WAIT_V(2); PG8_BAR;
        PG8_STAGE(PG8_SB(1, 0), cB + kstepB, voffB); PG8_STAGE(PG8_SA(1, 0), cA + kstep, voffA); PG8_STAGE(PG8_SB(1, 1), cB + hstepB + kstepB, voffB);
        PG8_WAIT_V(6); PG8_BAR;
    } else {
        PG8_STAGE(PG8_SB(0, 0), cB, voffB); PG8_STAGE(PG8_SA(0, 0), cA, voffA); PG8_STAGE(PG8_SB(0, 1), cB + hstepB, voffB); PG8_STAGE(PG8_SA(0, 1), cA + hstep, voffA);
        if (wr == 1) PG8_BAR;
        PG8_WAIT_V(4); PG8_BAR;
        PG8_STAGE(PG8_SB(1, 0), cB + kstepB, voffB); PG8_STAGE(PG8_SA(1, 0), cA + kstep, voffA); PG8_STAGE(PG8_SB(1, 1), cB + hstepB + kstepB, voffB);
        PG8_WAIT_V(6); PG8_BAR;
    }
    for (;;) {
        const bool has_next = S.next(ui + 1, nxt);
        const char* nA = has_next ? (const char*)g.A + (size_t)nxt.pm * tstep : cA; const char* nB = has_next ? (const char*)g.Bt + (size_t)nxt.pn * tstepB : cB;
        for (int t = 0; t < nt; t += 2) {
            const bool last = (t == nt - 2);
            const char* a1 = cA + (size_t)(t + 1) * kstep;
            const char* a2 = last ? nA : cA + (size_t)(t + 2) * kstep; const char* b2 = last ? nB : cB + (size_t)(t + 2) * kstepB;
            const char* a3 = a2 + kstep; const char* b3 = b2 + kstepB;
            if (last && has_next) S.a_ready(nxt);
            if constexpr (SP2) {
            const int relaxed = __builtin_amdgcn_readfirstlane((t == 0 && ui > 0) ? 1 : 0);
            PG8_LDB(B0, 0, 0); PG8_LDB(B1, 0, 1); PG8_SCHED; PG8_LDA(At, 0, 0); PG8_STAGE(PG8_SA(1, 1), a1 + hstep, voffA);
            wait_v8_or<8 + Epi::NST>(relaxed); PG8_WAIT_L(0); PG8_BAR; PG8_MMA(0, 0, At, B0); PG8_MMA(0, 1, At, B1); PG8_BAR; PG8_SCHED;
            PG8_LDA(At, 0, 1); PG8_STAGE(PG8_SB(0, 0), b2, voffB); PG8_STAGE(PG8_SB(0, 1), b2 + hstepB, voffB); PG8_STAGE(PG8_SA(0, 0), a2, voffA);
            wait_v8_or<8 + Epi::NST>(relaxed); PG8_WAIT_L(0); PG8_BAR; PG8_MMA(1, 0, At, B0); PG8_MMA(1, 1, At, B1); PG8_BAR; PG8_SCHED;
            PG8_LDB(B0, 1, 0); PG8_LDB(B1, 1, 1); PG8_SCHED; PG8_LDA(At, 1, 0); PG8_STAGE(PG8_SA(0, 1), a2 + hstep, voffA);
            PG8_WAIT_V(8); PG8_WAIT_L(0); PG8_BAR; PG8_MMA(0, 0, At, B0); PG8_MMA(0, 1, At, B1); PG8_BAR; PG8_SCHED;
            PG8_LDA(At, 1, 1); PG8_STAGE(PG8_SB(1, 0), b3, voffB); PG8_STAGE(PG8_SB(1, 1), b3 + hstepB, voffB); PG8_STAGE(PG8_SA(1, 0), a3, voffA);
            PG8_WAIT_V(8); PG8_WAIT_L(0); PG8_BAR; PG8_MMA(1, 0, At, B0); PG8_MMA(1, 1, At, B1); PG8_BAR; PG8_SCHED;
            } else {
            PG8_LDB(B0, 0, 0); PG8_SCHED; PG8_LDA(At, 0, 0); PG8_STAGE(PG8_SA(1, 1), a1 + hstep, voffA);
            PG8_WAIT_L(8); PG8_BAR; PG8_WAIT_L(0); PG8_MMA(0, 0, At, B0); PG8_BAR; PG8_SCHED;
            PG8_LDB(B1, 0, 1); PG8_STAGE(PG8_SB(0, 0), b2, voffB);
            PG8_BAR; PG8_WAIT_L(0); PG8_MMA(0, 1, At, B1); PG8_BAR;
            PG8_LDA(At, 0, 1); PG8_STAGE(PG8_SA(0, 0), a2, voffA);
            PG8_BAR; PG8_WAIT_L(0); PG8_MMA(1, 0, At, B0); PG8_BAR; PG8_SCHED;
            PG8_STAGE(PG8_SB(0, 1), b2 + hstepB, voffB);
            PG8_WAIT_V(6); PG8_BAR; PG8_MMA(1, 1, At, B1); PG8_BAR;
            PG8_LDB(B0, 1, 0); PG8_SCHED; PG8_LDA(At, 1, 0); PG8_STAGE(PG8_SA(0, 1), a2 + hstep, voffA);
            PG8_WAIT_L(8); PG8_BAR; PG8_WAIT_L(0); PG8_MMA(0, 0, At, B0); PG8_BAR; PG8_SCHED;
            PG8_LDB(B1, 1, 1); PG8_STAGE(PG8_SB(1, 0), b3, voffB);
            PG8_BAR; PG8_WAIT_L(0); PG8_MMA(0, 1, At, B1); PG8_BAR;
            PG8_LDA(At, 1, 1); PG8_STAGE(PG8_SA(1, 0), a3, voffA);
            PG8_BAR; PG8_WAIT_L(0); PG8_MMA(1, 0, At, B0); PG8_BAR; PG8_SCHED;
            PG8_STAGE(PG8_SB(1, 1), b3 + hstepB, voffB);
            PG8_WAIT_V(6); PG8_BAR; PG8_MMA(1, 1, At, B1); PG8_BAR;
            }
        }
        if constexpr (ALIGN_EPI) { if (wr == 0) PG8_BAR; }
        if constexpr (!Epi::AFTER_DRAIN) { E(acc, cur, wr, wc, fr, fq); S.done(cur); }
        if (!has_next) break;
#pragma unroll
        for (int a = 0; a < 2; ++a)
#pragma unroll
            for (int b = 0; b < 2; ++b)
#pragma unroll
                for (int m = 0; m < 4; ++m)
#pragma unroll
                    for (int n = 0; n < 2; ++n) acc[a][b][m][n] = (f32x4){0.f, 0.f, 0.f, 0.f};
        if constexpr (Epi::INIT) E.init(acc, nxt, wr, wc, fr, fq);
        cur = nxt; cA = nA; cB = nB; ++ui;
        if constexpr (ALIGN_EPI) { if (wr == 1) PG8_BAR; }
    }
    PG8_WAIT_V(0);
    if constexpr (!ALIGN_EPI) { if (wr == 0) PG8_BAR; }
    PG8_BAR;
    if constexpr (Epi::AFTER_DRAIN) { E.fused(acc, cur, wr, wc, fr, fq, lds, wid, lane); S.done(cur); }
#undef PG8_SA
#undef PG8_SB
#undef PG8_STAGE
#undef PG8_LDA
#undef PG8_LDB
#undef PG8_MMA
#undef PG8_WAIT_V
#undef PG8_WAIT_L
#undef PG8_BAR
#undef PG8_SCHED
}
}
constexpr int NWAVES = 8;
constexpr int BATCH = 16, SEQ = 2048, DM = 1024, DEPTH = 4, DFF = 4096;
constexpr int M = BATCH * SEQ;
constexpr int DIN = 2824;
constexpr int ZP = 3072;
constexpr int ZC_RW_R = 0, ZC_RW_K = 256, ZC_RW_V = 512, ZC_RW_DW = 768;
constexpr int ZC_GD_Q = 1024, ZC_GD_K = 1280, ZC_GD_V = 1536, ZC_GD_G = 1792;
constexpr int ZC_AT_Q = 2048, ZC_AT_K = 2560, ZC_AT_V = 2688;
constexpr int ZC_GD_B = 2816, ZC_GD_A = 2820;
__host__ __device__ __forceinline__ int win_src_col(int n) {
    if (n < 2048) return n;
    if (n < 2816) return n + 8;
    if (n < 2824) return n - 2816 + 2048;
    return -1;
}
constexpr size_t MiB = 1u << 20;
constexpr size_t WS_CTL = 0, CTL_ZERO_BYTES = 1 * MiB;
constexpr size_t WS_WIN = 1 * MiB;
constexpr size_t WS_WOUT = WS_WIN + (size_t)DEPTH * ZP * DM * 2;
constexpr size_t WS_W1 = WS_WOUT + (size_t)DEPTH * DM * DM * 2;
constexpr size_t WS_W2 = WS_W1 + (size_t)DEPTH * DFF * DM * 2;
constexpr size_t WS_XN = WS_W2 + (size_t)DEPTH * DM * DFF * 2;
constexpr size_t WS_Z = WS_XN + (size_t)M * DM * 2;
constexpr size_t WS_Y = WS_Z + (size_t)M * ZP * 2;
constexpr size_t WS_H = WS_Z;
constexpr size_t WS_HB = WS_Y + (size_t)M * DM * 2;
constexpr size_t WS_RSS = WS_HB + (size_t)256 * 8 * 24576;
constexpr size_t WS_XS = WS_RSS + (size_t)2 * DEPTH * M * 16 * 4;
constexpr size_t WS_END = WS_XS + (size_t)128 * 16384;
static_assert(WS_H + (size_t)M * DFF * 2 <= WS_HB, "H overlay");
static_assert(WS_END <= 512 * MiB, "d_ws map");
constexpr int CW_TMO = 8192, CW_SEQ = 16384;
constexpr int CW_BAR = 4096;
constexpr int RING_OFF = 0, RING_BYTES = 131072;
constexpr int LDSCTL_OFF = 158720, MISC_OFF = LDSCTL_OFF + 320;
constexpr int BIAS_OFF = LDSCTL_OFF + 1024;
constexpr int LDS_BYTES = 163840;
static_assert(BIAS_OFF + 4096 <= LDS_BYTES, "LDS map");

#define GAS __attribute__((address_space(1)))
#define LAS __attribute__((address_space(3)))
typedef unsigned short bf16;
typedef unsigned v4u __attribute__((ext_vector_type(4)));
typedef unsigned v2u __attribute__((ext_vector_type(2)));
typedef float f32x4 __attribute__((ext_vector_type(4)));
typedef GAS unsigned gu32;
#define RLX_AGENT __ATOMIC_RELAXED, __HIP_MEMORY_SCOPE_AGENT
#define LDS_WAIT() asm volatile("s_waitcnt lgkmcnt(0)" ::: "memory")
#define VM_WAIT() asm volatile("s_waitcnt vmcnt(0)" ::: "memory")
__device__ __forceinline__ int hw_lane() { return hwl_(); }
__device__ __forceinline__ unsigned f2bf(float f) { unsigned u = __builtin_bit_cast(unsigned, f); return (u + 0x7fffu + ((u >> 16) & 1u)) >> 16; }
__device__ __forceinline__ unsigned pk2(float lo, float hi) { return f2bf(lo) | (f2bf(hi) << 16); }
__device__ __forceinline__ float bf2f(unsigned short h) { return __builtin_bit_cast(float, (unsigned)h << 16); }
__device__ __forceinline__ float bflo(unsigned u) { return __builtin_bit_cast(float, u << 16); }
__device__ __forceinline__ float bfhi(unsigned u) { return __builtin_bit_cast(float, u & 0xffff0000u); }
__device__ __forceinline__ float sigmoidf_(float x) { return 1.f / (1.f + __expf(-x)); }
__device__ __forceinline__ float softplusf_(float x) { return fmaxf(x, 0.f) + log1pf(__expf(-fabsf(x))); }
__device__ __forceinline__ float dppf(float v, const int ctrl_sel) {
    int r;
    const int s = __builtin_bit_cast(int, v);
    if (ctrl_sel == 0) r = __builtin_amdgcn_update_dpp(0, s, 0xB1, 0xF, 0xF, true);
    else if (ctrl_sel == 1) r = __builtin_amdgcn_update_dpp(0, s, 0x4E, 0xF, 0xF, true);
    else if (ctrl_sel == 2) r = __builtin_amdgcn_update_dpp(0, s, 0x141, 0xF, 0xF, true);
    else r = __builtin_amdgcn_update_dpp(0, s, 0x140, 0xF, 0xF, true);
    return __builtin_bit_cast(float, r);
}
__device__ __forceinline__ float wave_allsum(float v) {
    v += dppf(v, 0); v += dppf(v, 1); v += dppf(v, 2); v += dppf(v, 3);
    const float a = __builtin_bit_cast(float, __builtin_amdgcn_readlane(__builtin_bit_cast(int, v), 0));
    const float b = __builtin_bit_cast(float, __builtin_amdgcn_readlane(__builtin_bit_cast(int, v), 16));
    const float c = __builtin_bit_cast(float, __builtin_amdgcn_readlane(__builtin_bit_cast(int, v), 32));
    const float d = __builtin_bit_cast(float, __builtin_amdgcn_readlane(__builtin_bit_cast(int, v), 48));
    return (a + b) + (c + d);
}
#define XB_TMO      128
#define XB_XCNT(j)  (256  + 64 * (j))
#define XB_XSUB(j)  (1280 + 64 * (j))
#define XB_XGEN(j)  (2304 + 64 * (j))
#define XB_TOP      3328
#define XB_TOPGEN   3392
#define XCD_BAR_WORDS 3456
#define XB_SPIN_CAP (1u << 18)

__device__ __forceinline__ unsigned xb_ld(unsigned* p)              { return __hip_atomic_load((GAS unsigned*)p, __ATOMIC_RELAXED, __HIP_MEMORY_SCOPE_AGENT); }
__device__ __forceinline__ unsigned xb_add(unsigned* p, unsigned v) { return __hip_atomic_fetch_add((GAS unsigned*)p, v, __ATOMIC_RELAXED, __HIP_MEMORY_SCOPE_AGENT); }
__device__ __forceinline__ unsigned xb_xcc_id() { return (unsigned)__builtin_amdgcn_s_getreg((3 << 11) | 20) & 0xFu; }
#define XB_SPIN(cond, bar) do { unsigned _sp = 0; while (cond) { __builtin_amdgcn_s_sleep(1); \
    if ((++_sp & 255u) == 0u) { if (xb_ld(&(bar)[XB_TMO])) break; if (_sp > XB_SPIN_CAP) { atomicAdd(&(bar)[XB_TMO], 1u); break; } } } } while (0)

struct XcdBarrier {
    unsigned* bar; unsigned x;
    volatile LAS unsigned* st;
};

__device__ __forceinline__ XcdBarrier xcd_barrier_post(unsigned* bar, volatile LAS unsigned* st, const bool t0  ) {
    XcdBarrier b; b.bar = bar; b.x = xb_xcc_id(); b.st = st;
    if (t0) (void)xb_add(&bar[XB_XCNT(b.x)], 1u);
    return b;
}
__device__ __forceinline__ void xcd_barrier_complete(unsigned* bar, unsigned x, unsigned& nloc, unsigned& nx) {
    const unsigned G = gridDim.x * gridDim.y * gridDim.z;
    unsigned sum, cnt, mine, sp = 0u;
    for (;;) {
        sum = 0u; cnt = 0u; mine = 0u;
#pragma unroll
        for (unsigned j = 0; j < 16; ++j) { const unsigned c = xb_ld(&bar[XB_XCNT(j)]); sum += c; cnt += (c > 0u) ? 1u : 0u; mine = (j == x) ? c : mine; }
        if (sum == G) break;
        __builtin_amdgcn_s_sleep(1);
        if ((++sp & 255u) == 0u) { if (xb_ld(&bar[XB_TMO])) break; if (sp > XB_SPIN_CAP) { atomicAdd(&bar[XB_TMO], 1u); break; } }
    }
    nloc = mine > 0u ? mine : 1u; nx = cnt > 0u ? cnt : 1u;
}

__device__ __forceinline__ void xcd_barrier(const XcdBarrier& b, const bool t0  ) {
    asm volatile("s_waitcnt vmcnt(0)" ::: "memory");
    __syncthreads();
    if (t0) {
        unsigned* bar = b.bar;
        __builtin_amdgcn_s_waitcnt(0);
        unsigned nloc = b.st[0], nx = b.st[1];
        if (nloc == 0u) { xcd_barrier_complete(bar, b.x, nloc, nx); b.st[0] = nloc; b.st[1] = nx; }
        const unsigned old = xb_add(&bar[XB_XSUB(b.x)], 1u);
        const unsigned gen = old / nloc;
        if (old + 1u == (gen + 1u) * nloc) {
            __builtin_amdgcn_fence(__ATOMIC_RELEASE, "agent");
            asm volatile("s_waitcnt vmcnt(0)" ::: "memory");
            const unsigned og = xb_add(&bar[XB_TOP], 1u);
            const unsigned tg = og / nx;
            if (og + 1u == (tg + 1u) * nx) xb_add(&bar[XB_TOPGEN], 1u);
            else XB_SPIN(xb_ld(&bar[XB_TOPGEN]) == tg, bar);
            __builtin_amdgcn_fence(__ATOMIC_ACQUIRE, "agent");
            xb_add(&bar[XB_XGEN(b.x)], 1u);
            asm volatile("s_waitcnt vmcnt(0)" ::: "memory");
        } else {
            XB_SPIN(xb_ld(&bar[XB_XGEN(b.x)]) == gen, bar);
            __builtin_amdgcn_fence(__ATOMIC_ACQUIRE, "agent");
            asm volatile("s_waitcnt vmcnt(0)" ::: "memory");
        }
    }
    __syncthreads();
}
struct Frame {
    LAS unsigned char* lds;
    int wave;
    int vcu, G;
    unsigned char* ws;
    float* out;
};
typedef const float* cfp;
typedef const __attribute__((address_space(4))) cfp* karg_tab;
__device__ __forceinline__ karg_tab ktab() { karg_tab t = (karg_tab)__builtin_amdgcn_kernarg_segment_ptr(); asm volatile("" : "+s"(t)); return t; }
#define INP(i) (ktab()[i])
__device__ __forceinline__ int ltid() { return hw_lane(); }
__device__ __forceinline__ unsigned char* lnd(unsigned char* p) { asm volatile("" : "+s"(p)); return p; }
#define WSP(off) (lnd(F.ws) + (off))
#define FZ ((bf16*)WSP(WS_Z))
#define FY ((bf16*)WSP(WS_Y))
#define FXN ((bf16*)WSP(WS_XN))
#define FH ((bf16*)WSP(WS_H))
enum { I_X = 0, I_LN1 = 1, I_WIN = 2, I_MU = 3, I_W0 = 4, I_WUP = 5, I_A0 = 6, I_AUP = 7, I_GUP = 8, I_KK = 9, I_KA = 10, I_RK = 11, I_LNXW = 12, I_LNXB = 13,
       I_CONV = 14, I_ALOG = 15, I_DTB = 16, I_GNW = 17, I_QNW = 18, I_KNW = 19, I_SINK = 20, I_RELB = 21, I_WOUT = 22, I_LN2 = 23, I_WFF1 = 24, I_WFF2 = 25 };

template <bool MAP>
__device__ __forceinline__ void p0_transpose_item(const float* W, int K, int Nsrc, int Ndst, bf16* WT, LAS float* scr, int item, int lane, const float* kscale = nullptr) {
    const int nblk = Ndst / 64, kb = item / nblk, nb = item % nblk, k0 = 64 * kb, n0 = 64 * nb;
    const int c4 = lane & 15, r = lane >> 4;
    const int nn = n0 + 4 * c4; const int src = MAP ? win_src_col(nn) : nn;
#pragma unroll 8
    for (int i = 0; i < 16; ++i) { const int kk = 4 * i + r;
        f32x4 v = {0.f, 0.f, 0.f, 0.f}; if (src >= 0) v = *(const GAS f32x4*)(W + (size_t)(k0 + kk) * Nsrc + src);
        const float sc = kscale ? kscale[k0 + kk] : 1.f;
        LAS float* d = scr + kk * 65 + 4 * c4; d[0] = v.x * sc; d[1] = v.y * sc; d[2] = v.z * sc; d[3] = v.w * sc; }
    LDS_WAIT(); asm volatile("" ::: "memory");
    const int c = lane & 7;
#pragma unroll
    for (int j = 0; j < 8; ++j) { const int n = (lane >> 3) + 8 * j; const LAS float* s = scr + (8 * c) * 65 + n;
        v4u o; o.x = pg8::cvt_pk_bf16(s[0 * 65], s[1 * 65]); o.y = pg8::cvt_pk_bf16(s[2 * 65], s[3 * 65]); o.z = pg8::cvt_pk_bf16(s[4 * 65], s[5 * 65]); o.w = pg8::cvt_pk_bf16(s[6 * 65], s[7 * 65]);
        const int nn_ = n0 + n, rb = nn_ & 127, v5 = rb & 31, R = (rb & ~31) + (((v5 >> 2) & 1) * 16 + ((v5 >> 3) << 2) + (v5 & 3));
        *(GAS v4u*)((GAS unsigned char*)WT + ((size_t)((nn_ >> 8) * (K / 64) + (k0 >> 6)) * 2 + ((nn_ >> 7) & 1)) * 16384 + pg8::lds_byte(R, 8 * c)) = o; }
    LDS_WAIT(); asm volatile("" ::: "memory");
}
__device__ __forceinline__ void cast_rows(Frame& F, const float* x, bf16* xn, float* rss) {
    const int lane = ltid() & 63;
    const int gw = F.vcu * NWAVES + F.wave, NGW = F.G * NWAVES;
    f32x4 nx[4];
    if (gw < M) { const GAS f32x4* xr = (const GAS f32x4*)(x + (size_t)gw * DM) + lane;
#pragma unroll
        for (int j = 0; j < 4; ++j) nx[j] = xr[64 * j]; }
    for (int m = gw; m < M; m += NGW) {
        f32x4 v[4]; float s = 0.f;
#pragma unroll
        for (int j = 0; j < 4; ++j) v[j] = nx[j];
        if (m + NGW < M) { const GAS f32x4* xr = (const GAS f32x4*)(x + (size_t)(m + NGW) * DM) + lane;
#pragma unroll
            for (int j = 0; j < 4; ++j) nx[j] = xr[64 * j]; }
#pragma unroll
        for (int j = 0; j < 4; ++j) s += (v[j].x * v[j].x + v[j].y * v[j].y) + (v[j].z * v[j].z + v[j].w * v[j].w);
        s = wave_allsum(s);
        if (lane < 16) rss[(size_t)m * 16 + lane] = (lane == 0) ? s : 0.f;
#pragma unroll
        for (int j = 0; j < 4; ++j) *(GAS unsigned long long*)((GAS unsigned char*)xn + pg8::tiled_byte(m, 4 * lane + 256 * j, DM / 64)) = (unsigned long long)pg8::cvt_pk_bf16(v[j].x, v[j].y) | ((unsigned long long)pg8::cvt_pk_bf16(v[j].z, v[j].w) << 32);
    }
}
__device__ __forceinline__ void p0_prologue(Frame& F) {
    const int lane_ = ltid() & 63;
    LAS float* scr = (LAS float*)(F.lds + RING_OFF + F.wave * 16640);
    const int gw = F.vcu * NWAVES + F.wave, NGW = F.G * NWAVES;
    constexpr int I_IN = (DM / 64) * (ZP / 64), I_O = (DM / 64) * (DM / 64), I_1 = (DM / 64) * (DFF / 64), I_2 = (DFF / 64) * (DM / 64);
    constexpr int PER_L = I_IN + I_O + I_1 + I_2, NITEMS = DEPTH * PER_L;
    for (int it = gw; it < NITEMS; it += NGW) {
        const int l = it / PER_L; int r = it % PER_L;
        if (r < I_IN) { p0_transpose_item<true>(INP(I_WIN) + (size_t)l * DM * DIN, DM, DIN, ZP, ((bf16*)WSP(WS_WIN)) + (size_t)l * ZP * DM, scr, r, lane_, INP(I_LN1) + (size_t)l * DM); continue; } r -= I_IN;
        if (r < I_O) { p0_transpose_item<false>(INP(I_WOUT) + (size_t)l * DM * DM, DM, DM, DM, ((bf16*)WSP(WS_WOUT)) + (size_t)l * DM * DM, scr, r, lane_); continue; } r -= I_O;
        if (r < I_1) { p0_transpose_item<false>(INP(I_WFF1) + (size_t)l * DM * DFF, DM, DFF, DFF, ((bf16*)WSP(WS_W1)) + (size_t)l * DFF * DM, scr, r, lane_, INP(I_LN2) + (size_t)l * DM); continue; } r -= I_1;
        p0_transpose_item<false>(INP(I_WFF2) + (size_t)l * DFF * DM, DFF, DM, DM, ((bf16*)WSP(WS_W2)) + (size_t)l * DM * DFF, scr, r, lane_);
    }
    cast_rows(F, INP(I_X), FXN, (float*)WSP(WS_RSS));
}

#define MX_DEV __device__ __forceinline__
#define MX_G __attribute__((address_space(1)))
#define MX_L __attribute__((address_space(3)))
#define MX_EXP(x) __expf(x)
#define MX_LOG1P(x) log1pf(x)
#define MXIN(i) ((const MX_G float*)INP(i))
#define MX_VMWAIT() asm volatile("s_waitcnt vmcnt(0)" ::: "memory")
#define MX_LDSWAIT() asm volatile("s_waitcnt lgkmcnt(0)" ::: "memory")
#define MX_SCHED() __builtin_amdgcn_sched_barrier(0)
#define MX_LAUNDER_S(p) asm volatile("" : "+s"(p))
#define MX_LAUNDER_V(p) asm volatile("" : "+v"(p))
#define MX_CONSUME(x) asm volatile("" :: "v"(x))
#define MX_FMAC(acc, a, b) asm("v_fmac_f32_e32 %0, %1, %2" : "+v"(acc) : "v"(a), "v"(b))
#define MX_RCP(x) __builtin_amdgcn_rcpf(x)
#define MX_RSQ(x) __builtin_amdgcn_rsqf(x)
#define MX_LOG(x) __logf(x)
typedef __bf16 mx_bf2_t __attribute__((ext_vector_type(2)));
typedef float mx_f2_t __attribute__((ext_vector_type(2)));
__device__ __forceinline__ unsigned mx_hwpk2(float lo, float hi) { mx_f2_t v = {lo, hi}; return __builtin_bit_cast(unsigned, __builtin_convertvector(v, mx_bf2_t)); }
#define MX_PK2(lo, hi) mx_hwpk2(lo, hi)
#define MX_UNIFORM(x) __builtin_amdgcn_readfirstlane(x)
#define MX_ROW_SHR(v, d) __builtin_bit_cast(float, __builtin_amdgcn_update_dpp(0, __builtin_bit_cast(int, (v)), 0x110 + (d), 0xF, 0xF, true))
#define MX_ROW_SHRU(v, d) ((unsigned)__builtin_amdgcn_update_dpp(0, (int)(v), 0x110 + (d), 0xF, 0xF, true))
#define MX_ROW_RORU(v, d) ((unsigned)__builtin_amdgcn_update_dpp(0, (int)(v), 0x120 + (d), 0xF, 0xF, true))
#define MX_ROW_LAST(v) __builtin_bit_cast(float, __builtin_amdgcn_update_dpp(0, __builtin_bit_cast(int, (v)), 0x15F, 0xF, 0xF, true))
#define MX_ROW_SHR(v, d) __builtin_bit_cast(float, __builtin_amdgcn_update_dpp(0, __builtin_bit_cast(int, (v)), 0x110 + (d), 0xF, 0xF, true))
#define MX_ROW_LAST(v) __builtin_bit_cast(float, __builtin_amdgcn_update_dpp(0, __builtin_bit_cast(int, (v)), 0x15F, 0xF, 0xF, true))
typedef unsigned mx_u2_t __attribute__((ext_vector_type(2)));
__device__ __forceinline__ float mx_hw_rowsum4(float v) {
    const mx_u2_t a = __builtin_amdgcn_permlane16_swap(__builtin_bit_cast(unsigned, v), __builtin_bit_cast(unsigned, v), false, false);
    const float s = __builtin_bit_cast(float, a.x) + __builtin_bit_cast(float, a.y);
    const mx_u2_t b = __builtin_amdgcn_permlane32_swap(__builtin_bit_cast(unsigned, s), __builtin_bit_cast(unsigned, s), false, false);
    return __builtin_bit_cast(float, b.x) + __builtin_bit_cast(float, b.y);
}
#define MX_ROWSUM4(v) mx_hw_rowsum4(v)
#define MX_FLAG_LOAD(p) __hip_atomic_load((p), __ATOMIC_RELAXED, __HIP_MEMORY_SCOPE_AGENT)
#define MX_FLAG_STORE(p, v) __hip_atomic_store((p), (v), __ATOMIC_RELAXED, __HIP_MEMORY_SCOPE_AGENT)
#define MX_FLAG_ADD(p, v) __hip_atomic_fetch_add((p), (v), __ATOMIC_RELAXED, __HIP_MEMORY_SCOPE_AGENT)
#define MX_SLEEP() __builtin_amdgcn_s_sleep(2)
#define MX_SC1_LOAD64(p) __hip_atomic_load((p), __ATOMIC_RELAXED, __HIP_MEMORY_SCOPE_AGENT)
#define MX_SC1_STORE64(p, v) __hip_atomic_store((p), (v), __ATOMIC_RELAXED, __HIP_MEMORY_SCOPE_AGENT)
__device__ __forceinline__ int mx_lane() { return ltid() & 63; }
__device__ __forceinline__ void mx_wgsync() { __syncthreads(); }
__device__ __forceinline__ float mx_shfl_xor(float v, int m) { return m == 16 ? xor16f(v) : xor32f(v); }
__device__ __forceinline__ float mx_shfl16l(float v, int src, int lane) { return __builtin_bit_cast(float, __builtin_amdgcn_ds_bpermute(((lane & 48) | src) << 2, __builtin_bit_cast(int, v))); }
typedef short mx_bf16x8_t __attribute__((ext_vector_type(8)));
typedef float mx_f32x4_t __attribute__((ext_vector_type(4)));
__device__ __forceinline__ mx_f32x4_t mx_mfma(mx_bf16x8_t a, mx_bf16x8_t b, mx_f32x4_t c) { return __builtin_amdgcn_mfma_f32_16x16x32_bf16(a, b, c, 0, 0, 0); }
typedef short mx_s16x4_t __attribute__((ext_vector_type(4)));
#define MX_MFMA16(a, b, c) __builtin_amdgcn_mfma_f32_16x16x16bf16_1k(__builtin_bit_cast(mx_s16x4_t, a), __builtin_bit_cast(mx_s16x4_t, b), c, 0, 0, 0)
typedef short mx_bf16x8 __attribute__((ext_vector_type(8)));
typedef float mx_f32x4 __attribute__((ext_vector_type(4)));
typedef unsigned mx_u32x4 __attribute__((ext_vector_type(4)));
typedef unsigned mx_u32x2 __attribute__((ext_vector_type(2)));

MX_DEV unsigned mx_bf(float f) { unsigned u = __builtin_bit_cast(unsigned, f); return (u + 0x7fffu + ((u >> 16) & 1u)) >> 16; }
MX_DEV unsigned mx_pk2(float lo, float hi) { return MX_PK2(lo, hi); }
MX_DEV float mx_lo(unsigned u) { return __builtin_bit_cast(float, u << 16); }
MX_DEV float mx_hi(unsigned u) { return __builtin_bit_cast(float, u & 0xffff0000u); }
MX_DEV mx_bf16x8 mx_frag8(const float* a, const float* b) {
    mx_u32x4 w; w.x = mx_pk2(a[0], a[1]); w.y = mx_pk2(a[2], a[3]); w.z = mx_pk2(b[0], b[1]); w.w = mx_pk2(b[2], b[3]); return __builtin_bit_cast(mx_bf16x8, w); }
MX_DEV mx_bf16x8 mx_frag8v(mx_f32x4 a, mx_f32x4 b) {
    mx_u32x4 w; w.x = mx_pk2(a.x, a.y); w.y = mx_pk2(a.z, a.w); w.z = mx_pk2(b.x, b.y); w.w = mx_pk2(b.z, b.w); return __builtin_bit_cast(mx_bf16x8, w); }
MX_DEV mx_u32x2 mx_frag4(mx_f32x4 a) { mx_u32x2 w; w.x = mx_pk2(a.x, a.y); w.y = mx_pk2(a.z, a.w); return w; }
MX_DEV mx_f32x4 mx_mfma(mx_u32x2 a, mx_u32x2 b, mx_f32x4 c) { return MX_MFMA16(a, b, c); }
typedef unsigned long long mx_u64x2 __attribute__((ext_vector_type(2)));
MX_DEV mx_u32x2 mx_frag4p(mx_u32x2 p) { return p; }
MX_DEV mx_u32x2 mx_pack4(mx_f32x4 a) { mx_u32x2 p; p.x = mx_pk2(a.x, a.y); p.y = mx_pk2(a.z, a.w); return p; }
MX_DEV mx_f32x4 mx_zero4() { mx_f32x4 z = {0.f, 0.f, 0.f, 0.f}; return z; }
MX_DEV float mx_sigmoid(float x) { return MX_RCP(1.f + MX_EXP(-x)); }
MX_DEV float mx_softplus(float x) { return fmaxf(x, 0.f) + MX_LOG(1.f + MX_EXP(-fabsf(x))); }
MX_DEV float mx_rowsum4(float v) { v += mx_shfl_xor(v, 16); v += mx_shfl_xor(v, 32); return v; }

constexpr int MX_HB_WA = 0, MX_HB_RT = 2048, MX_HB_ARB = 4096, MX_HB_ARK = 4608, MX_HB_BH = 5120, MX_HB_KH = 7168, MX_HB_VC = 9216, MX_HB_U0 = 11264, MX_HB_GAM = 13312, MX_HB_SLOT = 13568;
constexpr int MX_GB_GT = 0, MX_GB_EE = 2048, MX_GB_SLOT = 4096;
constexpr int MX_LDS_HB = 0, MX_LDS_WW = 108544, MX_LDS_WA = 117760, MX_LDS_WG = 126976, MX_LDS_PAR = 144384, MX_LDS_ST = 148480, MX_LDS_GAM = 152576  , MX_LDS_END = 156672, MX_RS64 = 144, MX_RS128 = 272;
constexpr int MX_P_MUR = 256, MX_P_MUK = 320, MX_P_MUV = 384, MX_P_W0 = 448, MX_P_A0 = 512, MX_P_KK = 576, MX_P_KA = 640, MX_P_RK = 704, MX_P_LNW = 768, MX_P_LNB = 832, MX_P_GNW = 768;

constexpr int MX_YS_PAR = 32768;
struct MxFin { bool on; int type; int wv  ; MX_G unsigned short* yb  ; int t0  , col0  ; const MX_G unsigned char* gbp; const MX_G unsigned char* ysp;
               const MX_G unsigned short* pf  ; int pfh; };
MX_DEV unsigned mx_zoff(int t, int col) { return (unsigned)(((t >> 4) * (ZP / 64) + (col >> 6)) * 1024 + ((col >> 5) & 1) * 512 + (t & 15) * 32 + (col & 31)); }
MX_DEV unsigned mx_yoff(int t, int col) { const int r = t & 127, c = col & 63, ob = (r & 15) * 64 + (c & 31) * 2;
    return (unsigned)((((t >> 8) * (DM / 64) + (col >> 6)) * 2 + ((t >> 7) & 1)) * 8192 + ((((r >> 4) * 2 + (c >> 5)) * 1024 + (ob ^ (((ob >> 9) & 1) << 5))) >> 1)); }
MX_DEV int mx_ch_off(int ct, int g);
MX_DEV void mx_finalize(const MxFin& f, int lane) {
    const int tk = lane & 15, g = lane >> 4;
#pragma unroll
    for (int cc = 0; cc < 2; ++cc) {
        const int c = 2 * f.wv + cc;
        mx_f32x4 y[4]; mx_u32x2 gt[4], ee[4];
#pragma unroll
        for (int q = 0; q < 4; ++q) {
            y[q] = *(const MX_G mx_f32x4*)(f.ysp + (unsigned)(((c * 4 + q) * 64 + lane) * 16));
            const MX_G unsigned char* sl = f.gbp + c * MX_GB_SLOT;
            if ((q & 1) == 0) { const mx_u32x4 g4 = *(const MX_G mx_u32x4*)(sl + (unsigned)(MX_GB_GT + (q >> 1) * 1024 + lane * 16)), e4 = f.type == 0 ? *(const MX_G mx_u32x4*)(sl + (unsigned)(MX_GB_EE + (q >> 1) * 1024 + lane * 16)) : mx_u32x4{0u, 0u, 0u, 0u};
                gt[q].x = g4.x; gt[q].y = g4.y; gt[q + 1].x = g4.z; gt[q + 1].y = g4.w; ee[q].x = e4.x; ee[q].y = e4.y; ee[q + 1].x = e4.z; ee[q + 1].y = e4.w; } }
        float s1 = 0.f, s2 = 0.f;
#pragma unroll
        for (int q = 0; q < 4; ++q) { s1 += (y[q].x + y[q].y) + (y[q].z + y[q].w); s2 += (y[q].x * y[q].x + y[q].y * y[q].y) + (y[q].z * y[q].z + y[q].w * y[q].w); }
        s1 = mx_rowsum4(s1); s2 = mx_rowsum4(s2);
        float mean, rstd;
        if (f.type == 0) { mean = s1 * (1.f / 64.f); const float var = fmaxf(s2 * (1.f / 64.f) - mean * mean, 0.f); rstd = MX_RSQ(var + 64e-5f); }
        else { mean = 0.f; rstd = MX_RSQ(s2 * (1.f / 64.f) + 1e-6f); }
        mx_u32x2 ov[4];
#pragma unroll
        for (int q = 0; q < 4; ++q) {
            const float o0 = (y[q].x - mean) * rstd * mx_lo(gt[q].x) + mx_lo(ee[q].x), o1 = (y[q].y - mean) * rstd * mx_hi(gt[q].x) + mx_hi(ee[q].x);
            const float o2 = (y[q].z - mean) * rstd * mx_lo(gt[q].y) + mx_lo(ee[q].y), o3 = (y[q].w - mean) * rstd * mx_hi(gt[q].y) + mx_hi(ee[q].y);
            ov[q].x = mx_pk2(o0, o1); ov[q].y = mx_pk2(o2, o3);
        }
#pragma unroll
        for (int qp = 0; qp < 2; ++qp) {
            mx_u32x4 o; o.x = ov[2 * qp].x; o.y = ov[2 * qp].y; o.z = ov[2 * qp + 1].x; o.w = ov[2 * qp + 1].y;
            *(MX_G mx_u32x4*)(f.yb + mx_yoff(f.t0 + 16 * c + tk, f.col0 + mx_ch_off(2 * qp, g))) = o;
        }
    }
}
MX_DEV void mx_prep_back(float (&lw)[16], float (&a)[16], float (&b)[16], float (&k2)[16], float (&r)[16], float (&v)[16], MX_L unsigned char* slot, MX_L unsigned char* gamp  , bool midbar, const MxFin& fin, int lane) {
    const int tk = lane & 15, g = lane >> 4;
    float G[16];
#pragma unroll
    for (int i = 0; i < 16; ++i) G[i] = lw[i];
#pragma unroll
    for (int i = 0; i < 16; ++i) { G[i] += MX_ROW_SHR(G[i], 1); G[i] += MX_ROW_SHR(G[i], 2); G[i] += MX_ROW_SHR(G[i], 4); G[i] += MX_ROW_SHR(G[i], 8); }
    MX_SCHED();
    mx_bf16x8 AtF[2], BtF[2], KtF[2], RtF[2], BhF[2], KhF[2], VF[2];
    {
        float x[16];
#pragma unroll
        for (int i = 0; i < 16; ++i) { x[i] = a[i] * MX_EXP(G[i] - lw[i]); }
        AtF[0] = mx_frag8(x, x + 4); AtF[1] = mx_frag8(x + 8, x + 12);
    }
    MX_SCHED();
    {
        float x[16];
#pragma unroll
        for (int i = 0; i < 16; ++i) { x[i] = r[i] * MX_EXP(G[i]); }
        RtF[0] = mx_frag8(x, x + 4); RtF[1] = mx_frag8(x + 8, x + 12);
        VF[0] = mx_frag8(v, v + 4); VF[1] = mx_frag8(v + 8, v + 12);
    }
    MX_SCHED();
    {
        float x[16], y[16];
#pragma unroll
        for (int i = 0; i < 16; ++i) { const float e = MX_EXP(-G[i]); x[i] = b[i] * e; y[i] = k2[i] * e; }
        BtF[0] = mx_frag8(x, x + 4); BtF[1] = mx_frag8(x + 8, x + 12); KtF[0] = mx_frag8(y, y + 4); KtF[1] = mx_frag8(y + 8, y + 12);
    }
    MX_SCHED();
    {
        float x[16], y[16], gam[16];
#pragma unroll
        for (int i = 0; i < 16; ++i) { const float gc = MX_ROW_LAST(G[i]); const float e = MX_EXP(gc - G[i]); x[i] = b[i] * e; y[i] = k2[i] * e; gam[i] = MX_EXP(gc); }
        BhF[0] = mx_frag8(x, x + 4); BhF[1] = mx_frag8(x + 8, x + 12); KhF[0] = mx_frag8(y, y + 4); KhF[1] = mx_frag8(y + 8, y + 12);
        if (tk == 0) {
#pragma unroll
            for (int ct = 0; ct < 4; ++ct) { mx_f32x4 q = {gam[4 * ct], gam[4 * ct + 1], gam[4 * ct + 2], gam[4 * ct + 3]}; *(MX_L mx_f32x4*)(gamp + (unsigned)((16 * ct + 4 * g) * 4)) = q; } }
    }
    MX_SCHED();
    const mx_f32x4 z4 = mx_zero4();
    mx_f32x4 L = mx_mfma(BtF[1], AtF[1], mx_mfma(BtF[0], AtF[0], z4));
    mx_f32x4 LT = mx_mfma(AtF[1], BtF[1], mx_mfma(AtF[0], BtF[0], z4));
    mx_f32x4 Lak = mx_mfma(KtF[1], AtF[1], mx_mfma(KtF[0], AtF[0], z4));
    mx_f32x4 Arb = mx_mfma(BtF[1], RtF[1], mx_mfma(BtF[0], RtF[0], z4));
    mx_f32x4 Ark = mx_mfma(KtF[1], RtF[1], mx_mfma(KtF[0], RtF[0], z4));
#pragma unroll
    for (int e = 0; e < 4; ++e) { const int s = 4 * g + e;
        L[e] = (s < tk) ? L[e] : 0.f; LT[e] = (s > tk) ? LT[e] : 0.f; Lak[e] = (s < tk) ? Lak[e] : 0.f; Arb[e] = (s <= tk) ? Arb[e] : 0.f; Ark[e] = (s <= tk) ? Ark[e] : 0.f; }
    unsigned pfv = 0u;
    if (midbar) { MX_LDSWAIT(); mx_wgsync(); if (fin.on) mx_finalize(fin, lane);
        if (fin.pf) {
            if (fin.type == 0) { pfv = *(const MX_G unsigned*)(fin.pf + ZC_RW_DW + 64 * g); if (g < 3) pfv ^= *(const MX_G unsigned*)(fin.pf + (g == 0 ? ZC_RW_R : (g == 1 ? ZC_RW_K : ZC_RW_V)) + 64 * fin.pfh); }
            else { pfv = *(const MX_G unsigned*)(fin.pf + (g == 0 ? ZC_GD_Q : (g == 1 ? ZC_GD_K : (g == 2 ? ZC_GD_V : ZC_GD_G))) + 64 * fin.pfh); if (g == 0) pfv ^= *(const MX_G unsigned*)(fin.pf + ZC_GD_B); } }
        MX_SCHED(); }
    *(MX_L mx_bf16x8*)(slot + (unsigned)(MX_HB_RT + lane * 16)) = RtF[0]; *(MX_L mx_bf16x8*)(slot + (unsigned)(MX_HB_RT + 1024 + lane * 16)) = RtF[1];
    *(MX_L mx_u32x2*)(slot + (unsigned)(MX_HB_ARB + lane * 8)) = mx_pack4(Arb); *(MX_L mx_u32x2*)(slot + (unsigned)(MX_HB_ARK + lane * 8)) = mx_pack4(Ark);
    mx_f32x4 T = L;
#pragma unroll
    for (int e = 0; e < 4; ++e) T[e] += (4 * g + e == tk) ? 1.f : 0.f;
    {
        const mx_u32x2 fL = mx_frag4(L), fLT = mx_frag4(LT);
        const mx_f32x4 L2 = mx_mfma(fLT, fL, z4), L2T = mx_mfma(fL, fLT, z4);
        const mx_u32x2 fL2 = mx_frag4(L2), fL2T = mx_frag4(L2T);
        T = mx_mfma(fL2T, mx_frag4(T), T);
        const mx_f32x4 L4 = mx_mfma(fL2T, fL2, z4), L4T = mx_mfma(fL2, fL2T, z4);
        const mx_u32x2 fL4 = mx_frag4(L4), fL4T = mx_frag4(L4T);
        T = mx_mfma(fL4T, mx_frag4(T), T);
        const mx_f32x4 L8T = mx_mfma(fL4, fL4T, z4);
        T = mx_mfma(mx_frag4(L8T), mx_frag4(T), T);
    }
    const mx_u32x2 fT = mx_frag4(T), fLak = mx_frag4(Lak);
    mx_bf16x8 Sel[2];
#pragma unroll
    for (int p = 0; p < 2; ++p) { mx_u32x4 w = {0u, 0u, 0u, 0u};
        if ((tk >> 2) == g) { const unsigned one = (tk & 1) ? 0x3F800000u : 0x00003F80u; const int q = 2 * p + ((tk & 3) >> 1); w.x = (q == 0) ? one : 0u; w.y = (q == 1) ? one : 0u; w.z = (q == 2) ? one : 0u; w.w = (q == 3) ? one : 0u; }
        Sel[p] = __builtin_bit_cast(mx_bf16x8, w); }
#pragma unroll
    for (int ks = 0; ks < 2; ++ks) {
        mx_f32x4 w0 = mx_mfma(mx_frag4(mx_mfma(AtF[ks], Sel[0], z4)), fT, z4);
        mx_f32x4 w1 = mx_mfma(mx_frag4(mx_mfma(AtF[ks], Sel[1], z4)), fT, z4);
        *(MX_L mx_bf16x8*)(slot + (unsigned)(MX_HB_WA + ks * 1024 + lane * 16)) = mx_frag8v(w0, w1);
    }
#pragma unroll
    for (int ct = 0; ct < 4; ++ct) {
        const mx_f32x4 vc = mx_mfma(VF[ct >> 1], Sel[ct & 1], z4);
        const mx_u32x2 vp = mx_pack4(vc);
        *(MX_L mx_u32x2*)(slot + (unsigned)(MX_HB_VC + ct * 512 + lane * 8)) = vp;
        const mx_f32x4 X = mx_mfma(fLak, mx_frag4p(vp), z4);
        const mx_f32x4 U0 = mx_mfma(fT, mx_frag4(X), z4);
        *(MX_L mx_u32x2*)(slot + (unsigned)(MX_HB_U0 + ct * 512 + lane * 8)) = mx_pack4(U0);
        *(MX_L mx_u32x2*)(slot + (unsigned)(MX_HB_BH + ct * 512 + lane * 8)) = mx_pack4(mx_mfma(BhF[ct >> 1], Sel[ct & 1], z4));
        *(MX_L mx_u32x2*)(slot + (unsigned)(MX_HB_KH + ct * 512 + lane * 8)) = mx_pack4(mx_mfma(KhF[ct >> 1], Sel[ct & 1], z4));
    }
    MX_CONSUME(pfv);
}
MX_DEV int mx_ch_off(int ct, int g);
MX_DEV void mx_load_t16(const MX_G unsigned short* p, bool ok, int g, float (&x)[16]) {
#pragma unroll
    for (int ct = 0; ct < 4; ++ct) { mx_u32x2 w = {0u, 0u}; if (ok) w = *(const MX_G mx_u32x2*)(p + mx_ch_off(ct, g));
        x[4 * ct] = mx_lo(w.x); x[4 * ct + 1] = mx_hi(w.x); x[4 * ct + 2] = mx_lo(w.y); x[4 * ct + 3] = mx_hi(w.y); }
}
MX_DEV void mx_load_par(const MX_G float* p, int g, float (&x)[16]) {
#pragma unroll
    for (int ct = 0; ct < 4; ++ct) { const mx_f32x4 w = *(const MX_G mx_f32x4*)(p + mx_ch_off(ct, g)); x[4 * ct] = w.x; x[4 * ct + 1] = w.y; x[4 * ct + 2] = w.z; x[4 * ct + 3] = w.w; }
}
MX_DEV void mx_store_t16(MX_G unsigned char* p, int lane, const float (&x)[16]) {
#pragma unroll
    for (int cp = 0; cp < 2; ++cp) { mx_u32x4 w; w.x = mx_pk2(x[8 * cp], x[8 * cp + 1]); w.y = mx_pk2(x[8 * cp + 2], x[8 * cp + 3]); w.z = mx_pk2(x[8 * cp + 4], x[8 * cp + 5]); w.w = mx_pk2(x[8 * cp + 6], x[8 * cp + 7]); *(MX_G mx_u32x4*)(p + cp * 1024 + lane * 16) = w; }
}

MX_DEV int mx_ch_off(int ct, int g) { return 32 * (ct >> 1) + 8 * g + 4 * (ct & 1); }
MX_DEV int mx_slot_of_ch(int ch) { return 16 * (2 * (ch >> 5) + ((ch >> 2) & 1)) + 4 * ((ch >> 3) & 3) + (ch & 3); }
MX_DEV void mx_load_parL(const MX_L float* p, int g, float (&x)[16]) {
#pragma unroll
    for (int ct = 0; ct < 4; ++ct) { const mx_f32x4 w = *(const MX_L mx_f32x4*)(p + mx_ch_off(ct, g)); x[4 * ct] = w.x; x[4 * ct + 1] = w.y; x[4 * ct + 2] = w.z; x[4 * ct + 3] = w.w; }
}
struct MxRaw16 { mx_u32x2 w[4]; };
MX_DEV MxRaw16 mx_raw_t16(const MX_G unsigned short* zseq, int t, int col, bool ok, int g) { MxRaw16 r;
    mx_u32x4 a = {0u, 0u, 0u, 0u}, b = {0u, 0u, 0u, 0u};
    if (ok) { a = *(const MX_G mx_u32x4*)(zseq + mx_zoff(t, col + 8 * g)); b = *(const MX_G mx_u32x4*)(zseq + mx_zoff(t, col + 32 + 8 * g)); }
    r.w[0].x = a.x; r.w[0].y = a.y; r.w[1].x = a.z; r.w[1].y = a.w; r.w[2].x = b.x; r.w[2].y = b.y; r.w[3].x = b.z; r.w[3].y = b.w;
    return r; }
MX_DEV void mx_unpack16(const MxRaw16& r, float (&x)[16]) {
#pragma unroll
    for (int ct = 0; ct < 4; ++ct) { x[4 * ct] = mx_lo(r.w[ct].x); x[4 * ct + 1] = mx_hi(r.w[ct].x); x[4 * ct + 2] = mx_lo(r.w[ct].y); x[4 * ct + 3] = mx_hi(r.w[ct].y); }
}
MX_DEV unsigned mx_shr_u(unsigned v, int d) { return d == 1 ? MX_ROW_SHRU(v, 1) : (d == 2 ? MX_ROW_SHRU(v, 2) : MX_ROW_SHRU(v, 3)); }
MX_DEV unsigned mx_ror8(unsigned v, int d) { return d == 1 ? MX_ROW_RORU(v, 1) : d == 2 ? MX_ROW_RORU(v, 2) : d == 3 ? MX_ROW_RORU(v, 3) : d == 4 ? MX_ROW_RORU(v, 4) : d == 5 ? MX_ROW_RORU(v, 5) : d == 6 ? MX_ROW_RORU(v, 6) : d == 7 ? MX_ROW_RORU(v, 7) : MX_ROW_RORU(v, 8); }
MX_DEV unsigned mx_ror_u(unsigned v, int d) { return d == 1 ? MX_ROW_RORU(v, 1) : (d == 2 ? MX_ROW_RORU(v, 2) : MX_ROW_RORU(v, 3)); }
MX_DEV MxRaw16 mx_raw_tail(const MX_G unsigned short* zseq, int col, int t0, int tk, int g) {
    return mx_raw_t16(zseq, t0 - 16 + tk, col, tk >= 13 && t0 - 16 + tk >= 0, g); }
MX_DEV MxRaw16 mx_raw_prev(const MxRaw16& cur, const MxRaw16& tail, int tk, int d) {
    MxRaw16 r;
#pragma unroll
    for (int ct = 0; ct < 4; ++ct) {
        const unsigned sx = mx_shr_u(cur.w[ct].x, d), sy = mx_shr_u(cur.w[ct].y, d), tx = mx_ror_u(tail.w[ct].x, d), ty = mx_ror_u(tail.w[ct].y, d);
        r.w[ct].x = (tk >= d) ? sx : tx; r.w[ct].y = (tk >= d) ? sy : ty; }
    return r;
}
MX_DEV MxRaw16 mx_raw_prev1(const MxRaw16& cur, const MxRaw16& tail, int tk, int rot) {
    MxRaw16 r;
#pragma unroll
    for (int ct = 0; ct < 4; ++ct) {
        const unsigned sx = MX_ROW_SHRU(cur.w[ct].x, 1), sy = MX_ROW_SHRU(cur.w[ct].y, 1), tx = mx_ror8(tail.w[ct].x, rot), ty = mx_ror8(tail.w[ct].y, rot);
        r.w[ct].x = (tk >= 1) ? sx : tx; r.w[ct].y = (tk >= 1) ? sy : ty; }
    return r;
}
MX_DEV void mx_prep_rwkv(int l, int h, const MX_G unsigned short* zseq  , int chunk, MX_L unsigned char* slot, MX_G unsigned char* gslot, MX_L unsigned char* gamp, bool midbar, const MxFin& fin, const MX_L unsigned char* lds, int lane) {
    const int tk = lane & 15, g = lane >> 4, t = 16 * chunk + tk;
    const MX_L float* par = (const MX_L float*)(lds + MX_LDS_PAR);
    const mx_f32x4 z4 = mx_zero4();
    mx_u32x4 cwv[8];
    const int tlast = 16 * chunk - 1;
    mx_u32x4 pwi = {0u, 0u, 0u, 0u}; if (tk >= 8 && chunk > 0) pwi = *(const MX_G mx_u32x4*)(zseq + mx_zoff(tlast, ZC_RW_DW + 32 * (tk - 8) + 8 * g));
#pragma unroll
    for (int ks = 0; ks < 8; ++ks) { const int col = ZC_RW_DW + 32 * ks + 8 * g; cwv[ks] = *(const MX_G mx_u32x4*)(zseq + mx_zoff(t, col)); }
    MxRaw16 kc, rc, vc_, tl;
    MX_SCHED();
    mx_f32x4 accw[4], acca[4], accg[4];
#pragma unroll
    for (int ct = 0; ct < 4; ++ct) { accw[ct] = z4; acca[ct] = z4; accg[ct] = z4; }
#pragma unroll
    for (int ks = 0; ks < 8; ++ks) {
        const mx_u32x4 cw = cwv[ks]; mx_u32x4 pw = pwi;
        { const unsigned sx = MX_ROW_SHRU(cw.x, 1), sy = MX_ROW_SHRU(cw.y, 1), sz = MX_ROW_SHRU(cw.z, 1), sw = MX_ROW_SHRU(cw.w, 1), tx = mx_ror8(pw.x, 8 - ks), ty = mx_ror8(pw.y, 8 - ks), tz = mx_ror8(pw.z, 8 - ks), tw = mx_ror8(pw.w, 8 - ks);
          pw.x = tk ? sx : tx; pw.y = tk ? sy : ty; pw.z = tk ? sz : tz; pw.w = tk ? sw : tw; }
        const mx_f32x4 m0 = *(const MX_L mx_f32x4*)(par + 32 * ks + 8 * g), m1 = *(const MX_L mx_f32x4*)(par + 32 * ks + 8 * g + 4);
        float x[8];
        x[0] = mx_lo(cw.x) + (mx_lo(pw.x) - mx_lo(cw.x)) * m0.x; x[1] = mx_hi(cw.x) + (mx_hi(pw.x) - mx_hi(cw.x)) * m0.y; x[2] = mx_lo(cw.y) + (mx_lo(pw.y) - mx_lo(cw.y)) * m0.z; x[3] = mx_hi(cw.y) + (mx_hi(pw.y) - mx_hi(cw.y)) * m0.w;
        x[4] = mx_lo(cw.z) + (mx_lo(pw.z) - mx_lo(cw.z)) * m1.x; x[5] = mx_hi(cw.z) + (mx_hi(pw.z) - mx_hi(cw.z)) * m1.y; x[6] = mx_lo(cw.w) + (mx_lo(pw.w) - mx_lo(cw.w)) * m1.z; x[7] = mx_hi(cw.w) + (mx_hi(pw.w) - mx_hi(cw.w)) * m1.w;
#pragma unroll
        for (int e = 0; e < 8; ++e) { if (ks < 2) x[e] = 2.f * MX_RCP(1.f + MX_EXP(-2.f * x[e])) - 1.f; else if (ks >= 4) x[e] = mx_sigmoid(x[e]); }
        const mx_bf16x8 bf = mx_frag8(x, x + 4);
#pragma unroll
        for (int ct = 0; ct < 4; ++ct) {
            if (ks < 2) accw[ct] = mx_mfma(*(const MX_L mx_bf16x8*)(lds + MX_LDS_WW + (16 * ct + tk) * MX_RS64 + (32 * ks + 8 * g) * 2), bf, accw[ct]);
            else if (ks < 4) acca[ct] = mx_mfma(*(const MX_L mx_bf16x8*)(lds + MX_LDS_WA + (16 * ct + tk) * MX_RS64 + (32 * (ks - 2) + 8 * g) * 2), bf, acca[ct]);
            else accg[ct] = mx_mfma(*(const MX_L mx_bf16x8*)(lds + MX_LDS_WG + (16 * ct + tk) * MX_RS128 + (32 * (ks - 4) + 8 * g) * 2), bf, accg[ct]);
        }
        if (ks == 0) { kc = mx_raw_t16(zseq, t, ZC_RW_K + 64 * h, true, g); tl = mx_raw_t16(zseq, tlast, (tk == 13 ? ZC_RW_R : (tk == 14 ? ZC_RW_K : ZC_RW_V)) + 64 * h, tk >= 13 && chunk > 0, g); }
        if (ks == 1) rc = mx_raw_t16(zseq, t, ZC_RW_R + 64 * h, true, g);
        if (ks == 2) vc_ = mx_raw_t16(zseq, t, ZC_RW_V + 64 * h, true, g);
        MX_SCHED();
    }
    float lw[16], a[16], b[16], k2[16], r[16], v[16];
    {
        float zc[16], zp[16], pr[16];
        mx_load_parL(par + MX_P_A0, g, pr);
#pragma unroll
        for (int i = 0; i < 16; ++i) b[i] = mx_sigmoid(pr[i] + acca[i >> 2][i & 3]);
        mx_unpack16(kc, zc); mx_unpack16(mx_raw_prev1(kc, tl, tk, 2), zp); mx_load_parL(par + MX_P_MUK, g, pr);
#pragma unroll
        for (int i = 0; i < 16; ++i) k2[i] = zc[i] + (zp[i] - zc[i]) * pr[i];
        mx_load_parL(par + MX_P_KK, g, pr);
        float ss = 0.f;
#pragma unroll
        for (int i = 0; i < 16; ++i) { a[i] = k2[i] * pr[i]; ss += a[i] * a[i]; }
        ss = mx_rowsum4(ss);
        const float rn = MX_RSQ(ss + 1e-6f);
        mx_load_parL(par + MX_P_KA, g, pr);
#pragma unroll
        for (int i = 0; i < 16; ++i) { const float kk = a[i] * rn, ic = b[i]; b[i] = kk * ic; a[i] = -kk; k2[i] = k2[i] * (1.f + (ic - 1.f) * pr[i]); }
    }
    MX_SCHED();
    float bs = 0.f;
    {
        float zc[16], zp[16], pr[16];
        mx_unpack16(rc, zc); mx_unpack16(mx_raw_prev1(rc, tl, tk, 3), zp); mx_load_parL(par + MX_P_MUR, g, pr);
#pragma unroll
        for (int i = 0; i < 16; ++i) r[i] = zc[i] + (zp[i] - zc[i]) * pr[i];
        mx_load_parL(par + MX_P_RK, g, pr);
#pragma unroll
        for (int i = 0; i < 16; ++i) bs += r[i] * k2[i] * pr[i];
        bs = mx_rowsum4(bs);
    }
    MX_SCHED();
    {
        float zc[16], zp[16], pr[16];
        mx_unpack16(vc_, zc); mx_unpack16(mx_raw_prev1(vc_, tl, tk, 1), zp); mx_load_parL(par + MX_P_MUV, g, pr);
#pragma unroll
        for (int i = 0; i < 16; ++i) v[i] = zc[i] + (zp[i] - zc[i]) * pr[i];
        mx_load_parL(par + MX_P_LNW, g, pr);
#pragma unroll
        for (int i = 0; i < 16; ++i) zc[i] = accg[i >> 2][i & 3] * pr[i];
        mx_store_t16(gslot + MX_GB_GT, lane, zc);
        mx_load_parL(par + MX_P_LNB, g, pr);
#pragma unroll
        for (int i = 0; i < 16; ++i) zp[i] = (pr[i] + bs * v[i]) * accg[i >> 2][i & 3];
        mx_store_t16(gslot + MX_GB_EE, lane, zp);
    }
    MX_SCHED();
    {
        float pr[16];
        mx_load_parL(par + MX_P_W0, g, pr);
#pragma unroll
        for (int i = 0; i < 16; ++i) { const float u = pr[i] + accw[i >> 2][i & 3]; lw[i] = -0.60653065971263342f * mx_sigmoid(u); }
    }
    MX_SCHED();
    mx_prep_back(lw, a, b, k2, r, v, slot, gamp, midbar, fin, lane);
}
MX_DEV void mx_prep_gdn(int l, int h, const MX_G unsigned short* zseq, int chunk, MX_L unsigned char* slot, MX_G unsigned char* gslot, MX_L unsigned char* gamp, bool midbar, const MxFin& fin, const MX_L unsigned char* lds, int lane) {
    const int tk = lane & 15, g = lane >> 4, t = 16 * chunk + tk;
    const MX_L float* par = (const MX_L float*)(lds + MX_LDS_PAR);
    const MxRaw16 cq = mx_raw_t16(zseq, t, ZC_GD_Q + 64 * h, true, g), tq = mx_raw_tail(zseq, ZC_GD_Q + 64 * h, 16 * chunk, tk, g);
    const MxRaw16 ck = mx_raw_t16(zseq, t, ZC_GD_K + 64 * h, true, g), tk_ = mx_raw_tail(zseq, ZC_GD_K + 64 * h, 16 * chunk, tk, g);
    MX_SCHED();
    float q[16], k[16], v[16];
#pragma unroll
    for (int i = 0; i < 16; ++i) { q[i] = 0.f; k[i] = 0.f; v[i] = 0.f; }
#pragma unroll
    for (int d = 0; d < 4; ++d) {
        float x[16], w[16];
        if (d == 3) mx_unpack16(cq, x); else mx_unpack16(mx_raw_prev(cq, tq, tk, 3 - d), x);
        mx_load_parL(par + d * 192, g, w);
#pragma unroll
        for (int i = 0; i < 16; ++i) MX_FMAC(q[i], w[i], x[i]);
    }
    const MxRaw16 cv = mx_raw_t16(zseq, t, ZC_GD_V + 64 * h, true, g), tv = mx_raw_tail(zseq, ZC_GD_V + 64 * h, 16 * chunk, tk, g);
    const MxRaw16 rg = mx_raw_t16(zseq, t, ZC_GD_G + 64 * h, true, g);
    const float bl = mx_lo((unsigned)zseq[mx_zoff(t, ZC_GD_B + h)]), al = mx_lo((unsigned)zseq[mx_zoff(t, ZC_GD_A + h)]);
    MX_SCHED();
#pragma unroll
    for (int d = 0; d < 4; ++d) {
        float x[16], w[16];
        if (d == 3) mx_unpack16(ck, x); else mx_unpack16(mx_raw_prev(ck, tk_, tk, 3 - d), x);
        mx_load_parL(par + d * 192 + 64, g, w);
#pragma unroll
        for (int i = 0; i < 16; ++i) MX_FMAC(k[i], w[i], x[i]);
    }
    MX_SCHED();
#pragma unroll
    for (int d = 0; d < 4; ++d) {
        float x[16], w[16];
        if (d == 3) mx_unpack16(cv, x); else mx_unpack16(mx_raw_prev(cv, tv, tk, 3 - d), x);
        mx_load_parL(par + d * 192 + 128, g, w);
#pragma unroll
        for (int i = 0; i < 16; ++i) MX_FMAC(v[i], w[i], x[i]);
    }
    MX_SCHED();
    float sq = 0.f, sk = 0.f;
#pragma unroll
    for (int i = 0; i < 16; ++i) { q[i] = q[i] * mx_sigmoid(q[i]); k[i] = k[i] * mx_sigmoid(k[i]); v[i] = v[i] * mx_sigmoid(v[i]); sq += q[i] * q[i]; sk += k[i] * k[i]; }
    sq = mx_rowsum4(sq); sk = mx_rowsum4(sk);
    const float rqn = 0.125f * MX_RSQ(sq + 1e-6f), rkn = MX_RSQ(sk + 1e-6f);
    const float beta = mx_sigmoid(bl);
    const float gl = -MX_EXP(MXIN(I_ALOG)[l * 4 + h]) * mx_softplus(al + MXIN(I_DTB)[l * 4 + h]);
    const float wb = -MX_EXP(gl) * beta;
    float lw[16], a[16], b[16];
#pragma unroll
    for (int i = 0; i < 16; ++i) { const float kn = k[i] * rkn; lw[i] = gl; a[i] = kn; b[i] = wb * kn; k[i] = kn; q[i] = q[i] * rqn; v[i] = beta * v[i]; }
    {
        float zg[16], pr[16], ee[16];
        mx_unpack16(rg, zg); mx_load_parL(par + MX_P_GNW, g, pr);
#pragma unroll
        for (int i = 0; i < 16; ++i) { zg[i] = pr[i] * (zg[i] * mx_sigmoid(zg[i])); ee[i] = 0.f; }
        mx_store_t16(gslot + MX_GB_GT, lane, zg);
    }
    MX_SCHED();
    mx_prep_back(lw, a, b, k, q, v, slot, gamp, midbar, fin, lane);
}
struct MxOps { mx_bf16x8 wa0, wa1, rt0, rt1; mx_u32x2 arb, ark, vc; mx_f32x4 u0; mx_f32x4 gm0, gm1, gm2, gm3; mx_u32x2 bh0, bh1, bh2, bh3, kh0, kh1, kh2, kh3; };
MX_DEV MxOps mx_scan_load(const MX_L unsigned char* slot, const MX_L unsigned char* gamp, int it, int lane) {
    const int g = lane >> 4;
    MxOps o;
    o.wa0 = *(const MX_L mx_bf16x8*)(slot + (unsigned)(MX_HB_WA + lane * 16)); o.wa1 = *(const MX_L mx_bf16x8*)(slot + (unsigned)(MX_HB_WA + 1024 + lane * 16));
    o.rt0 = *(const MX_L mx_bf16x8*)(slot + (unsigned)(MX_HB_RT + lane * 16)); o.rt1 = *(const MX_L mx_bf16x8*)(slot + (unsigned)(MX_HB_RT + 1024 + lane * 16));
    o.arb = *(const MX_L mx_u32x2*)(slot + (unsigned)(MX_HB_ARB + lane * 8)); o.ark = *(const MX_L mx_u32x2*)(slot + (unsigned)(MX_HB_ARK + lane * 8));
    o.vc = *(const MX_L mx_u32x2*)(slot + (unsigned)(MX_HB_VC + it * 512 + lane * 8));
    { const mx_u32x2 u = *(const MX_L mx_u32x2*)(slot + (unsigned)(MX_HB_U0 + it * 512 + lane * 8)); o.u0.x = mx_lo(u.x); o.u0.y = mx_hi(u.x); o.u0.z = mx_lo(u.y); o.u0.w = mx_hi(u.y); }
#define MX_LDJ(jt) do { o.gm##jt = *(const MX_L mx_f32x4*)(gamp + (unsigned)((16 * jt + 4 * g) * 4)); \
        o.bh##jt = *(const MX_L mx_u32x2*)(slot + (unsigned)(MX_HB_BH + jt * 512 + lane * 8)); o.kh##jt = *(const MX_L mx_u32x2*)(slot + (unsigned)(MX_HB_KH + jt * 512 + lane * 8)); } while (0)
    MX_LDJ(0); MX_LDJ(1); MX_LDJ(2); MX_LDJ(3);
#undef MX_LDJ
    return o;
}
MX_DEV mx_f32x4 mx_scan_compute(mx_f32x4 (&S)[4], const MxOps& o, int lane) {
    const int tk = lane & 15, g = lane >> 4;
    const mx_f32x4 z4 = mx_zero4();
    const mx_bf16x8 sb0 = mx_frag8v(S[0], S[1]), sb1 = mx_frag8v(S[2], S[3]);
    const mx_f32x4 U = mx_mfma(o.wa1, sb1, mx_mfma(o.wa0, sb0, o.u0));
    const mx_u32x2 ub = mx_frag4(U), vb = mx_frag4p(o.vc);
    mx_f32x4 Y = mx_mfma(o.rt1, sb1, mx_mfma(o.rt0, sb0, z4));
    Y = mx_mfma(mx_frag4p(o.ark), vb, mx_mfma(mx_frag4p(o.arb), ub, Y));
    S[0] = mx_mfma(mx_frag4p(o.kh0), vb, mx_mfma(mx_frag4p(o.bh0), ub, S[0] * o.gm0)); S[1] = mx_mfma(mx_frag4p(o.kh1), vb, mx_mfma(mx_frag4p(o.bh1), ub, S[1] * o.gm1));
    S[2] = mx_mfma(mx_frag4p(o.kh2), vb, mx_mfma(mx_frag4p(o.bh2), ub, S[2] * o.gm2)); S[3] = mx_mfma(mx_frag4p(o.kh3), vb, mx_mfma(mx_frag4p(o.bh3), ub, S[3] * o.gm3));
    mx_u32x2 selI = {0u, 0u};
    if ((tk >> 2) == g) { const unsigned one = (tk & 1) ? 0x3F800000u : 0x00003F80u; if ((tk & 3) >> 1) selI.y = one; else selI.x = one; }
    mx_f32x4 Yh, Yl;
#pragma unroll
    for (int e = 0; e < 4; ++e) { Yh[e] = __builtin_bit_cast(float, mx_bf(Y[e]) << 16); Yl[e] = Y[e] - Yh[e]; }
    return mx_mfma(mx_frag4(Yl), selI, mx_mfma(mx_frag4(Yh), selI, z4));
}
MX_DEV void mx_sequence(int l, int type, int h, const MX_G unsigned short* zseq, MX_G unsigned short* yseq  , int nchunks, MX_G unsigned char* gb  , MX_L unsigned char* lds, int wave,
                        int role, MX_G unsigned long long* xs, MX_G unsigned* flag, MX_G unsigned* tmo, MX_G unsigned char* ys  ) {
    const int lane0 = mx_lane();
    {
        const int tid = wave * 64 + lane0;
        MX_L float* par = (MX_L float*)(lds + MX_LDS_PAR);
        if (type == 0) {
            const MX_G float* wup = MXIN(I_WUP) + l * 64 * 256 + 64 * h; const MX_G float* aup = MXIN(I_AUP) + l * 64 * 256 + 64 * h; const MX_G float* gup = MXIN(I_GUP) + l * 128 * 256 + 64 * h;
            {
                const int ch = tid & 63, k0 = tid >> 6, sl = mx_slot_of_ch(ch);
                float vw[8], va[8], vg[16];
#pragma unroll
                for (int i = 0; i < 8; ++i) { vw[i] = wup[(k0 + 8 * i) * 256 + ch]; va[i] = aup[(k0 + 8 * i) * 256 + ch]; }
#pragma unroll
                for (int i = 0; i < 16; ++i) vg[i] = gup[(k0 + 8 * i) * 256 + ch];
#pragma unroll
                for (int i = 0; i < 8; ++i) { *(MX_L unsigned short*)(lds + MX_LDS_WW + sl * MX_RS64 + (k0 + 8 * i) * 2) = (unsigned short)mx_bf(vw[i]); *(MX_L unsigned short*)(lds + MX_LDS_WA + sl * MX_RS64 + (k0 + 8 * i) * 2) = (unsigned short)mx_bf(va[i]); }
#pragma unroll
                for (int i = 0; i < 16; ++i) *(MX_L unsigned short*)(lds + MX_LDS_WG + sl * MX_RS128 + (k0 + 8 * i) * 2) = (unsigned short)mx_bf(vg[i]);
            }
            const MX_G float* mu = MXIN(I_MU) + l * 1024;
            if (tid < 256) par[tid] = mu[ZC_RW_DW + tid];
            else if (tid < 448) { const int a = (tid - 256) >> 6, c = (tid - 256) & 63; par[tid] = mu[(a == 0 ? ZC_RW_R : (a == 1 ? ZC_RW_K : ZC_RW_V)) + 64 * h + c]; }
            if (tid < 448) { const int a = tid >> 6, c = tid & 63;
                const MX_G float* src = a == 0 ? MXIN(I_W0) : a == 1 ? MXIN(I_A0) : a == 2 ? MXIN(I_KK) : a == 3 ? MXIN(I_KA) : a == 4 ? MXIN(I_RK) : a == 5 ? MXIN(I_LNXW) : MXIN(I_LNXB);
                par[MX_P_W0 + tid] = src[l * 256 + 64 * h + c]; }
        } else {
            const MX_G float* cw = MXIN(I_CONV) + l * 4 * 768;
            for (int idx = tid; idx < 768; idx += 512) { const int d = idx / 192, a = (idx % 192) >> 6, c = idx & 63; par[idx] = cw[d * 768 + a * 256 + 64 * h + c]; }
            if (tid < 64) par[MX_P_GNW + tid] = MXIN(I_GNW)[l * 64 + tid];
        }
    }
    mx_wgsync();
    mx_f32x4 S[4];
#pragma unroll
    for (int jt = 0; jt < 4; ++jt) S[jt] = mx_zero4();
    MX_L float* st = (MX_L float*)(lds + MX_LDS_ST);
    typedef float mx_f32x2 __attribute__((ext_vector_type(2)));
    const int ngroups = nchunks / 8;
    for (int itr = role - 2; itr < ngroups; itr += 2) {
        int lane = lane0; MX_LAUNDER_V(lane);
        const int tk = lane & 15, g = lane >> 4;
        const bool scan_now = itr >= 0, more = itr + 2 < ngroups;
        const int par_c = (itr >> 1) & 1, par_n = ((itr + 2) >> 1) & 1;
        if (wave < 4 && scan_now) {
            const MX_L unsigned char* gamc = lds + MX_LDS_GAM + par_c * 2048;
            MX_G unsigned char* ysc = ys + par_c * MX_YS_PAR; MX_LAUNDER_S(ysc);
            if (itr > 0) {
                const unsigned want = 4u * (unsigned)itr;
                for (unsigned spins = 0;;) {
                    if ((unsigned)MX_UNIFORM(MX_FLAG_LOAD(flag)) >= want) break;
                    MX_SLEEP();
                    if (++spins > (1u << 20)) { if (lane == 0) MX_FLAG_STORE(tmo, 1u); break; }
                }
#pragma unroll
                for (int jt = 0; jt < 4; ++jt) { const MX_G unsigned long long* p = xs + (unsigned)(((wave * 4 + jt) * 64 + lane) * 2);
                    const unsigned long long a = MX_SC1_LOAD64(p), b = MX_SC1_LOAD64(p + 1);
                    mx_u32x4 w; w.x = (unsigned)a; w.y = (unsigned)(a >> 32); w.z = (unsigned)b; w.w = (unsigned)(b >> 32); S[jt] = __builtin_bit_cast(mx_f32x4, w); }
            }
#pragma unroll
            for (int c = 0; c < 8; ++c) {
                const MxOps o = mx_scan_load(lds + MX_LDS_HB + c * MX_HB_SLOT, gamc + c * 256, wave, lane);
                const mx_f32x4 yk = mx_scan_compute(S, o, lane);
                *(MX_G mx_f32x4*)(ysc + (unsigned)(((c * 4 + wave) * 64 + lane) * 16)) = yk;
                MX_SCHED();
            }
            if (itr + 1 < ngroups) {
#pragma unroll
                for (int jt = 0; jt < 4; ++jt) { MX_G unsigned long long* p = xs + (unsigned)(((wave * 4 + jt) * 64 + lane) * 2);
                    const mx_u32x4 w = __builtin_bit_cast(mx_u32x4, S[jt]);
                    MX_SC1_STORE64(p, (unsigned long long)w.x | ((unsigned long long)w.y << 32)); MX_SC1_STORE64(p + 1, (unsigned long long)w.z | ((unsigned long long)w.w << 32)); }
            }
            MX_VMWAIT();
            if (itr + 1 < ngroups) { if (lane == 0) MX_FLAG_ADD(flag, 1u); }
            unsigned pfw = 0u;
            if (more) {
                const int pc = 8 * (itr + 2) + 4 + wave;
                const MX_G unsigned short* zb = zseq + (size_t)pc * (ZP / 64) * 1024 + (lane & 15) * 64;
                if (type == 0) { pfw = *(const MX_G unsigned*)(zb + (ZC_RW_DW / 64 + g) * 1024); if (g < 3) pfw ^= *(const MX_G unsigned*)(zb + ((g == 0 ? ZC_RW_R : (g == 1 ? ZC_RW_K : ZC_RW_V)) / 64 + h) * 1024); }
                else { pfw = *(const MX_G unsigned*)(zb + ((g == 0 ? ZC_GD_Q : (g == 1 ? ZC_GD_K : (g == 2 ? ZC_GD_V : ZC_GD_G))) / 64 + h) * 1024); if (lane < 8) pfw ^= *(const MX_G unsigned*)(zb + (ZC_GD_B / 64) * 1024); }
            }
            MX_LDSWAIT(); mx_wgsync();
            MX_CONSUME(pfw);
        } else if (wave < 4) { mx_wgsync(); }
        MX_SCHED();
        MxFin fin; fin.on = scan_now && wave >= 4; fin.type = type; fin.wv = wave - 4; fin.yb = yseq; fin.t0 = 16 * 8 * (itr < 0 ? 0 : itr); fin.col0 = type * 256 + 64 * h; fin.gbp = gb + par_c * (8 * MX_GB_SLOT); fin.ysp = ys + par_c * MX_YS_PAR;
        fin.pf = (const MX_G unsigned short*)nullptr; fin.pfh = h;
        if (more) {
            const int c = (wave < 4) ? wave + 4 : wave - 4;
            MX_G unsigned char* gbn = gb + par_n * (8 * MX_GB_SLOT) + c * MX_GB_SLOT; MX_LAUNDER_S(gbn);
            MX_L unsigned char* slot = lds + MX_LDS_HB + c * MX_HB_SLOT; MX_L unsigned char* gamn = lds + MX_LDS_GAM + par_n * 2048 + c * 256;
            if (type == 0) mx_prep_rwkv(l, h, zseq, 8 * (itr + 2) + c, slot, gbn, gamn, wave >= 4, fin, lds, lane); else mx_prep_gdn(l, h, zseq, 8 * (itr + 2) + c, slot, gbn, gamn, wave >= 4, fin, lds, lane);
        } else if (wave >= 4) { mx_wgsync(); if (fin.on) mx_finalize(fin, lane); }
        MX_VMWAIT(); MX_LDSWAIT(); mx_wgsync();
    }
}

MX_DEV void mx_attn_unit4(int kvh, int q0, const MX_G unsigned short* zseq  , MX_G unsigned short* yatt  ,
                          const MX_L float* btab_all  , float Mb, const float (&esink)[4]  , const float (&qkw)[16], MX_L unsigned char* vts  , int lane) {
    const int tk = lane & 15, g = lane >> 4;
    const mx_f32x4 z4 = mx_zero4();
    const MX_G unsigned short* qrow = zseq + mx_zoff(q0 + tk, ZC_AT_Q + 256 * kvh + 8 * g);
    mx_u32x4 qa = *(const MX_G mx_u32x4*)(qrow), qb = *(const MX_G mx_u32x4*)(qrow + 512);
    mx_u32x4 kA[9], kB[9], vA[9], vB[9];
#pragma unroll
    for (int kt = 0; kt < 9; ++kt) {
        const int key0 = q0 - 128 + 16 * kt;
        if (key0 >= 0) {
            const MX_G unsigned short* krow = zseq + mx_zoff(key0 + tk, ZC_AT_K + 64 * kvh + 8 * g); const MX_G unsigned short* vrow = zseq + mx_zoff(key0 + tk, ZC_AT_V + 64 * kvh + 8 * g);
            kA[kt] = *(const MX_G mx_u32x4*)(krow); kB[kt] = *(const MX_G mx_u32x4*)(krow + 512);
            vA[kt] = *(const MX_G mx_u32x4*)(vrow); vB[kt] = *(const MX_G mx_u32x4*)(vrow + 512);
        } else { const mx_u32x4 z_ = {0u, 0u, 0u, 0u}; kA[kt] = z_; kB[kt] = z_; vA[kt] = z_; vB[kt] = z_; }
    }
    MX_SCHED();
    mx_bf16x8 Sel[2];
#pragma unroll
    for (int p = 0; p < 2; ++p) { mx_u32x4 w = {0u, 0u, 0u, 0u};
        if ((tk >> 2) == g) { const unsigned one = (tk & 1) ? 0x3F800000u : 0x00003F80u; const int q = 2 * p + ((tk & 3) >> 1); w.x = (q == 0) ? one : 0u; w.y = (q == 1) ? one : 0u; w.z = (q == 2) ? one : 0u; w.w = (q == 3) ? one : 0u; }
        Sel[p] = __builtin_bit_cast(mx_bf16x8, w); }
    float rk[9];
#pragma unroll
    for (int kt = 0; kt < 9; ++kt) {
        float ssk = 0.f;
        { const unsigned kk[8] = {kA[kt].x, kA[kt].y, kA[kt].z, kA[kt].w, kB[kt].x, kB[kt].y, kB[kt].z, kB[kt].w};
#pragma unroll
          for (int i = 0; i < 8; ++i) { const float a = mx_lo(kk[i]), b = mx_hi(kk[i]); ssk += a * a + b * b; } }
        rk[kt] = MX_RSQ(mx_rowsum4(ssk) * (1.f / 64.f) + 1e-6f);
#pragma unroll
        for (int dt = 0; dt < 4; ++dt) *(MX_L mx_u32x2*)(vts + (unsigned)(((kt * 4 + dt) * 64 + lane) * 8)) = mx_pack4(mx_mfma(__builtin_bit_cast(mx_bf16x8, (dt >> 1) ? vB[kt] : vA[kt]), Sel[dt & 1], z4));
    }
    MX_LDSWAIT(); MX_SCHED();
    for (int hh = 0; hh < 4; ++hh) {
        const int h = 4 * kvh + hh;
        const mx_u32x4 cqa = qa, cqb = qb;
        if (hh < 3) { qa = *(const MX_G mx_u32x4*)(qrow + 1024 * (hh + 1)); qb = *(const MX_G mx_u32x4*)(qrow + 1024 * (hh + 1) + 512); }
        const MX_L float* btab = btab_all + 128 * h;
        mx_bf16x8 QF[2];
        {
            float q[16]; float ss = 0.f;
            q[0] = mx_lo(cqa.x); q[1] = mx_hi(cqa.x); q[2] = mx_lo(cqa.y); q[3] = mx_hi(cqa.y); q[4] = mx_lo(cqa.z); q[5] = mx_hi(cqa.z); q[6] = mx_lo(cqa.w); q[7] = mx_hi(cqa.w);
            q[8] = mx_lo(cqb.x); q[9] = mx_hi(cqb.x); q[10] = mx_lo(cqb.y); q[11] = mx_hi(cqb.y); q[12] = mx_lo(cqb.z); q[13] = mx_hi(cqb.z); q[14] = mx_lo(cqb.w); q[15] = mx_hi(cqb.w);
#pragma unroll
            for (int i = 0; i < 16; ++i) ss += q[i] * q[i];
            ss = mx_rowsum4(ss);
            const float rs = MX_RSQ(ss * (1.f / 64.f) + 1e-6f);
#pragma unroll
            for (int i = 0; i < 16; ++i) q[i] = q[i] * rs * qkw[i];
            QF[0] = mx_frag8(q, q + 4); QF[1] = mx_frag8(q + 8, q + 12);
        }
        mx_f32x4 O[4];
#pragma unroll
        for (int dt = 0; dt < 4; ++dt) O[dt] = z4;
        float lsum = 0.f;
#pragma unroll
        for (int kt = 0; kt < 9; ++kt) {
            const int key0 = q0 - 128 + 16 * kt;
            const mx_f32x4 S = mx_mfma(__builtin_bit_cast(mx_bf16x8, kB[kt]), QF[1], mx_mfma(__builtin_bit_cast(mx_bf16x8, kA[kt]), QF[0], z4));
            mx_f32x4 P;
#pragma unroll
            for (int e = 0; e < 4; ++e) {
                const float rke = mx_shfl16l(rk[kt], 4 * g + e, lane);
                const int dist = (q0 + tk) - (key0 + 4 * g + e); const bool valid = (dist >= 0) && (dist < 128) && (key0 >= 0);
                float ex = MX_EXP(S[e] * rke + btab[dist & 127] - Mb); MX_LAUNDER_V(ex);
                P[e] = valid ? ex : 0.f; lsum += P[e];
            }
            const mx_u32x2 pf = mx_frag4(P);
#pragma unroll
            for (int dt = 0; dt < 4; ++dt) O[dt] = mx_mfma(mx_frag4p(*(const MX_L mx_u32x2*)(vts + (unsigned)(((kt * 4 + dt) * 64 + lane) * 8))), pf, O[dt]);
        }
        lsum = mx_rowsum4(lsum);
        const float inv = MX_RCP(lsum + esink[hh]);
        const int ycol = 512 + 64 * h;
#pragma unroll
        for (int dp = 0; dp < 2; ++dp) { mx_u32x4 o; o.x = mx_pk2(O[2 * dp].x * inv, O[2 * dp].y * inv); o.y = mx_pk2(O[2 * dp].z * inv, O[2 * dp].w * inv); o.z = mx_pk2(O[2 * dp + 1].x * inv, O[2 * dp + 1].y * inv); o.w = mx_pk2(O[2 * dp + 1].z * inv, O[2 * dp + 1].w * inv);
            *(MX_G mx_u32x4*)(yatt + mx_yoff(q0 + tk, ycol + mx_ch_off(2 * dp, g))) = o; }
    }
}

__device__ __forceinline__ float wave_allmax(float v) {
    v = fmaxf(v, dppf(v, 0)); v = fmaxf(v, dppf(v, 1)); v = fmaxf(v, dppf(v, 2)); v = fmaxf(v, dppf(v, 3));
    const float a = __builtin_bit_cast(float, __builtin_amdgcn_readlane(__builtin_bit_cast(int, v), 0)), b = __builtin_bit_cast(float, __builtin_amdgcn_readlane(__builtin_bit_cast(int, v), 16));
    const float c = __builtin_bit_cast(float, __builtin_amdgcn_readlane(__builtin_bit_cast(int, v), 32)), d = __builtin_bit_cast(float, __builtin_amdgcn_readlane(__builtin_bit_cast(int, v), 48));
    return fmaxf(fmaxf(a, b), fmaxf(c, d));
}
__device__ __forceinline__ void mixer_phase(Frame& F, int l) {
    const int blk = blockIdx.x;
    {
        const int lane = ltid() & 63;
        const LAS float* btab_all = (const LAS float*)(F.lds + BIAS_OFF);
        float mb = 0.f;
#pragma unroll
        for (int i = 0; i < 16; ++i) mb = fmaxf(mb, fabsf(btab_all[lane + 64 * i]));
        const int pair = blk >> 3, seg = blk & 7, b = pair >> 1, kvh = pair & 1;
        const MX_G float* qnw = MXIN(I_QNW) + l * 64; const MX_G float* knw = MXIN(I_KNW) + l * 64; const MX_G float* snk = MXIN(I_SINK) + l * 8 + 4 * kvh;
        float sk[4]; mx_f32x4 qkw4[4]; const float qn_l = qnw[lane], kn_l = knw[lane];
#pragma unroll
        for (int j = 0; j < 4; ++j) { const mx_f32x4 q4 = *(const MX_G mx_f32x4*)(qnw + 32 * (j >> 1) + 8 * (lane >> 4) + 4 * (j & 1)), k4 = *(const MX_G mx_f32x4*)(knw + 32 * (j >> 1) + 8 * (lane >> 4) + 4 * (j & 1));
            sk[j] = snk[j];
            qkw4[j] = q4 * k4; }
        const float Mb = 8.f * wave_allmax(fabsf(qn_l)) * wave_allmax(fabsf(kn_l)) + wave_allmax(mb);
        float esink[4];
#pragma unroll
        for (int hh = 0; hh < 4; ++hh) esink[hh] = __expf(sk[hh] - Mb);
        float qkw[16];
#pragma unroll
        for (int i = 0; i < 16; ++i) qkw[i] = 0.125f * qkw4[i >> 2][i & 3];
        const MX_G unsigned short* zseq = (const MX_G unsigned short*)FZ + (size_t)b * SEQ * ZP;
        MX_G unsigned short* yatt = (MX_G unsigned short*)FY + (size_t)b * SEQ * DM;
        for (int i = 0; i < 2; ++i) {
            const int qt = 16 * seg + F.wave + 8 * i;
            int ln = lane; MX_LAUNDER_V(ln);
            mx_attn_unit4(kvh, 16 * qt, zseq, yatt, btab_all, Mb, esink, qkw, F.lds + RING_OFF + F.wave * 18432, ln);
        }
    }
    __syncthreads();
    {
        const int seq = blk & 127, role = blk >> 7, type = seq >> 6, bh = seq & 63, b = bh >> 2, h = bh & 3;
        const MX_G unsigned short* zseq = (const MX_G unsigned short*)FZ + (size_t)b * SEQ * ZP;
        MX_G unsigned short* yseq = (MX_G unsigned short*)FY + (size_t)b * SEQ * DM;
        MX_G unsigned* ctlw = (MX_G unsigned*)WSP(WS_CTL);
        mx_sequence(l, type, h, zseq, yseq, SEQ / 16, (MX_G unsigned char*)WSP(WS_HB) + (size_t)blk * (2 * 8 * MX_GB_SLOT), F.lds + RING_OFF, F.wave,
                    role, (MX_G unsigned long long*)WSP(WS_XS) + (size_t)seq * 2048, ctlw + CW_SEQ + (l * 128 + seq) * 64, ctlw + CW_TMO,
                    (MX_G unsigned char*)WSP(WS_HB) + (size_t)256 * (2 * 8 * MX_GB_SLOT) + (size_t)blk * (2 * MX_YS_PAR));
    }
}
constexpr int PH_PER_L = 5, NPH = 1 + DEPTH * PH_PER_L;
struct Args { const float* in[26]; float* out; unsigned char* ws; int ph_lo, ph_hi; };
__global__ void __launch_bounds__(NWAVES * 64, 2) fwd(Args args) {
    extern __shared__ __attribute__((aligned(16))) unsigned char lds[];
    Frame F;
    F.lds = (LAS unsigned char*)lds;
    const int tid0 = threadIdx.x; F.wave = __builtin_amdgcn_readfirstlane(tid0 >> 6);
    F.G = gridDim.x; { const int bx = blockIdx.x; F.vcu = (F.G % 8 == 0) ? (bx % 8) * (F.G / 8) + bx / 8 : bx; }
    F.ws = args.ws; F.out = args.out;
    for (int u = tid0; u < (BIAS_OFF - LDSCTL_OFF) / 4; u += NWAVES * 64) ((LAS unsigned*)(F.lds + LDSCTL_OFF))[u] = 0u;
    for (int u = tid0; u < 8 * 128; u += NWAVES * 64) {
        const int h = u >> 7, d = u & 127;
        int bucket;
        if (d < 16) bucket = d;
        else { int lg = 16 + (int)(logf((float)d / 16.f) / logf(8.f) * 16.f); bucket = lg < 31 ? lg : 31; }
        ((LAS float*)(F.lds + BIAS_OFF))[u] = INP(I_RELB)[bucket * 8 + h];
    }
    __syncthreads();
    const int lo = args.ph_lo, hi = args.ph_hi;
    const bool one = (hi - lo) > 1;
    XcdBarrier bar; bar.bar = (unsigned*)(F.ws + WS_CTL) + CW_BAR; bar.x = 0; bar.st = nullptr;
    if (one) bar = xcd_barrier_post((unsigned*)(F.ws + WS_CTL) + CW_BAR, (volatile LAS unsigned*)(F.lds + MISC_OFF) + 8, tid0 == 0);
#define IN(k) (lo <= (k) && (k) < hi)
#define SEAM(k) do { if (IN(k) && IN((k) + 1)) { XcdBarrier b2_ = bar; asm volatile("" : "+s"(b2_.bar)); xcd_barrier(b2_, F.wave == 0 && hw_lane() == 0); } } while (0)

    #ifndef DIS_PRO
    if (IN(0)) { p0_prologue(F); SEAM(0); }
#endif
    for (int l = 0; l < DEPTH; ++l) {
        const int pb = 1 + PH_PER_L * l;
        if (IN(pb + 0)) {
            pg8::Gemm g{FXN, ((bf16*)WSP(WS_WIN)) + (size_t)l * ZP * DM, M, ZP, DM}; pg8::StaticOrder S; S.init(M, ZP, F.G, (int)blockIdx.x);
            pg8::EpiBf16<0, true> E{FZ, ZP, (const float*)WSP(WS_RSS) + (size_t)(2 * l) * M * 16};
            pg8::gemm_phase<pg8::EpiBf16<0, true>, pg8::StaticOrder, true, true>(F.lds + RING_OFF, g, S, E, F.wave);
            SEAM(pb + 0);
        }
        if (IN(pb + 1)) { mixer_phase(F, l); SEAM(pb + 1); }
        if (IN(pb + 2)) {
            pg8::Gemm g{FY, ((bf16*)WSP(WS_WOUT)) + (size_t)l * DM * DM, M, DM, DM}; pg8::StaticOrder S; S.init(M, DM, F.G, (int)blockIdx.x);
            pg8::EpiResBf16 E{FXN, DM, (float*)nullptr, (float*)WSP(WS_RSS) + (size_t)(2 * l + 1) * M * 16};
            pg8::gemm_phase<pg8::EpiResBf16, pg8::StaticOrder, true, true>(F.lds + RING_OFF, g, S, E, F.wave);
            SEAM(pb + 2);
        }
        if (IN(pb + 3)) {
            pg8::Gemm g{FXN, ((bf16*)WSP(WS_W1)) + (size_t)l * DFF * DM, M, DFF, DM}; pg8::StaticOrder S; S.init(M, DFF, F.G, (int)blockIdx.x);
            pg8::EpiBf16<2> E{FH, DFF, (const float*)WSP(WS_RSS) + (size_t)(2 * l + 1) * M * 16};
            pg8::gemm_phase<pg8::EpiBf16<2>, pg8::StaticOrder, true, true>(F.lds + RING_OFF, g, S, E, F.wave);
            SEAM(pb + 3);
        }
        if (IN(pb + 4)) {
            pg8::Gemm g{FH, ((bf16*)WSP(WS_W2)) + (size_t)l * DM * DFF, M, DM, DFF}; pg8::StaticOrder S; S.init(M, DM, F.G, (int)blockIdx.x);
            pg8::EpiResBf16 E{FXN, DM, l + 1 < DEPTH ? (float*)nullptr : F.out, l + 1 < DEPTH ? (float*)WSP(WS_RSS) + (size_t)(2 * l + 2) * M * 16 : (float*)nullptr};
            pg8::gemm_phase<pg8::EpiResBf16, pg8::StaticOrder, true, true>(F.lds + RING_OFF, g, S, E, F.wave);
            SEAM(pb + 4);
        }
    }
#undef IN
#undef SEAM
}

#ifndef MK_ONE_LAUNCH
#define MK_ONE_LAUNCH 1
#endif
extern "C" void kernel_launch(void* const* d_in, const int* in_sizes, int n_in, void* d_out, int out_size, void* d_ws, size_t ws_size, hipStream_t stream) {
    static int grid = 0;
    if (grid == 0) {
        if (n_in != 26 || in_sizes[0] != M * DM || out_size != M * DM || ws_size < WS_END) { fprintf(stderr, "kernel_launch: unexpected shapes (n_in %d, in0 %d, out %d, ws %zu, need %zu)\n", n_in, n_in > 0 ? in_sizes[0] : -1, out_size, ws_size, (size_t)WS_END); grid = -1; return; }
        int dev = 0, cus = 0, per_cu = 0;
        if (hipGetDevice(&dev) != hipSuccess || hipDeviceGetAttribute(&cus, hipDeviceAttributeMultiprocessorCount, dev) != hipSuccess) { grid = -1; return; }
        if (hipFuncSetAttribute((const void*)fwd, hipFuncAttributeMaxDynamicSharedMemorySize, LDS_BYTES) != hipSuccess) { fprintf(stderr, "kernel_launch: hipFuncSetAttribute failed\n"); grid = -1; return; }
        if (hipOccupancyMaxActiveBlocksPerMultiprocessor(&per_cu, (const void*)fwd, NWAVES * 64, LDS_BYTES) != hipSuccess || per_cu < 1) fprintf(stderr, "kernel_launch: occupancy query reports %d\n", per_cu);
        (void)hipGetLastError();
        grid = cus;
    }
    if (grid < 0) return;
    if (hipMemsetAsync((char*)d_ws + WS_CTL, 0, CTL_ZERO_BYTES, stream) != hipSuccess) return;
    Args a{};
    for (int i = 0; i < 26; ++i) a.in[i] = (const float*)d_in[i];
    a.out = (float*)d_out; a.ws = (unsigned char*)d_ws;
#if MK_ONE_LAUNCH
    a.ph_lo = 0; a.ph_hi = NPH;
    hipLaunchKernelGGL(fwd, dim3(grid), dim3(NWAVES * 64), LDS_BYTES, stream, a);
#else
    for (int ph = 0; ph < NPH; ++ph) {
        a.ph_lo = ph; a.ph_hi = ph + 1;
        hipLaunchKernelGGL(fwd, dim3(grid), dim3(NWAVES * 64), LDS_BYTES, stream, a);
    }
#endif
}
```

```cpp
#include <hip/hip_runtime.h>
#include <cstdio>
#include <cstdint>
#include <cmath>
#include <type_traits>
__device__ __forceinline__ int hwl_() { int t; asm volatile("v_mbcnt_lo_u32_b32 %0, -1, 0\n\tv_mbcnt_hi_u32_b32 %0, -1, %0" : "=v"(t)); return t; }
__device__ __forceinline__ float xor16f(float v) { return __builtin_bit_cast(float, __builtin_amdgcn_ds_swizzle(__builtin_bit_cast(int, v), 0x401F)); }
__device__ __forceinline__ float xor32f(float v) { return __builtin_bit_cast(float, __builtin_amdgcn_ds_bpermute((hwl_() ^ 32) << 2, __builtin_bit_cast(int, v))); }
namespace pg8 {
#define PG8_LAS __attribute__((address_space(3)))
typedef unsigned short bf16_t;
typedef short bf16x8 __attribute__((ext_vector_type(8)));
typedef float f32x4 __attribute__((ext_vector_type(4)));
typedef unsigned u32x4 __attribute__((ext_vector_type(4)));
constexpr int BM = 256, BK = 64, HALF = 128, HTB = HALF * BK * 2  , STAGE_BYTES = 8 * HTB, NXCD = 8, WGM = 8;

__host__ __device__ __forceinline__ int lds_byte(int r, int c) { const int st = (r >> 4) * 2 + (c >> 5), rr = r & 15, cc = c & 31, ob = rr * 64 + cc * 2; return st * 1024 + (ob ^ (((ob >> 9) & 1) << 5)); }
__host__ __device__ __forceinline__ size_t tiled_byte(int row, int col, int nt) { return ((size_t)((row >> 8) * nt + (col >> 6)) * 2 + ((row >> 7) & 1)) * 16384 + lds_byte(row & 127, col & 63); }
__host__ __device__ __forceinline__ void stage_rc(int b, int& R, int& C) { const int st = b / 1024, sb = b % 1024, swz = sb ^ (((sb >> 9) & 1) << 5); R = (st >> 1) * 16 + swz / 64; C = (st & 1) * 32 + (swz % 64) / 2; }
__host__ __device__ __forceinline__ int perm32(int rho) { const int n = rho >> 4, i = rho & 15; return 8 * (i >> 2) + 4 * n + (i & 3); }

struct Unit { int pm, pn; };
struct Gemm { const bf16_t* A; const bf16_t* Bt; int M, N, K; size_t askip = 0; };

struct StaticOrder {
    int nM, nN, nwg, G, c;
    __host__ __device__ void init(int M, int N, int G_, int c_) { nM = M / BM; nN = N / BM; nwg = nM * nN; G = G_; c = c_; }
    __host__ __device__ bool next(int i, Unit& u) const {
        const long L = (long)i * G + c; if (L >= nwg) return false;
        int wgid = (int)L; { const int q = nwg / NXCD, r = nwg % NXCD, xcd = wgid % NXCD, off = wgid / NXCD; wgid = (xcd < r ? xcd * (q + 1) : r * (q + 1) + (xcd - r) * q) + off; }
        const int nig = WGM * nN, gid = wgid / nig, fm = gid * WGM, gsz = (nM - fm) < WGM ? (nM - fm) : WGM;
        u.pm = fm + ((wgid % nig) % gsz); u.pn = (wgid % nig) / gsz; return true;
    }
    __device__ __forceinline__ void a_ready(const Unit&) const {}
    __device__ __forceinline__ void done(const Unit&) const {}
};

__device__ __forceinline__ unsigned cvt_pk_bf16(float lo, float hi) { unsigned r; asm volatile("v_cvt_pk_bf16_f32 %0, %1, %2" : "=v"(r) : "v"(lo), "v"(hi)); return r; }
#define PG8_GAS __attribute__((address_space(1)))
constexpr size_t ZSLAB_SKIP = (size_t)4 * 1024 * 1024;
template <int ACT  , bool ZB = false  > struct EpiBf16 {
    static constexpr bool PERM = true, AFTER_DRAIN = false;
    static constexpr int NST = 16;
    bf16_t* O; int ldc; const float* rss;
    __device__ __forceinline__ void operator()(const f32x4 (&acc)[2][2][4][2], const Unit& u, int wr, int wc, int fr, int fq) const {
        const int row0 = u.pm * BM + wr * 64 + fr, col0 = u.pn * BM + wc * 32 + 8 * fq;
        float rs[8];
        { f32x4 pr[8];
#pragma unroll
          for (int r = 0; r < 8; ++r) pr[r] = *(const PG8_GAS f32x4*)(rss + (size_t)(row0 + (r >> 2) * HALF + (r & 3) * 16) * 16 + 4 * fq);
          __builtin_amdgcn_sched_barrier(0);
#pragma unroll
          for (int r = 0; r < 8; ++r) { float ssum = (pr[r][0] + pr[r][1]) + (pr[r][2] + pr[r][3]); ssum += ::xor16f(ssum); ssum += ::xor32f(ssum); rs[r] = __builtin_amdgcn_rsqf(ssum * (1.f / 1024.f) + 1e-6f); } }
#pragma unroll
        for (int ai = 0; ai < 2; ++ai)
#pragma unroll
            for (int m = 0; m < 4; ++m) { const int row = row0 + ai * HALF + m * 16; const float rsr = rs[ai * 4 + m];
                bf16_t* rowp = ZB ? O + (size_t)(row >> 12) * ZSLAB_SKIP + ((size_t)(row >> 4) * (ldc / 64) + (col0 >> 6)) * 1024 + ((col0 >> 5) & 1) * 512 + (row & 15) * 32 + (col0 & 31) : (bf16_t*)((char*)O + tiled_byte(row, col0, ldc >> 6));
#pragma unroll
                for (int bj = 0; bj < 2; ++bj) { f32x4 v0 = acc[ai][bj][m][0] * rsr, v1 = acc[ai][bj][m][1] * rsr;
                    if (ACT == 2) {
#pragma unroll
                        for (int e = 0; e < 4; ++e) { const float a = v0[e] > 0.f ? v0[e] : 0.f, b = v1[e] > 0.f ? v1[e] : 0.f; v0[e] = a * a; v1[e] = b * b; } }
                    u32x4 w; w.x = cvt_pk_bf16(v0[0], v0[1]); w.y = cvt_pk_bf16(v0[2], v0[3]); w.z = cvt_pk_bf16(v1[0], v1[1]); w.w = cvt_pk_bf16(v1[2], v1[3]);
                    *(PG8_GAS u32x4*)(rowp + (ZB ? bj * (HALF / 64) * 1024 : bj * (HALF / 64) * 2 * 8192)) = w; } }
    }
};
struct EpiResF32 {
    static constexpr bool PERM = true, AFTER_DRAIN = false;
    static constexpr int NST = 16;
    const float* base; float* out; int ldc; bf16_t* xn; float* rss;
    __device__ __forceinline__ void operator()(const f32x4 (&acc)[2][2][4][2], const Unit& u, int wr, int wc, int fr, int fq) const {
        const int row0 = u.pm * BM + wr * 64 + fr, col0 = u.pn * BM + wc * 32 + 8 * fq;
#pragma unroll
        for (int ai = 0; ai < 2; ++ai)
#pragma unroll
            for (int m = 0; m < 4; ++m) { const int row = row0 + ai * HALF + m * 16; const size_t off = (size_t)row * ldc + col0; float ss = 0.f;
#pragma unroll
                for (int bj = 0; bj < 2; ++bj) {
                    const f32x4 b0 = *(const PG8_GAS f32x4*)(base + off + bj * HALF), b1 = *(const PG8_GAS f32x4*)(base + off + bj * HALF + 4);
                    const f32x4 o0 = b0 + acc[ai][bj][m][0], o1 = b1 + acc[ai][bj][m][1];
                    *(PG8_GAS f32x4*)(out + off + bj * HALF) = o0; *(PG8_GAS f32x4*)(out + off + bj * HALF + 4) = o1;
                    if (xn) { u32x4 w; w.x = cvt_pk_bf16(o0[0], o0[1]); w.y = cvt_pk_bf16(o0[2], o0[3]); w.z = cvt_pk_bf16(o1[0], o1[1]); w.w = cvt_pk_bf16(o1[2], o1[3]); *(PG8_GAS u32x4*)(xn + off + bj * HALF) = w;
                        ss += ((o0[0] * o0[0] + o0[1] * o0[1]) + (o0[2] * o0[2] + o0[3] * o0[3])) + ((o1[0] * o1[0] + o1[1] * o1[1]) + (o1[2] * o1[2] + o1[3] * o1[3])); } }
                if (xn) { ss += ::xor16f(ss); ss += ::xor32f(ss); if (fq == 0) *(PG8_GAS float*)(rss + (size_t)row * 16 + 4 * u.pn + wc) = ss; } }
    }
};

struct EpiResBf16 {
    static constexpr bool PERM = true, AFTER_DRAIN = false;
    static constexpr int NST = 32;
    bf16_t* x; int ldc; float* outf; float* rss;
    __device__ __forceinline__ void operator()(const f32x4 (&acc)[2][2][4][2], const Unit& u, int wr, int wc, int fr, int fq) const {
        const int row0 = u.pm * BM + wr * 64 + fr, col0 = u.pn * BM + wc * 32 + 8 * fq;
        const int ntx = ldc >> 6; constexpr size_t XH = (size_t)(HALF / 64) * 2 * 8192;
        u32x4 nb0 = *(const PG8_GAS u32x4*)((const char*)x + tiled_byte(row0, col0, ntx)), nb1 = *(const PG8_GAS u32x4*)((const char*)x + tiled_byte(row0, col0, ntx) + 2 * XH);
#pragma unroll
        for (int r = 0; r < 8; ++r) { const int ai = r >> 2, m = r & 3; const int row = row0 + ai * HALF + m * 16; const size_t off = (size_t)row * ldc + col0; float ss = 0.f;
            const u32x4 cb0 = nb0, cb1 = nb1;
            if (r < 7) { const char* np_ = (const char*)x + tiled_byte(row0 + ((r + 1) >> 2) * HALF + ((r + 1) & 3) * 16, col0, ntx); nb0 = *(const PG8_GAS u32x4*)(np_); nb1 = *(const PG8_GAS u32x4*)(np_ + 2 * XH); }
            __builtin_amdgcn_sched_barrier(0);
#pragma unroll
            for (int bj = 0; bj < 2; ++bj) {
                const u32x4 b = bj ? cb1 : cb0;
                f32x4 o0, o1;
                o0[0] = __builtin_bit_cast(float, b.x << 16) + acc[ai][bj][m][0][0]; o0[1] = __builtin_bit_cast(float, b.x & 0xffff0000u) + acc[ai][bj][m][0][1];
                o0[2] = __builtin_bit_cast(float, b.y << 16) + acc[ai][bj][m][0][2]; o0[3] = __builtin_bit_cast(float, b.y & 0xffff0000u) + acc[ai][bj][m][0][3];
                o1[0] = __builtin_bit_cast(float, b.z << 16) + acc[ai][bj][m][1][0]; o1[1] = __builtin_bit_cast(float, b.z & 0xffff0000u) + acc[ai][bj][m][1][1];
                o1[2] = __builtin_bit_cast(float, b.w << 16) + acc[ai][bj][m][1][2]; o1[3] = __builtin_bit_cast(float, b.w & 0xffff0000u) + acc[ai][bj][m][1][3];
                if (outf) { *(PG8_GAS f32x4*)(outf + off + bj * HALF) = o0; *(PG8_GAS f32x4*)(outf + off + bj * HALF + 4) = o1; }
                else { u32x4 w; w.x = cvt_pk_bf16(o0[0], o0[1]); w.y = cvt_pk_bf16(o0[2], o0[3]); w.z = cvt_pk_bf16(o1[0], o1[1]); w.w = cvt_pk_bf16(o1[2], o1[3]); *(PG8_GAS u32x4*)((char*)x + tiled_byte(row, col0, ntx) + bj * 2 * XH) = w;
                    ss += ((o0[0] * o0[0] + o0[1] * o0[1]) + (o0[2] * o0[2] + o0[3] * o0[3])) + ((o1[0] * o1[0] + o1[1] * o1[1]) + (o1[2] * o1[2] + o1[3] * o1[3])); } }
            if (!outf) { ss += ::xor16f(ss); ss += ::xor32f(ss); if (fq == 0) *(PG8_GAS float*)(rss + (size_t)row * 16 + 4 * u.pn + wc) = ss; }
            __builtin_amdgcn_sched_barrier(0); }
    }
};
template <int N> __device__ __forceinline__ void wait_v8_or(int relaxed) { static_assert(N > 8 && N <= 63, "vmcnt is 6 bits");
    asm volatile("s_cmp_lg_u32 %0, 0\n\ts_cbranch_scc1 .Lpg8wv%=\n\ts_waitcnt vmcnt(8)\n.Lpg8wv%=:\n\ts_waitcnt vmcnt(%1)" :: "s"(relaxed), "n"(N) : "memory", "scc"); }
template <class Epi, class Sched, bool ALIGN_EPI = false, bool SP2 = false>
__device__ __forceinline__ void gemm_phase(PG8_LAS unsigned char* lds, const Gemm g, const Sched& S, const Epi& E, const int wave_id  ) {
    int tid_l = wave_id * 64 + ::hwl_();
    const int tid = tid_l, wid = __builtin_amdgcn_readfirstlane(tid >> 6), lane = tid & 63, wr = wid >> 2, wc = wid & 3, fr = lane & 15, fq = lane >> 4;
    const int K = g.K, nt = K / BK;
    unsigned voffA[2], voffB[2];
#pragma unroll
    for (int i = 0; i < 2; ++i) { int R, C; stage_rc(tid * 16 + i * 8192, R, C); const int Rb = Epi::PERM ? ((R & ~31) + perm32(R & 31)) : R;
        voffA[i] = (unsigned)(tid * 16 + i * 8192); voffB[i] = voffA[i]; (void)Rb; (void)R; (void)C; }
    const size_t kstep = 2 * HTB;
    const size_t hstep = HTB;
    const size_t tstep = (size_t)nt * 2 * HTB;
    const size_t kstepB = 2 * HTB, hstepB = HTB, tstepB = (size_t)nt * 2 * HTB;
    const unsigned ldsw = (unsigned)wid * 1024u;
    const int aoff = lds_byte(wr * 64 + fr, fq * 8), boff = lds_byte(wc * 32 + fr, fq * 8);
#define PG8_SA(b, h) (((b) * 2 + (h)) * HTB)
#define PG8_SB(b, h) ((4 + (b) * 2 + (h)) * HTB)
#define PG8_STAGE(bufoff, gbase, voff) do { _Pragma("unroll") for (int _i = 0; _i < 2; ++_i) \
        __builtin_amdgcn_global_load_lds((const unsigned*)((const char*)(gbase) + (voff)[_i]), (PG8_LAS unsigned*)(lds + (bufoff) + ldsw + _i * 8192), 16, 0, 0); } while (0)
#define PG8_LDA(dst, b, h) do { _Pragma("unroll") for (int m = 0; m < 4; ++m) _Pragma("unroll") for (int k = 0; k < 2; ++k) dst[m][k] = *(const PG8_LAS bf16x8*)(lds + PG8_SA(b, h) + aoff + m * 2048 + k * 1024); } while (0)
#define PG8_LDB(dst, b, h) do { _Pragma("unroll") for (int n = 0; n < 2; ++n) _Pragma("unroll") for (int k = 0; k < 2; ++k) dst[n][k] = *(const PG8_LAS bf16x8*)(lds + PG8_SB(b, h) + boff + n * 2048 + k * 1024); } while (0)
#define PG8_MMA(ai, bj, At, Bt) do { __builtin_amdgcn_s_setprio(1); _Pragma("unroll") for (int m = 0; m < 4; ++m) _Pragma("unroll") for (int n = 0; n < 2; ++n) _Pragma("unroll") for (int k = 0; k < 2; ++k) \
        acc[ai][bj][m][n] = __builtin_amdgcn_mfma_f32_16x16x32_bf16(Bt[n][k], At[m][k], acc[ai][bj][m][n], 0, 0, 0); __builtin_amdgcn_s_setprio(0); } while (0)
#define PG8_WAIT_V(n) asm volatile("s_waitcnt vmcnt(" #n ")" ::: "memory")
#define PG8_WAIT_L(n) asm volatile("s_waitcnt lgkmcnt(" #n ")" ::: "memory")
#define PG8_BAR __builtin_amdgcn_s_barrier()
#define PG8_SCHED __builtin_amdgcn_sched_barrier(0)
    Unit cur, nxt; int ui = 0;
    if (!S.next(0, cur)) return;
    f32x4 acc[2][2][4][2];
#pragma unroll
    for (int a = 0; a < 2; ++a)
#pragma unroll
        for (int b = 0; b < 2; ++b)
#pragma unroll
            for (int m = 0; m < 4; ++m)
#pragma unroll
                for (int n = 0; n < 2; ++n) acc[a][b][m][n] = (f32x4){0.f, 0.f, 0.f, 0.f};
    bf16x8 At[4][2], B0[2][2], B1[2][2];
    const char* cA = (const char*)g.A + (size_t)cur.pm * tstep + (size_t)(cur.pm >> 4) * g.askip; const char* cB = (const char*)g.Bt + (size_t)cur.pn * tstepB;
    S.a_ready(cur);
    if constexpr (SP2) {
        PG8_STAGE(PG8_SB(0, 0), cB, voffB); PG8_STAGE(PG8_SB(0, 1), cB + hstepB, voffB); PG8_STAGE(PG8_SA(0, 0), cA, voffA); PG8_STAGE(PG8_SA(0, 1), cA + hstep, voffA);
        if (wr == 1) PG8_BAR;
        PG8_WAIT_V(2); PG8_BAR;
        PG8_STAGE(PG8_SB(1, 0), cB + kstepB, voffB); PG8_STAGE(PG8_SA(1, 0), cA + kstep, voffA); PG8_STAGE(PG8_SB(1, 1), cB + hstepB + kstepB, voffB);
        PG8_WAIT_V(6); PG8_BAR;
    } else {
        PG8_STAGE(PG8_SB(0, 0), cB, voffB); PG8_STAGE(PG8_SA(0, 0), cA, voffA); PG8_STAGE(PG8_SB(0, 1), cB + hstepB, voffB); PG8_STAGE(PG8_SA(0, 1), cA + hstep, voffA);
        if (wr == 1) PG8_BAR;
        PG8_WAIT_V(4); PG8_BAR;
        PG8_STAGE(PG8_SB(1, 0), cB + kstepB, voffB); PG8_STAGE(PG8_SA(1, 0), cA + kstep, voffA); PG8_STAGE(PG8_SB(1, 1), cB + hstepB + kstepB, voffB);
        PG8_WAIT_V(6); PG8_BAR;
    }
    for (;;) {
        const bool has_next = S.next(ui + 1, nxt);
        const char* nA = has_next ? (const char*)g.A + (size_t)nxt.pm * tstep + (size_t)(nxt.pm >> 4) * g.askip : cA; const char* nB = has_next ? (const char*)g.Bt + (size_t)nxt.pn * tstepB : cB;
        for (int t = 0; t < nt; t += 2) {
            const bool last = (t == nt - 2);
            const char* a1 = cA + (size_t)(t + 1) * kstep;
            const char* a2 = last ? nA : cA + (size_t)(t + 2) * kstep; const char* b2 = last ? nB : cB + (size_t)(t + 2) * kstepB;
            const char* a3 = a2 + kstep; const char* b3 = b2 + kstepB;
            if (last && has_next) S.a_ready(nxt);
            if constexpr (SP2) {
            const int relaxed = __builtin_amdgcn_readfirstlane((t == 0 && ui > 0) ? 1 : 0);
            PG8_LDB(B0, 0, 0); PG8_LDB(B1, 0, 1); PG8_SCHED; PG8_LDA(At, 0, 0); PG8_STAGE(PG8_SA(1, 1), a1 + hstep, voffA);
            wait_v8_or<8 + Epi::NST>(relaxed); PG8_WAIT_L(0); PG8_BAR; PG8_MMA(0, 0, At, B0); PG8_MMA(0, 1, At, B1); PG8_BAR; PG8_SCHED;
            PG8_LDA(At, 0, 1); PG8_STAGE(PG8_SB(0, 0), b2, voffB); PG8_STAGE(PG8_SB(0, 1), b2 + hstepB, voffB); PG8_STAGE(PG8_SA(0, 0), a2, voffA);
            wait_v8_or<8 + Epi::NST>(relaxed); PG8_WAIT_L(0); PG8_BAR; PG8_MMA(1, 0, At, B0); PG8_MMA(1, 1, At, B1); PG8_BAR; PG8_SCHED;
            PG8_LDB(B0, 1, 0); PG8_LDB(B1, 1, 1); PG8_SCHED; PG8_LDA(At, 1, 0); PG8_STAGE(PG8_SA(0, 1), a2 + hstep, voffA);
            PG8_WAIT_V(8); PG8_WAIT_L(0); PG8_BAR; PG8_MMA(0, 0, At, B0); PG8_MMA(0, 1, At, B1); PG8_BAR; PG8_SCHED;
            PG8_LDA(At, 1, 1); PG8_STAGE(PG8_SB(1, 0), b3, voffB); PG8_STAGE(PG8_SB(1, 1), b3 + hstepB, voffB); PG8_STAGE(PG8_SA(1, 0), a3, voffA);
            PG8_WAIT_V(8); PG8_WAIT_L(0); PG8_BAR; PG8_MMA(1, 0, At, B0); PG8_MMA(1, 1, At, B1); PG8_BAR; PG8_SCHED;
            } else {
            PG8_LDB(B0, 0, 0); PG8_SCHED; PG8_LDA(At, 0, 0); PG8_STAGE(PG8_SA(1, 1), a1 + hstep, voffA);
            PG8_WAIT_L(8); PG8_BAR; PG8_WAIT_L(0); PG8_MMA(0, 0, At, B0); PG8_BAR; PG8_SCHED;
            PG8_LDB(B1, 0, 1); PG8_STAGE(PG8_SB(0, 0), b2, voffB);
            PG8_BAR; PG8_WAIT_L(0); PG8_MMA(0, 1, At, B1); PG8_BAR;
            PG8_LDA(At, 0, 1); PG8_STAGE(PG8_SA(0, 0), a2, voffA);
            PG8_BAR; PG8_WAIT_L(0); PG8_MMA(1, 0, At, B0); PG8_BAR; PG8_SCHED;
            PG8_STAGE(PG8_SB(0, 1), b2 + hstepB, voffB);
            PG8_WAIT_V(6); PG8_BAR; PG8_MMA(1, 1, At, B1); PG8_BAR;
            PG8_LDB(B0, 1, 0); PG8_SCHED; PG8_LDA(At, 1, 0); PG8_STAGE(PG8_SA(0, 1), a2 + hstep, voffA);
            PG8_WAIT_L(8); PG8_BAR; PG8_WAIT_L(0); PG8_MMA(0, 0, At, B0); PG8_BAR; PG8_SCHED;
            PG8_LDB(B1, 1, 1); PG8_STAGE(PG8_SB(1, 0), b3, voffB);
            PG8_BAR; PG8_WAIT_L(0); PG8_MMA(0, 1, At, B1); PG8_BAR;
            PG8_LDA(At, 1, 1); PG8_STAGE(PG8_SA(1, 0), a3, voffA);
            PG8_BAR; PG8_WAIT_L(0); PG8_MMA(1, 0, At, B0); PG8_BAR; PG8_SCHED;
            PG8_STAGE(PG8_SB(1, 1), b3 + hstepB, voffB);
            PG8_WAIT_V(6); PG8_BAR; PG8_MMA(1, 1, At, B1); PG8_BAR;
            }
        }
        if constexpr (ALIGN_EPI) { if (wr == 0) PG8_BAR; }
        if constexpr (!Epi::AFTER_DRAIN) { E(acc, cur, wr, wc, fr, fq); S.done(cur); }
        if (!has_next) break;
#pragma unroll
        for (int a = 0; a < 2; ++a)
#pragma unroll
            for (int b = 0; b < 2; ++b)
#pragma unroll
                for (int m = 0; m < 4; ++m)
#pragma unroll
                    for (int n = 0; n < 2; ++n) acc[a][b][m][n] = (f32x4){0.f, 0.f, 0.f, 0.f};
        cur = nxt; cA = nA; cB = nB; ++ui;
        if constexpr (ALIGN_EPI) { if (wr == 1) PG8_BAR; }
    }
    PG8_WAIT_V(0);
    if constexpr (!ALIGN_EPI) { if (wr == 0) PG8_BAR; }
    PG8_BAR;
    if constexpr (Epi::AFTER_DRAIN) { E.fused(acc, cur, wr, wc, fr, fq, lds, wid, lane); S.done(cur); }
#undef PG8_SA
#undef PG8_SB
#undef PG8_STAGE
#undef PG8_LDA
#undef PG8_LDB
#undef PG8_MMA
#undef PG8_WAIT_V
#undef PG8_WAIT_L
#undef PG8_BAR
#undef PG8_SCHED
}
}
constexpr int NWAVES = 8;
constexpr int BATCH = 16, SEQ = 2048, DM = 1024, DEPTH = 4, DFF = 4096;
constexpr int M = BATCH * SEQ;
constexpr int DIN = 2824;
constexpr int ZP = 3072;
constexpr int ZC_RW_R = 0, ZC_RW_K = 256, ZC_RW_V = 512, ZC_RW_DW = 768;
constexpr int ZC_GD_Q = 1024, ZC_GD_K = 1280, ZC_GD_V = 1536, ZC_GD_G = 1792;
constexpr int ZC_AT_Q = 2048, ZC_AT_K = 2560, ZC_AT_V = 2688;
constexpr int ZC_GD_B = 2816, ZC_GD_A = 2820;
__host__ __device__ __forceinline__ int win_src_col(int n) {
    if (n < 2048) return n;
    if (n < 2816) return n + 8;
    if (n < 2824) return n - 2816 + 2048;
    return -1;
}
constexpr size_t MiB = 1u << 20;
constexpr size_t WS_CTL = 0, CTL_ZERO_BYTES = 1 * MiB;
constexpr size_t WS_WIN = 1 * MiB;
constexpr size_t WS_WOUT = WS_WIN + (size_t)DEPTH * ZP * DM * 2;
constexpr size_t WS_W1 = WS_WOUT + (size_t)DEPTH * DM * DM * 2;
constexpr size_t WS_W2 = WS_W1 + (size_t)DEPTH * DFF * DM * 2;
constexpr size_t WS_XN = WS_W2 + (size_t)DEPTH * DM * DFF * 2;
constexpr size_t WS_Z = WS_XN + (size_t)M * DM * 2;
constexpr size_t WS_Y = WS_Z + (size_t)M * ZP * 2;
constexpr size_t WS_H = WS_Z;
constexpr size_t WS_HB = WS_Y + (size_t)M * DM * 2;
constexpr size_t WS_RSS = WS_HB + (size_t)256 * 8 * 24576;
constexpr size_t WS_XS = WS_RSS + (size_t)2 * DEPTH * M * 16 * 4;
constexpr size_t WS_LRW = WS_XS + (size_t)128 * 16384;
constexpr size_t LRW_IMG = 36864;
constexpr size_t WS_END = WS_LRW + (size_t)DEPTH * 4 * LRW_IMG;
static_assert(WS_H + (size_t)M * DFF * 2 <= WS_HB, "H overlay");
static_assert(WS_END <= 512 * MiB, "d_ws map");
constexpr int CW_TMO = 8192, CW_SEQ = 16384;
constexpr int CW_CLS = 1024;
constexpr int CW_BAR = 4096;
constexpr int RING_OFF = 0, RING_BYTES = 131072;
constexpr int LDSCTL_OFF = 158720, MISC_OFF = LDSCTL_OFF + 320;
constexpr int BIAS_OFF = LDSCTL_OFF + 1024;
constexpr int LDS_BYTES = 163840;
static_assert(BIAS_OFF + 4096 <= LDS_BYTES, "LDS map");

#define GAS __attribute__((address_space(1)))
#define LAS __attribute__((address_space(3)))
typedef unsigned short bf16;
typedef unsigned v4u __attribute__((ext_vector_type(4)));
typedef unsigned v2u __attribute__((ext_vector_type(2)));
typedef float f32x4 __attribute__((ext_vector_type(4)));
typedef GAS unsigned gu32;
#define RLX_AGENT __ATOMIC_RELAXED, __HIP_MEMORY_SCOPE_AGENT
#define LDS_WAIT() asm volatile("s_waitcnt lgkmcnt(0)" ::: "memory")
#define VM_WAIT() asm volatile("s_waitcnt vmcnt(0)" ::: "memory")
__device__ __forceinline__ int hw_lane() { return hwl_(); }
__device__ __forceinline__ unsigned f2bf(float f) { unsigned u = __builtin_bit_cast(unsigned, f); return (u + 0x7fffu + ((u >> 16) & 1u)) >> 16; }
__device__ __forceinline__ unsigned pk2(float lo, float hi) { return f2bf(lo) | (f2bf(hi) << 16); }
__device__ __forceinline__ float bf2f(unsigned short h) { return __builtin_bit_cast(float, (unsigned)h << 16); }
__device__ __forceinline__ float bflo(unsigned u) { return __builtin_bit_cast(float, u << 16); }
__device__ __forceinline__ float bfhi(unsigned u) { return __builtin_bit_cast(float, u & 0xffff0000u); }
__device__ __forceinline__ float sigmoidf_(float x) { return 1.f / (1.f + __expf(-x)); }
__device__ __forceinline__ float softplusf_(float x) { return fmaxf(x, 0.f) + log1pf(__expf(-fabsf(x))); }
__device__ __forceinline__ float dppf(float v, const int ctrl_sel) {
    int r;
    const int s = __builtin_bit_cast(int, v);
    if (ctrl_sel == 0) r = __builtin_amdgcn_update_dpp(0, s, 0xB1, 0xF, 0xF, true);
    else if (ctrl_sel == 1) r = __builtin_amdgcn_update_dpp(0, s, 0x4E, 0xF, 0xF, true);
    else if (ctrl_sel == 2) r = __builtin_amdgcn_update_dpp(0, s, 0x141, 0xF, 0xF, true);
    else r = __builtin_amdgcn_update_dpp(0, s, 0x140, 0xF, 0xF, true);
    return __builtin_bit_cast(float, r);
}
__device__ __forceinline__ float wave_allsum(float v) {
    v += dppf(v, 0); v += dppf(v, 1); v += dppf(v, 2); v += dppf(v, 3);
    const float a = __builtin_bit_cast(float, __builtin_amdgcn_readlane(__builtin_bit_cast(int, v), 0));
    const float b = __builtin_bit_cast(float, __builtin_amdgcn_readlane(__builtin_bit_cast(int, v), 16));
    const float c = __builtin_bit_cast(float, __builtin_amdgcn_readlane(__builtin_bit_cast(int, v), 32));
    const float d = __builtin_bit_cast(float, __builtin_amdgcn_readlane(__builtin_bit_cast(int, v), 48));
    return (a + b) + (c + d);
}
#define XB_TMO      128
#define XB_XCNT(j)  (256  + 64 * (j))
#define XB_XSUB(j)  (1280 + 64 * (j))
#define XB_XGEN(j)  (2304 + 64 * (j))
#define XB_TOP      3328
#define XB_TOPGEN   3392
#define XCD_BAR_WORDS 3456
#define XB_SPIN_CAP (1u << 18)

__device__ __forceinline__ unsigned xb_ld(unsigned* p)              { return __hip_atomic_load((GAS unsigned*)p, __ATOMIC_RELAXED, __HIP_MEMORY_SCOPE_AGENT); }
__device__ __forceinline__ unsigned xb_add(unsigned* p, unsigned v) { return __hip_atomic_fetch_add((GAS unsigned*)p, v, __ATOMIC_RELAXED, __HIP_MEMORY_SCOPE_AGENT); }
__device__ __forceinline__ unsigned xb_xcc_id() { return (unsigned)__builtin_amdgcn_s_getreg((3 << 11) | 20) & 0xFu; }
#define XB_SPIN(cond, bar) do { unsigned _sp = 0; while (cond) { __builtin_amdgcn_s_sleep(1); \
    if ((++_sp & 255u) == 0u) { if (xb_ld(&(bar)[XB_TMO])) break; if (_sp > XB_SPIN_CAP) { atomicAdd(&(bar)[XB_TMO], 1u); break; } } } } while (0)

struct XcdBarrier {
    unsigned* bar; unsigned x;
    volatile LAS unsigned* st;
};

__device__ __forceinline__ XcdBarrier xcd_barrier_post(unsigned* bar, volatile LAS unsigned* st, const bool t0  ) {
    XcdBarrier b; b.bar = bar; b.x = xb_xcc_id(); b.st = st;
    if (t0) (void)xb_add(&bar[XB_XCNT(b.x)], 1u);
    return b;
}
__device__ __forceinline__ void xcd_barrier_complete(unsigned* bar, unsigned x, unsigned& nloc, unsigned& nx) {
    const unsigned G = gridDim.x * gridDim.y * gridDim.z;
    unsigned sum, cnt, mine, sp = 0u;
    for (;;) {
        sum = 0u; cnt = 0u; mine = 0u;
#pragma unroll
        for (unsigned j = 0; j < 16; ++j) { const unsigned c = xb_ld(&bar[XB_XCNT(j)]); sum += c; cnt += (c > 0u) ? 1u : 0u; mine = (j == x) ? c : mine; }
        if (sum == G) break;
        __builtin_amdgcn_s_sleep(1);
        if ((++sp & 255u) == 0u) { if (xb_ld(&bar[XB_TMO])) break; if (sp > XB_SPIN_CAP) { atomicAdd(&bar[XB_TMO], 1u); break; } }
    }
    nloc = mine > 0u ? mine : 1u; nx = cnt > 0u ? cnt : 1u;
}

__device__ __forceinline__ void xcd_barrier(const XcdBarrier& b, const bool t0  , const bool local_data = false) {
    asm volatile("s_waitcnt vmcnt(0)" ::: "memory");
    __syncthreads();
    if (t0) {
        unsigned* bar = b.bar;
        __builtin_amdgcn_s_waitcnt(0);
        unsigned nloc = b.st[0], nx = b.st[1];
        if (nloc == 0u) { xcd_barrier_complete(bar, b.x, nloc, nx); b.st[0] = nloc; b.st[1] = nx; }
        const unsigned old = xb_add(&bar[XB_XSUB(b.x)], 1u);
        const unsigned gen = old / nloc;
        if (old + 1u == (gen + 1u) * nloc) {
            if (!local_data) __builtin_amdgcn_fence(__ATOMIC_RELEASE, "agent");
            asm volatile("s_waitcnt vmcnt(0)" ::: "memory");
            if (!local_data) {
            const unsigned og = xb_add(&bar[XB_TOP], 1u);
            const unsigned tg = og / nx;
            if (og + 1u == (tg + 1u) * nx) xb_add(&bar[XB_TOPGEN], 1u);
            else XB_SPIN(xb_ld(&bar[XB_TOPGEN]) == tg, bar);
            }
            __builtin_amdgcn_fence(__ATOMIC_ACQUIRE, "agent");
            xb_add(&bar[XB_XGEN(b.x)], 1u);
            asm volatile("s_waitcnt vmcnt(0)" ::: "memory");
        } else {
            XB_SPIN(xb_ld(&bar[XB_XGEN(b.x)]) == gen, bar);
            __builtin_amdgcn_fence(__ATOMIC_ACQUIRE, "agent");
            asm volatile("s_waitcnt vmcnt(0)" ::: "memory");
        }
    }
    __syncthreads();
}
struct Frame {
    LAS unsigned char* lds;
    int wave;
    int vcu, G;
    unsigned char* ws;
    float* out;
};
typedef const float* cfp;
typedef const __attribute__((address_space(4))) cfp* karg_tab;
__device__ __forceinline__ karg_tab ktab() { karg_tab t = (karg_tab)__builtin_amdgcn_kernarg_segment_ptr(); asm volatile("" : "+s"(t)); return t; }
#define INP(i) (ktab()[i])
__device__ __forceinline__ int ltid() { return hw_lane(); }
__device__ __forceinline__ unsigned char* lnd(unsigned char* p) { asm volatile("" : "+s"(p)); return p; }
#define WSP(off) (lnd(F.ws) + (off))
#define FZ ((bf16*)WSP(WS_Z))
#define FY ((bf16*)(WSP(WS_Z) + SLAB_Y_OFF))
constexpr size_t SLAB_BYTES = (size_t)32 * 1024 * 1024, SLAB_Y_OFF = (size_t)24 * 1024 * 1024;
#define FXN ((bf16*)WSP(WS_XN))
#define FH ((bf16*)WSP(WS_H))
enum { I_X = 0, I_LN1 = 1, I_WIN = 2, I_MU = 3, I_W0 = 4, I_WUP = 5, I_A0 = 6, I_AUP = 7, I_GUP = 8, I_KK = 9, I_KA = 10, I_RK = 11, I_LNXW = 12, I_LNXB = 13,
       I_CONV = 14, I_ALOG = 15, I_DTB = 16, I_GNW = 17, I_QNW = 18, I_KNW = 19, I_SINK = 20, I_RELB = 21, I_WOUT = 22, I_LN2 = 23, I_WFF1 = 24, I_WFF2 = 25 };

template <bool MAP>
__device__ __forceinline__ void p0_transpose_item(const float* W, int K, int Nsrc, int Ndst, bf16* WT, LAS float* scr, int item, int lane, const float* kscale = nullptr) {
    const int nblk = Ndst / 64, kb = item / nblk, nb = item % nblk, k0 = 64 * kb, n0 = 64 * nb;
    const int c4 = lane & 15, r = lane >> 4;
    const int nn = n0 + 4 * c4; const int src = MAP ? win_src_col(nn) : nn;
#pragma unroll 8
    for (int i = 0; i < 16; ++i) { const int kk = 4 * i + r;
        f32x4 v = {0.f, 0.f, 0.f, 0.f}; if (src >= 0) v = *(const GAS f32x4*)(W + (size_t)(k0 + kk) * Nsrc + src);
        const float sc = kscale ? kscale[k0 + kk] : 1.f;
        LAS float* d = scr + kk * 65 + 4 * c4; d[0] = v.x * sc; d[1] = v.y * sc; d[2] = v.z * sc; d[3] = v.w * sc; }
    LDS_WAIT(); asm volatile("" ::: "memory");
    const int c = lane & 7;
#pragma unroll
    for (int j = 0; j < 8; ++j) { const int n = (lane >> 3) + 8 * j; const LAS float* s = scr + (8 * c) * 65 + n;
        v4u o; o.x = pg8::cvt_pk_bf16(s[0 * 65], s[1 * 65]); o.y = pg8::cvt_pk_bf16(s[2 * 65], s[3 * 65]); o.z = pg8::cvt_pk_bf16(s[4 * 65], s[5 * 65]); o.w = pg8::cvt_pk_bf16(s[6 * 65], s[7 * 65]);
        const int nn_ = n0 + n, rb = nn_ & 127, v5 = rb & 31, R = (rb & ~31) + (((v5 >> 2) & 1) * 16 + ((v5 >> 3) << 2) + (v5 & 3));
        *(GAS v4u*)((GAS unsigned char*)WT + ((size_t)((nn_ >> 8) * (K / 64) + (k0 >> 6)) * 2 + ((nn_ >> 7) & 1)) * 16384 + pg8::lds_byte(R, 8 * c)) = o; }
    LDS_WAIT(); asm volatile("" ::: "memory");
}
__device__ __forceinline__ void cast_rows(Frame& F, const float* x, bf16* xn, float* rss) {
    const int lane = ltid() & 63;
    const int gw = F.vcu * NWAVES + F.wave, NGW = F.G * NWAVES;
    f32x4 nx[4];
    if (gw < M) { const GAS f32x4* xr = (const GAS f32x4*)(x + (size_t)gw * DM) + lane;
#pragma unroll
        for (int j = 0; j < 4; ++j) nx[j] = xr[64 * j]; }
    for (int m = gw; m < M; m += NGW) {
        f32x4 v[4]; float s = 0.f;
#pragma unroll
        for (int j = 0; j < 4; ++j) v[j] = nx[j];
        if (m + NGW < M) { const GAS f32x4* xr = (const GAS f32x4*)(x + (size_t)(m + NGW) * DM) + lane;
#pragma unroll
            for (int j = 0; j < 4; ++j) nx[j] = xr[64 * j]; }
#pragma unroll
        for (int j = 0; j < 4; ++j) s += (v[j].x * v[j].x + v[j].y * v[j].y) + (v[j].z * v[j].z + v[j].w * v[j].w);
        s = wave_allsum(s);
        if (lane < 16) rss[(size_t)m * 16 + lane] = (lane == 0) ? s : 0.f;
#pragma unroll
        for (int j = 0; j < 4; ++j) *(GAS unsigned long long*)((GAS unsigned char*)xn + pg8::tiled_byte(m, 4 * lane + 256 * j, DM / 64)) = (unsigned long long)pg8::cvt_pk_bf16(v[j].x, v[j].y) | ((unsigned long long)pg8::cvt_pk_bf16(v[j].z, v[j].w) << 32);
    }
}
__device__ __forceinline__ int lrw_slot(int ch) { return 16 * (2 * (ch >> 5) + ((ch >> 2) & 1)) + 4 * ((ch >> 3) & 3) + (ch & 3); }
__device__ __forceinline__ void p0_prologue(Frame& F) {
    const int lane_ = ltid() & 63;
    LAS float* scr = (LAS float*)(F.lds + RING_OFF + F.wave * 16640);
    const int gw = F.vcu * NWAVES + F.wave, NGW = F.G * NWAVES;
    constexpr int I_IN = (DM / 64) * (ZP / 64), I_O = (DM / 64) * (DM / 64), I_1 = (DM / 64) * (DFF / 64), I_2 = (DFF / 64) * (DM / 64);
    constexpr int PER_L = I_IN + I_O + I_1 + I_2, NITEMS = DEPTH * PER_L;
    for (int it = gw; it < NITEMS; it += NGW) {
        const int l = it / PER_L; int r = it % PER_L;
        if (r < I_IN) { p0_transpose_item<true>(INP(I_WIN) + (size_t)l * DM * DIN, DM, DIN, ZP, ((bf16*)WSP(WS_WIN)) + (size_t)l * ZP * DM, scr, r, lane_, INP(I_LN1) + (size_t)l * DM); continue; } r -= I_IN;
        if (r < I_O) { p0_transpose_item<false>(INP(I_WOUT) + (size_t)l * DM * DM, DM, DM, DM, ((bf16*)WSP(WS_WOUT)) + (size_t)l * DM * DM, scr, r, lane_); continue; } r -= I_O;
        if (r < I_1) { p0_transpose_item<false>(INP(I_WFF1) + (size_t)l * DM * DFF, DM, DFF, DFF, ((bf16*)WSP(WS_W1)) + (size_t)l * DFF * DM, scr, r, lane_, INP(I_LN2) + (size_t)l * DM); continue; } r -= I_1;
        p0_transpose_item<false>(INP(I_WFF2) + (size_t)l * DFF * DM, DFF, DM, DM, ((bf16*)WSP(WS_W2)) + (size_t)l * DM * DFF, scr, r, lane_);
    }
    {
        for (int e = gw * 64 + lane_; e < DEPTH * 4 * 16384; e += NGW * 64) {
            const int im = e >> 14, r = e & 16383, l = im >> 2, h = im & 3;
            GAS unsigned char* img = (GAS unsigned char*)WSP(WS_LRW) + (size_t)im * LRW_IMG;
            if (r < 8192) { const int wa = r >> 12, q = r & 4095, ch = q & 63, k = q >> 6;
                const float v = (wa ? INP(I_AUP) : INP(I_WUP))[(size_t)l * 64 * 256 + k * 256 + 64 * h + ch];
                *(GAS unsigned short*)(img + wa * 9216 + lrw_slot(ch) * 144 + k * 2) = (unsigned short)f2bf(v); }
            else { const int q = r - 8192, ch = q & 63, k = q >> 6;
                const float v = INP(I_GUP)[(size_t)l * 128 * 256 + k * 256 + 64 * h + ch];
                *(GAS unsigned short*)(img + 18432 + lrw_slot(ch) * 272 + k * 2) = (unsigned short)f2bf(v); }
        }
    }
    cast_rows(F, INP(I_X), FXN, (float*)WSP(WS_RSS));
}

#define MX_DEV __device__ __forceinline__
#define MX_G __attribute__((address_space(1)))
#define MX_L __attribute__((address_space(3)))
#define MX_EXP(x) __expf(x)
#define MX_LOG1P(x) log1pf(x)
#define MXIN(i) ((const MX_G float*)INP(i))
#define MX_VMWAIT() asm volatile("s_waitcnt vmcnt(0)" ::: "memory")
#define MX_LDSWAIT() asm volatile("s_waitcnt lgkmcnt(0)" ::: "memory")
#define MX_SCHED() __builtin_amdgcn_sched_barrier(0)
#define MX_LAUNDER_S(p) asm volatile("" : "+s"(p))
#define MX_LAUNDER_V(p) asm volatile("" : "+v"(p))
#define MX_CONSUME(x) asm volatile("" :: "v"(x))
#define MX_LRW_DMA(src, dst) __builtin_amdgcn_global_load_lds((const MX_G unsigned*)(src), (MX_L unsigned*)(dst), 16, 0, 0)
#define MX_FMAC(acc, a, b) asm("v_fmac_f32_e32 %0, %1, %2" : "+v"(acc) : "v"(a), "v"(b))
#define MX_RCP(x) __builtin_amdgcn_rcpf(x)
#define MX_RSQ(x) __builtin_amdgcn_rsqf(x)
#define MX_LOG(x) __logf(x)
typedef __bf16 mx_bf2_t __attribute__((ext_vector_type(2)));
typedef float mx_f2_t __attribute__((ext_vector_type(2)));
__device__ __forceinline__ unsigned mx_hwpk2(float lo, float hi) { mx_f2_t v = {lo, hi}; return __builtin_bit_cast(unsigned, __builtin_convertvector(v, mx_bf2_t)); }
#define MX_PK2(lo, hi) mx_hwpk2(lo, hi)
#define MX_UNIFORM(x) __builtin_amdgcn_readfirstlane(x)
#define MX_ROW_SHR(v, d) __builtin_bit_cast(float, __builtin_amdgcn_update_dpp(0, __builtin_bit_cast(int, (v)), 0x110 + (d), 0xF, 0xF, true))
#define MX_ROW_SHRU(v, d) ((unsigned)__builtin_amdgcn_update_dpp(0, (int)(v), 0x110 + (d), 0xF, 0xF, true))
#define MX_ROW_RORU(v, d) ((unsigned)__builtin_amdgcn_update_dpp(0, (int)(v), 0x120 + (d), 0xF, 0xF, true))
#define MX_ROW_LAST(v) __builtin_bit_cast(float, __builtin_amdgcn_update_dpp(0, __builtin_bit_cast(int, (v)), 0x15F, 0xF, 0xF, true))
#define MX_ROW_SHR(v, d) __builtin_bit_cast(float, __builtin_amdgcn_update_dpp(0, __builtin_bit_cast(int, (v)), 0x110 + (d), 0xF, 0xF, true))
#define MX_ROW_LAST(v) __builtin_bit_cast(float, __builtin_amdgcn_update_dpp(0, __builtin_bit_cast(int, (v)), 0x15F, 0xF, 0xF, true))
typedef unsigned mx_u2_t __attribute__((ext_vector_type(2)));
__device__ __forceinline__ float mx_hw_rowsum4(float v) {
    const mx_u2_t a = __builtin_amdgcn_permlane16_swap(__builtin_bit_cast(unsigned, v), __builtin_bit_cast(unsigned, v), false, false);
    const float s = __builtin_bit_cast(float, a.x) + __builtin_bit_cast(float, a.y);
    const mx_u2_t b = __builtin_amdgcn_permlane32_swap(__builtin_bit_cast(unsigned, s), __builtin_bit_cast(unsigned, s), false, false);
    return __builtin_bit_cast(float, b.x) + __builtin_bit_cast(float, b.y);
}
#define MX_ROWSUM4(v) mx_hw_rowsum4(v)
#define MX_FLAG_LOAD(p) __hip_atomic_load((p), __ATOMIC_RELAXED, __HIP_MEMORY_SCOPE_AGENT)
#define MX_FLAG_STORE(p, v) __hip_atomic_store((p), (v), __ATOMIC_RELAXED, __HIP_MEMORY_SCOPE_AGENT)
#define MX_FLAG_ADD(p, v) __hip_atomic_fetch_add((p), (v), __ATOMIC_RELAXED, __HIP_MEMORY_SCOPE_AGENT)
#define MX_SLEEP() __builtin_amdgcn_s_sleep(2)
#define MX_SC1_LOAD64(p) __hip_atomic_load((p), __ATOMIC_RELAXED, __HIP_MEMORY_SCOPE_AGENT)
#define MX_SC1_STORE64(p, v) __hip_atomic_store((p), (v), __ATOMIC_RELAXED, __HIP_MEMORY_SCOPE_AGENT)
__device__ __forceinline__ int mx_lane() { return ltid() & 63; }
__device__ __forceinline__ void mx_wgsync() { __syncthreads(); }
__device__ __forceinline__ float mx_shfl_xor(float v, int m) { return m == 16 ? xor16f(v) : xor32f(v); }
__device__ __forceinline__ float mx_shfl16l(float v, int src, int lane) { return __builtin_bit_cast(float, __builtin_amdgcn_ds_bpermute(((lane & 48) | src) << 2, __builtin_bit_cast(int, v))); }
typedef short mx_bf16x8_t __attribute__((ext_vector_type(8)));
typedef float mx_f32x4_t __attribute__((ext_vector_type(4)));
__device__ __forceinline__ mx_f32x4_t mx_mfma(mx_bf16x8_t a, mx_bf16x8_t b, mx_f32x4_t c) { return __builtin_amdgcn_mfma_f32_16x16x32_bf16(a, b, c, 0, 0, 0); }
typedef short mx_s16x4_t __attribute__((ext_vector_type(4)));
#define MX_MFMA16(a, b, c) __builtin_amdgcn_mfma_f32_16x16x16bf16_1k(__builtin_bit_cast(mx_s16x4_t, a), __builtin_bit_cast(mx_s16x4_t, b), c, 0, 0, 0)
typedef short mx_bf16x8 __attribute__((ext_vector_type(8)));
typedef float mx_f32x4 __attribute__((ext_vector_type(4)));
typedef unsigned mx_u32x4 __attribute__((ext_vector_type(4)));
typedef unsigned mx_u32x2 __attribute__((ext_vector_type(2)));

MX_DEV unsigned mx_bf(float f) { unsigned u = __builtin_bit_cast(unsigned, f); return (u + 0x7fffu + ((u >> 16) & 1u)) >> 16; }
MX_DEV unsigned mx_pk2(float lo, float hi) { return MX_PK2(lo, hi); }
MX_DEV float mx_lo(unsigned u) { return __builtin_bit_cast(float, u << 16); }
MX_DEV float mx_hi(unsigned u) { return __builtin_bit_cast(float, u & 0xffff0000u); }
MX_DEV mx_bf16x8 mx_frag8(const float* a, const float* b) {
    mx_u32x4 w; w.x = mx_pk2(a[0], a[1]); w.y = mx_pk2(a[2], a[3]); w.z = mx_pk2(b[0], b[1]); w.w = mx_pk2(b[2], b[3]); return __builtin_bit_cast(mx_bf16x8, w); }
MX_DEV mx_bf16x8 mx_frag8v(mx_f32x4 a, mx_f32x4 b) {
    mx_u32x4 w; w.x = mx_pk2(a.x, a.y); w.y = mx_pk2(a.z, a.w); w.z = mx_pk2(b.x, b.y); w.w = mx_pk2(b.z, b.w); return __builtin_bit_cast(mx_bf16x8, w); }
MX_DEV mx_u32x2 mx_frag4(mx_f32x4 a) { mx_u32x2 w; w.x = mx_pk2(a.x, a.y); w.y = mx_pk2(a.z, a.w); return w; }
MX_DEV mx_f32x4 mx_mfma(mx_u32x2 a, mx_u32x2 b, mx_f32x4 c) { return MX_MFMA16(a, b, c); }
typedef unsigned long long mx_u64x2 __attribute__((ext_vector_type(2)));
MX_DEV mx_u32x2 mx_frag4p(mx_u32x2 p) { return p; }
MX_DEV mx_u32x2 mx_pack4(mx_f32x4 a) { mx_u32x2 p; p.x = mx_pk2(a.x, a.y); p.y = mx_pk2(a.z, a.w); return p; }
MX_DEV mx_f32x4 mx_zero4() { mx_f32x4 z = {0.f, 0.f, 0.f, 0.f}; return z; }
MX_DEV float mx_sigmoid(float x) { return MX_RCP(1.f + MX_EXP(-x)); }
MX_DEV float mx_softplus(float x) { return fmaxf(x, 0.f) + MX_LOG(1.f + MX_EXP(-fabsf(x))); }
MX_DEV float mx_rowsum4(float v) { v += mx_shfl_xor(v, 16); v += mx_shfl_xor(v, 32); return v; }

constexpr int MX_HB_WA = 0, MX_HB_RT = 2048, MX_HB_ARB = 4096, MX_HB_ARK = 4608, MX_HB_BH = 5120, MX_HB_KH = 7168, MX_HB_VC = 9216, MX_HB_U0 = 11264, MX_HB_GAM = 13312, MX_HB_SLOT = 13568;
constexpr int MX_GB_GT = 0, MX_GB_EE = 2048, MX_GB_SLOT = 4096;
constexpr int MX_LDS_HB = 0, MX_LDS_WW = 108544, MX_LDS_WA = 117760, MX_LDS_WG = 126976, MX_LDS_PAR = 144384, MX_LDS_ST = 148480, MX_LDS_GAM = 152576  , MX_LDS_END = 156672, MX_RS64 = 144, MX_RS128 = 272;
constexpr int MX_P_MUR = 256, MX_P_MUK = 320, MX_P_MUV = 384, MX_P_W0 = 448, MX_P_A0 = 512, MX_P_KK = 576, MX_P_KA = 640, MX_P_RK = 704, MX_P_LNW = 768, MX_P_LNB = 832, MX_P_GNW = 768;

constexpr int MX_YS_PAR = 32768;
struct MxFin { bool on; int type; int wv  ; MX_G unsigned short* yb  ; int t0  , col0  ; const MX_G unsigned char* gbp; const MX_G unsigned char* ysp;
               const MX_G unsigned short* pf  ; int pfh; };
MX_DEV unsigned mx_zoff(int t, int col) { return (unsigned)(((t >> 4) * (ZP / 64) + (col >> 6)) * 1024 + ((col >> 5) & 1) * 512 + (t & 15) * 32 + (col & 31)); }
MX_DEV unsigned mx_yoff(int t, int col) { const int r = t & 127, c = col & 63, ob = (r & 15) * 64 + (c & 31) * 2;
    return (unsigned)((((t >> 8) * (DM / 64) + (col >> 6)) * 2 + ((t >> 7) & 1)) * 8192 + ((((r >> 4) * 2 + (c >> 5)) * 1024 + (ob ^ (((ob >> 9) & 1) << 5))) >> 1)); }
MX_DEV int mx_ch_off(int ct, int g);
MX_DEV void mx_finalize(const MxFin& f, int lane) {
    const int tk = lane & 15, g = lane >> 4;
#pragma unroll
    for (int cc = 0; cc < 2; ++cc) {
        const int c = 2 * f.wv + cc;
        mx_f32x4 y[4]; mx_u32x2 gt[4], ee[4];
#pragma unroll
        for (int q = 0; q < 4; ++q) {
            y[q] = *(const MX_G mx_f32x4*)(f.ysp + (unsigned)(((c * 4 + q) * 64 + lane) * 16));
            const MX_G unsigned char* sl = f.gbp + c * MX_GB_SLOT;
            if ((q & 1) == 0) { const mx_u32x4 g4 = *(const MX_G mx_u32x4*)(sl + (unsigned)(MX_GB_GT + (q >> 1) * 1024 + lane * 16)), e4 = f.type == 0 ? *(const MX_G mx_u32x4*)(sl + (unsigned)(MX_GB_EE + (q >> 1) * 1024 + lane * 16)) : mx_u32x4{0u, 0u, 0u, 0u};
                gt[q].x = g4.x; gt[q].y = g4.y; gt[q + 1].x = g4.z; gt[q + 1].y = g4.w; ee[q].x = e4.x; ee[q].y = e4.y; ee[q + 1].x = e4.z; ee[q + 1].y = e4.w; } }
        float s1 = 0.f, s2 = 0.f;
#pragma unroll
        for (int q = 0; q < 4; ++q) { s1 += (y[q].x + y[q].y) + (y[q].z + y[q].w); s2 += (y[q].x * y[q].x + y[q].y * y[q].y) + (y[q].z * y[q].z + y[q].w * y[q].w); }
        s1 = mx_rowsum4(s1); s2 = mx_rowsum4(s2);
        float mean, rstd;
        if (f.type == 0) { mean = s1 * (1.f / 64.f); const float var = fmaxf(s2 * (1.f / 64.f) - mean * mean, 0.f); rstd = MX_RSQ(var + 64e-5f); }
        else { mean = 0.f; rstd = MX_RSQ(s2 * (1.f / 64.f) + 1e-6f); }
        mx_u32x2 ov[4];
#pragma unroll
        for (int q = 0; q < 4; ++q) {
            const float o0 = (y[q].x - mean) * rstd * mx_lo(gt[q].x) + mx_lo(ee[q].x), o1 = (y[q].y - mean) * rstd * mx_hi(gt[q].x) + mx_hi(ee[q].x);
            const float o2 = (y[q].z - mean) * rstd * mx_lo(gt[q].y) + mx_lo(ee[q].y), o3 = (y[q].w - mean) * rstd * mx_hi(gt[q].y) + mx_hi(ee[q].y);
            ov[q].x = mx_pk2(o0, o1); ov[q].y = mx_pk2(o2, o3);
        }
#pragma unroll
        for (int qp = 0; qp < 2; ++qp) {
            mx_u32x4 o; o.x = ov[2 * qp].x; o.y = ov[2 * qp].y; o.z = ov[2 * qp + 1].x; o.w = ov[2 * qp + 1].y;
            *(MX_G mx_u32x4*)(f.yb + mx_yoff(f.t0 + 16 * c + tk, f.col0 + mx_ch_off(2 * qp, g))) = o;
        }
    }
}
MX_DEV void mx_prep_back(float (&lw)[16], float (&a)[16], float (&b)[16], float (&k2)[16], float (&r)[16], float (&v)[16], MX_L unsigned char* slot, MX_L unsigned char* gamp  , bool midbar, const MxFin& fin, int lane) {
    const int tk = lane & 15, g = lane >> 4;
    float G[16];
#pragma unroll
    for (int i = 0; i < 16; ++i) G[i] = lw[i];
#pragma unroll
    for (int i = 0; i < 16; ++i) { G[i] += MX_ROW_SHR(G[i], 1); G[i] += MX_ROW_SHR(G[i], 2); G[i] += MX_ROW_SHR(G[i], 4); G[i] += MX_ROW_SHR(G[i], 8); }
    MX_SCHED();
    mx_bf16x8 AtF[2], BtF[2], KtF[2], RtF[2], BhF[2], KhF[2], VF[2];
    float E1[16], E2[16];
#pragma unroll
    for (int i = 0; i < 16; ++i) { E1[i] = MX_EXP(-G[i]); E2[i] = MX_RCP(E1[i]); }
    MX_SCHED();
    {
        float x[16];
#pragma unroll
        for (int i = 0; i < 16; ++i) { const float ep = MX_ROW_SHR(E2[i], 1); x[i] = a[i] * (tk ? ep : 1.f); }
        AtF[0] = mx_frag8(x, x + 4); AtF[1] = mx_frag8(x + 8, x + 12);
    }
    MX_SCHED();
    {
        float x[16];
#pragma unroll
        for (int i = 0; i < 16; ++i) { x[i] = r[i] * E2[i]; }
        RtF[0] = mx_frag8(x, x + 4); RtF[1] = mx_frag8(x + 8, x + 12);
        VF[0] = mx_frag8(v, v + 4); VF[1] = mx_frag8(v + 8, v + 12);
    }
    MX_SCHED();
    {
        float x[16], y[16];
#pragma unroll
        for (int i = 0; i < 16; ++i) { x[i] = b[i] * E1[i]; y[i] = k2[i] * E1[i]; }
        BtF[0] = mx_frag8(x, x + 4); BtF[1] = mx_frag8(x + 8, x + 12); KtF[0] = mx_frag8(y, y + 4); KtF[1] = mx_frag8(y + 8, y + 12);
    }
    MX_SCHED();
    {
        float x[16], y[16], gam[16];
#pragma unroll
        for (int i = 0; i < 16; ++i) { gam[i] = MX_ROW_LAST(E2[i]); const float e = gam[i] * E1[i]; x[i] = b[i] * e; y[i] = k2[i] * e; }
        BhF[0] = mx_frag8(x, x + 4); BhF[1] = mx_frag8(x + 8, x + 12); KhF[0] = mx_frag8(y, y + 4); KhF[1] = mx_frag8(y + 8, y + 12);
        if (tk == 0) {
#pragma unroll
            for (int ct = 0; ct < 4; ++ct) { mx_f32x4 q = {gam[4 * ct], gam[4 * ct + 1], gam[4 * ct + 2], gam[4 * ct + 3]}; *(MX_L mx_f32x4*)(gamp + (unsigned)((16 * ct + 4 * g) * 4)) = q; } }
    }
    MX_SCHED();
    const mx_f32x4 z4 = mx_zero4();
    mx_f32x4 L = mx_mfma(BtF[1], AtF[1], mx_mfma(BtF[0], AtF[0], z4));
    mx_f32x4 LT = mx_mfma(AtF[1], BtF[1], mx_mfma(AtF[0], BtF[0], z4));
    mx_f32x4 Lak = mx_mfma(KtF[1], AtF[1], mx_mfma(KtF[0], AtF[0], z4));
    mx_f32x4 Arb = mx_mfma(BtF[1], RtF[1], mx_mfma(BtF[0], RtF[0], z4));
    mx_f32x4 Ark = mx_mfma(KtF[1], RtF[1], mx_mfma(KtF[0], RtF[0], z4));
#pragma unroll
    for (int e = 0; e < 4; ++e) { const int s = 4 * g + e;
        L[e] = (s < tk) ? L[e] : 0.f; LT[e] = (s > tk) ? LT[e] : 0.f; Lak[e] = (s < tk) ? Lak[e] : 0.f; Arb[e] = (s <= tk) ? Arb[e] : 0.f; Ark[e] = (s <= tk) ? Ark[e] : 0.f; }
    unsigned pfv = 0u;
    if (midbar) { MX_LDSWAIT(); mx_wgsync(); if (fin.on) mx_finalize(fin, lane);
        if (fin.pf) {
            if (fin.type == 0) { pfv = *(const MX_G unsigned*)(fin.pf + ZC_RW_DW + 64 * g); if (g < 3) pfv ^= *(const MX_G unsigned*)(fin.pf + (g == 0 ? ZC_RW_R : (g == 1 ? ZC_RW_K : ZC_RW_V)) + 64 * fin.pfh); }
            else { pfv = *(const MX_G unsigned*)(fin.pf + (g == 0 ? ZC_GD_Q : (g == 1 ? ZC_GD_K : (g == 2 ? ZC_GD_V : ZC_GD_G))) + 64 * fin.pfh); if (g == 0) pfv ^= *(const MX_G unsigned*)(fin.pf + ZC_GD_B); } }
        MX_SCHED(); }
    *(MX_L mx_bf16x8*)(slot + (unsigned)(MX_HB_RT + lane * 16)) = RtF[0]; *(MX_L mx_bf16x8*)(slot + (unsigned)(MX_HB_RT + 1024 + lane * 16)) = RtF[1];
    *(MX_L mx_u32x2*)(slot + (unsigned)(MX_HB_ARB + lane * 8)) = mx_pack4(Arb); *(MX_L mx_u32x2*)(slot + (unsigned)(MX_HB_ARK + lane * 8)) = mx_pack4(Ark);
    mx_f32x4 T = L;
#pragma unroll
    for (int e = 0; e < 4; ++e) T[e] += (4 * g + e == tk) ? 1.f : 0.f;
    {
        const mx_u32x2 fL = mx_frag4(L), fLT = mx_frag4(LT);
        const mx_f32x4 L2 = mx_mfma(fLT, fL, z4), L2T = mx_mfma(fL, fLT, z4);
        const mx_u32x2 fL2 = mx_frag4(L2), fL2T = mx_frag4(L2T);
        T = mx_mfma(fL2T, mx_frag4(T), T);
        const mx_f32x4 L4 = mx_mfma(fL2T, fL2, z4), L4T = mx_mfma(fL2, fL2T, z4);
        const mx_u32x2 fL4 = mx_frag4(L4), fL4T = mx_frag4(L4T);
        T = mx_mfma(fL4T, mx_frag4(T), T);
        const mx_f32x4 L8T = mx_mfma(fL4, fL4T, z4);
        T = mx_mfma(mx_frag4(L8T), mx_frag4(T), T);
    }
    const mx_u32x2 fT = mx_frag4(T), fLak = mx_frag4(Lak);
    mx_bf16x8 Sel[2];
#pragma unroll
    for (int p = 0; p < 2; ++p) { mx_u32x4 w = {0u, 0u, 0u, 0u};
        if ((tk >> 2) == g) { const unsigned one = (tk & 1) ? 0x3F800000u : 0x00003F80u; const int q = 2 * p + ((tk & 3) >> 1); w.x = (q == 0) ? one : 0u; w.y = (q == 1) ? one : 0u; w.z = (q == 2) ? one : 0u; w.w = (q == 3) ? one : 0u; }
        Sel[p] = __builtin_bit_cast(mx_bf16x8, w); }
#pragma unroll
    for (int ks = 0; ks < 2; ++ks) {
        mx_f32x4 w0 = mx_mfma(mx_frag4(mx_mfma(AtF[ks], Sel[0], z4)), fT, z4);
        mx_f32x4 w1 = mx_mfma(mx_frag4(mx_mfma(AtF[ks], Sel[1], z4)), fT, z4);
        *(MX_L mx_bf16x8*)(slot + (unsigned)(MX_HB_WA + ks * 1024 + lane * 16)) = mx_frag8v(w0, w1);
    }
#pragma unroll
    for (int ct = 0; ct < 4; ++ct) {
        const mx_f32x4 vc = mx_mfma(VF[ct >> 1], Sel[ct & 1], z4);
        const mx_u32x2 vp = mx_pack4(vc);
        *(MX_L mx_u32x2*)(slot + (unsigned)(MX_HB_VC + ct * 512 + lane * 8)) = vp;
        const mx_f32x4 X = mx_mfma(fLak, mx_frag4p(vp), z4);
        const mx_f32x4 U0 = mx_mfma(fT, mx_frag4(X), z4);
        *(MX_L mx_u32x2*)(slot + (unsigned)(MX_HB_U0 + ct * 512 + lane * 8)) = mx_pack4(U0);
        *(MX_L mx_u32x2*)(slot + (unsigned)(MX_HB_BH + ct * 512 + lane * 8)) = mx_pack4(mx_mfma(BhF[ct >> 1], Sel[ct & 1], z4));
        *(MX_L mx_u32x2*)(slot + (unsigned)(MX_HB_KH + ct * 512 + lane * 8)) = mx_pack4(mx_mfma(KhF[ct >> 1], Sel[ct & 1], z4));
    }
    MX_CONSUME(pfv);
}
MX_DEV int mx_ch_off(int ct, int g);
MX_DEV void mx_load_t16(const MX_G unsigned short* p, bool ok, int g, float (&x)[16]) {
#pragma unroll
    for (int ct = 0; ct < 4; ++ct) { mx_u32x2 w = {0u, 0u}; if (ok) w = *(const MX_G mx_u32x2*)(p + mx_ch_off(ct, g));
        x[4 * ct] = mx_lo(w.x); x[4 * ct + 1] = mx_hi(w.x); x[4 * ct + 2] = mx_lo(w.y); x[4 * ct + 3] = mx_hi(w.y); }
}
MX_DEV void mx_load_par(const MX_G float* p, int g, float (&x)[16]) {
#pragma unroll
    for (int ct = 0; ct < 4; ++ct) { const mx_f32x4 w = *(const MX_G mx_f32x4*)(p + mx_ch_off(ct, g)); x[4 * ct] = w.x; x[4 * ct + 1] = w.y; x[4 * ct + 2] = w.z; x[4 * ct + 3] = w.w; }
}
MX_DEV void mx_store_t16(MX_G unsigned char* p, int lane, const float (&x)[16]) {
#pragma unroll
    for (int cp = 0; cp < 2; ++cp) { mx_u32x4 w; w.x = mx_pk2(x[8 * cp], x[8 * cp + 1]); w.y = mx_pk2(x[8 * cp + 2], x[8 * cp + 3]); w.z = mx_pk2(x[8 * cp + 4], x[8 * cp + 5]); w.w = mx_pk2(x[8 * cp + 6], x[8 * cp + 7]); *(MX_G mx_u32x4*)(p + cp * 1024 + lane * 16) = w; }
}

MX_DEV int mx_ch_off(int ct, int g) { return 32 * (ct >> 1) + 8 * g + 4 * (ct & 1); }
MX_DEV int mx_slot_of_ch(int ch) { return 16 * (2 * (ch >> 5) + ((ch >> 2) & 1)) + 4 * ((ch >> 3) & 3) + (ch & 3); }
static_assert(MX_LDS_WA - MX_LDS_WW == 9216 && MX_LDS_WG - MX_LDS_WW == 18432 && MX_RS64 == 144 && MX_RS128 == 272 && MX_LDS_PAR - MX_LDS_WW <= 36864 && MX_LDS_WG + 64 * MX_RS128 - MX_LDS_WW == 35840, "the prologue's low-rank weight images (WS_LRW) assume this LDS map");
MX_DEV void mx_load_parL(const MX_L float* p, int g, float (&x)[16]) {
#pragma unroll
    for (int ct = 0; ct < 4; ++ct) { const mx_f32x4 w = *(const MX_L mx_f32x4*)(p + mx_ch_off(ct, g)); x[4 * ct] = w.x; x[4 * ct + 1] = w.y; x[4 * ct + 2] = w.z; x[4 * ct + 3] = w.w; }
}
struct MxRaw16 { mx_u32x2 w[4]; };
MX_DEV MxRaw16 mx_raw_t16(const MX_G unsigned short* zseq, int t, int col, bool ok, int g) { MxRaw16 r;
    mx_u32x4 a = {0u, 0u, 0u, 0u}, b = {0u, 0u, 0u, 0u};
    if (ok) { a = *(const MX_G mx_u32x4*)(zseq + mx_zoff(t, col + 8 * g)); b = *(const MX_G mx_u32x4*)(zseq + mx_zoff(t, col + 32 + 8 * g)); }
    r.w[0].x = a.x; r.w[0].y = a.y; r.w[1].x = a.z; r.w[1].y = a.w; r.w[2].x = b.x; r.w[2].y = b.y; r.w[3].x = b.z; r.w[3].y = b.w;
    return r; }
MX_DEV void mx_unpack16(const MxRaw16& r, float (&x)[16]) {
#pragma unroll
    for (int ct = 0; ct < 4; ++ct) { x[4 * ct] = mx_lo(r.w[ct].x); x[4 * ct + 1] = mx_hi(r.w[ct].x); x[4 * ct + 2] = mx_lo(r.w[ct].y); x[4 * ct + 3] = mx_hi(r.w[ct].y); }
}
MX_DEV unsigned mx_shr_u(unsigned v, int d) { return d == 1 ? MX_ROW_SHRU(v, 1) : (d == 2 ? MX_ROW_SHRU(v, 2) : MX_ROW_SHRU(v, 3)); }
MX_DEV unsigned mx_ror8(unsigned v, int d) { return d == 1 ? MX_ROW_RORU(v, 1) : d == 2 ? MX_ROW_RORU(v, 2) : d == 3 ? MX_ROW_RORU(v, 3) : d == 4 ? MX_ROW_RORU(v, 4) : d == 5 ? MX_ROW_RORU(v, 5) : d == 6 ? MX_ROW_RORU(v, 6) : d == 7 ? MX_ROW_RORU(v, 7) : MX_ROW_RORU(v, 8); }
MX_DEV unsigned mx_ror_u(unsigned v, int d) { return d == 1 ? MX_ROW_RORU(v, 1) : (d == 2 ? MX_ROW_RORU(v, 2) : MX_ROW_RORU(v, 3)); }
MX_DEV MxRaw16 mx_raw_tail(const MX_G unsigned short* zseq, int col, int t0, int tk, int g) {
    return mx_raw_t16(zseq, t0 - 16 + tk, col, tk >= 13 && t0 - 16 + tk >= 0, g); }
MX_DEV MxRaw16 mx_raw_prev(const MxRaw16& cur, const MxRaw16& tail, int tk, int d) {
    MxRaw16 r;
#pragma unroll
    for (int ct = 0; ct < 4; ++ct) {
        const unsigned sx = mx_shr_u(cur.w[ct].x, d), sy = mx_shr_u(cur.w[ct].y, d), tx = mx_ror_u(tail.w[ct].x, d), ty = mx_ror_u(tail.w[ct].y, d);
        r.w[ct].x = (tk >= d) ? sx : tx; r.w[ct].y = (tk >= d) ? sy : ty; }
    return r;
}
MX_DEV MxRaw16 mx_raw_prev1(const MxRaw16& cur, const MxRaw16& tail, int tk, int rot) {
    MxRaw16 r;
#pragma unroll
    for (int ct = 0; ct < 4; ++ct) {
        const unsigned sx = MX_ROW_SHRU(cur.w[ct].x, 1), sy = MX_ROW_SHRU(cur.w[ct].y, 1), tx = mx_ror8(tail.w[ct].x, rot), ty = mx_ror8(tail.w[ct].y, rot);
        r.w[ct].x = (tk >= 1) ? sx : tx; r.w[ct].y = (tk >= 1) ? sy : ty; }
    return r;
}
MX_DEV void mx_prep_rwkv(int l, int h, const MX_G unsigned short* zseq  , int chunk, MX_L unsigned char* slot, MX_G unsigned char* gslot, MX_L unsigned char* gamp, bool midbar, const MxFin& fin, const MX_L unsigned char* lds, int lane) {
    const int tk = lane & 15, g = lane >> 4, t = 16 * chunk + tk;
    const MX_L float* par = (const MX_L float*)(lds + MX_LDS_PAR);
    const mx_f32x4 z4 = mx_zero4();
    mx_u32x4 cwv[8];
    const int tlast = 16 * chunk - 1;
    mx_u32x4 pwi = {0u, 0u, 0u, 0u}; if (tk >= 8 && chunk > 0) pwi = *(const MX_G mx_u32x4*)(zseq + mx_zoff(tlast, ZC_RW_DW + 32 * (tk - 8) + 8 * g));
#pragma unroll
    for (int ks = 0; ks < 8; ++ks) { const int col = ZC_RW_DW + 32 * ks + 8 * g; cwv[ks] = *(const MX_G mx_u32x4*)(zseq + mx_zoff(t, col)); }
    MxRaw16 kc, rc, vc_, tl;
    MX_SCHED();
    mx_f32x4 accw[4], acca[4], accg[4];
#pragma unroll
    for (int ct = 0; ct < 4; ++ct) { accw[ct] = z4; acca[ct] = z4; accg[ct] = z4; }
#pragma unroll
    for (int ks = 0; ks < 8; ++ks) {
        const mx_u32x4 cw = cwv[ks]; mx_u32x4 pw = pwi;
        { const unsigned sx = MX_ROW_SHRU(cw.x, 1), sy = MX_ROW_SHRU(cw.y, 1), sz = MX_ROW_SHRU(cw.z, 1), sw = MX_ROW_SHRU(cw.w, 1), tx = mx_ror8(pw.x, 8 - ks), ty = mx_ror8(pw.y, 8 - ks), tz = mx_ror8(pw.z, 8 - ks), tw = mx_ror8(pw.w, 8 - ks);
          pw.x = tk ? sx : tx; pw.y = tk ? sy : ty; pw.z = tk ? sz : tz; pw.w = tk ? sw : tw; }
        const mx_f32x4 m0 = *(const MX_L mx_f32x4*)(par + 32 * ks + 8 * g), m1 = *(const MX_L mx_f32x4*)(par + 32 * ks + 8 * g + 4);
        float x[8];
        x[0] = mx_lo(cw.x) + (mx_lo(pw.x) - mx_lo(cw.x)) * m0.x; x[1] = mx_hi(cw.x) + (mx_hi(pw.x) - mx_hi(cw.x)) * m0.y; x[2] = mx_lo(cw.y) + (mx_lo(pw.y) - mx_lo(cw.y)) * m0.z; x[3] = mx_hi(cw.y) + (mx_hi(pw.y) - mx_hi(cw.y)) * m0.w;
        x[4] = mx_lo(cw.z) + (mx_lo(pw.z) - mx_lo(cw.z)) * m1.x; x[5] = mx_hi(cw.z) + (mx_hi(pw.z) - mx_hi(cw.z)) * m1.y; x[6] = mx_lo(cw.w) + (mx_lo(pw.w) - mx_lo(cw.w)) * m1.z; x[7] = mx_hi(cw.w) + (mx_hi(pw.w) - mx_hi(cw.w)) * m1.w;
#pragma unroll
        for (int e = 0; e < 8; ++e) { if (ks < 2) x[e] = 2.f * MX_RCP(1.f + MX_EXP(-2.f * x[e])) - 1.f; else if (ks >= 4) x[e] = mx_sigmoid(x[e]); }
        const mx_bf16x8 bf = mx_frag8(x, x + 4);
#pragma unroll
        for (int ct = 0; ct < 4; ++ct) {
            if (ks < 2) accw[ct] = mx_mfma(*(const MX_L mx_bf16x8*)(lds + MX_LDS_WW + (16 * ct + tk) * MX_RS64 + (32 * ks + 8 * g) * 2), bf, accw[ct]);
            else if (ks < 4) acca[ct] = mx_mfma(*(const MX_L mx_bf16x8*)(lds + MX_LDS_WA + (16 * ct + tk) * MX_RS64 + (32 * (ks - 2) + 8 * g) * 2), bf, acca[ct]);
            else accg[ct] = mx_mfma(*(const MX_L mx_bf16x8*)(lds + MX_LDS_WG + (16 * ct + tk) * MX_RS128 + (32 * (ks - 4) + 8 * g) * 2), bf, accg[ct]);
        }
        if (ks == 0) { kc = mx_raw_t16(zseq, t, ZC_RW_K + 64 * h, true, g); tl = mx_raw_t16(zseq, tlast, (tk == 13 ? ZC_RW_R : (tk == 14 ? ZC_RW_K : ZC_RW_V)) + 64 * h, tk >= 13 && chunk > 0, g); }
        if (ks == 1) rc = mx_raw_t16(zseq, t, ZC_RW_R + 64 * h, true, g);
        if (ks == 2) vc_ = mx_raw_t16(zseq, t, ZC_RW_V + 64 * h, true, g);
        MX_SCHED();
    }
    float lw[16], a[16], b[16], k2[16], r[16], v[16];
    {
        float zc[16], zp[16], pr[16];
        mx_load_parL(par + MX_P_A0, g, pr);
#pragma unroll
        for (int i = 0; i < 16; ++i) b[i] = mx_sigmoid(pr[i] + acca[i >> 2][i & 3]);
        mx_unpack16(kc, zc); mx_unpack16(mx_raw_prev1(kc, tl, tk, 2), zp); mx_load_parL(par + MX_P_MUK, g, pr);
#pragma unroll
        for (int i = 0; i < 16; ++i) k2[i] = zc[i] + (zp[i] - zc[i]) * pr[i];
        mx_load_parL(par + MX_P_KK, g, pr);
        float ss = 0.f;
#pragma unroll
        for (int i = 0; i < 16; ++i) { a[i] = k2[i] * pr[i]; ss += a[i] * a[i]; }
        ss = mx_rowsum4(ss);
        const float rn = MX_RSQ(ss + 1e-6f);
        mx_load_parL(par + MX_P_KA, g, pr);
#pragma unroll
        for (int i = 0; i < 16; ++i) { const float kk = a[i] * rn, ic = b[i]; b[i] = kk * ic; a[i] = -kk; k2[i] = k2[i] * (1.f + (ic - 1.f) * pr[i]); }
    }
    MX_SCHED();
    float bs = 0.f;
    {
        float zc[16], zp[16], pr[16];
        mx_unpack16(rc, zc); mx_unpack16(mx_raw_prev1(rc, tl, tk, 3), zp); mx_load_parL(par + MX_P_MUR, g, pr);
#pragma unroll
        for (int i = 0; i < 16; ++i) r[i] = zc[i] + (zp[i] - zc[i]) * pr[i];
        mx_load_parL(par + MX_P_RK, g, pr);
#pragma unroll
        for (int i = 0; i < 16; ++i) bs += r[i] * k2[i] * pr[i];
        bs = mx_rowsum4(bs);
    }
    MX_SCHED();
    {
        float zc[16], zp[16], pr[16];
        mx_unpack16(vc_, zc); mx_unpack16(mx_raw_prev1(vc_, tl, tk, 1), zp); mx_load_parL(par + MX_P_MUV, g, pr);
#pragma unroll
        for (int i = 0; i < 16; ++i) v[i] = zc[i] + (zp[i] - zc[i]) * pr[i];
        mx_load_parL(par + MX_P_LNW, g, pr);
#pragma unroll
        for (int i = 0; i < 16; ++i) zc[i] = accg[i >> 2][i & 3] * pr[i];
        mx_store_t16(gslot + MX_GB_GT, lane, zc);
        mx_load_parL(par + MX_P_LNB, g, pr);
#pragma unroll
        for (int i = 0; i < 16; ++i) zp[i] = (pr[i] + bs * v[i]) * accg[i >> 2][i & 3];
        mx_store_t16(gslot + MX_GB_EE, lane, zp);
    }
    MX_SCHED();
    {
        float pr[16];
        mx_load_parL(par + MX_P_W0, g, pr);
#pragma unroll
        for (int i = 0; i < 16; ++i) { const float u = pr[i] + accw[i >> 2][i & 3]; lw[i] = -0.60653065971263342f * mx_sigmoid(u); }
    }
    MX_SCHED();
    mx_prep_back(lw, a, b, k2, r, v, slot, gamp, midbar, fin, lane);
}
MX_DEV void mx_prep_gdn(int l, int h, const MX_G unsigned short* zseq, int chunk, MX_L unsigned char* slot, MX_G unsigned char* gslot, MX_L unsigned char* gamp, bool midbar, const MxFin& fin, const MX_L unsigned char* lds, int lane) {
    const int tk = lane & 15, g = lane >> 4, t = 16 * chunk + tk;
    const MX_L float* par = (const MX_L float*)(lds + MX_LDS_PAR);
    const MxRaw16 cq = mx_raw_t16(zseq, t, ZC_GD_Q + 64 * h, true, g), tq = mx_raw_tail(zseq, ZC_GD_Q + 64 * h, 16 * chunk, tk, g);
    const MxRaw16 ck = mx_raw_t16(zseq, t, ZC_GD_K + 64 * h, true, g), tk_ = mx_raw_tail(zseq, ZC_GD_K + 64 * h, 16 * chunk, tk, g);
    MX_SCHED();
    float q[16], k[16], v[16];
#pragma unroll
    for (int i = 0; i < 16; ++i) { q[i] = 0.f; k[i] = 0.f; v[i] = 0.f; }
#pragma unroll
    for (int d = 0; d < 4; ++d) {
        float x[16], w[16];
        if (d == 3) mx_unpack16(cq, x); else mx_unpack16(mx_raw_prev(cq, tq, tk, 3 - d), x);
        mx_load_parL(par + d * 192, g, w);
#pragma unroll
        for (int i = 0; i < 16; ++i) MX_FMAC(q[i], w[i], x[i]);
    }
    const MxRaw16 cv = mx_raw_t16(zseq, t, ZC_GD_V + 64 * h, true, g), tv = mx_raw_tail(zseq, ZC_GD_V + 64 * h, 16 * chunk, tk, g);
    const MxRaw16 rg = mx_raw_t16(zseq, t, ZC_GD_G + 64 * h, true, g);
    const float bl = mx_lo((unsigned)zseq[mx_zoff(t, ZC_GD_B + h)]), al = mx_lo((unsigned)zseq[mx_zoff(t, ZC_GD_A + h)]);
    MX_SCHED();
#pragma unroll
    for (int d = 0; d < 4; ++d) {
        float x[16], w[16];
        if (d == 3) mx_unpack16(ck, x); else mx_unpack16(mx_raw_prev(ck, tk_, tk, 3 - d), x);
        mx_load_parL(par + d * 192 + 64, g, w);
#pragma unroll
        for (int i = 0; i < 16; ++i) MX_FMAC(k[i], w[i], x[i]);
    }
    MX_SCHED();
#pragma unroll
    for (int d = 0; d < 4; ++d) {
        float x[16], w[16];
        if (d == 3) mx_unpack16(cv, x); else mx_unpack16(mx_raw_prev(cv, tv, tk, 3 - d), x);
        mx_load_parL(par + d * 192 + 128, g, w);
#pragma unroll
        for (int i = 0; i < 16; ++i) MX_FMAC(v[i], w[i], x[i]);
    }
    MX_SCHED();
    float sq = 0.f, sk = 0.f;
#pragma unroll
    for (int i = 0; i < 16; ++i) { q[i] = q[i] * mx_sigmoid(q[i]); k[i] = k[i] * mx_sigmoid(k[i]); v[i] = v[i] * mx_sigmoid(v[i]); sq += q[i] * q[i]; sk += k[i] * k[i]; }
    sq = mx_rowsum4(sq); sk = mx_rowsum4(sk);
    const float rqn = 0.125f * MX_RSQ(sq + 1e-6f), rkn = MX_RSQ(sk + 1e-6f);
    const float beta = mx_sigmoid(bl);
    const float gl = -MX_EXP(MXIN(I_ALOG)[l * 4 + h]) * mx_softplus(al + MXIN(I_DTB)[l * 4 + h]);
    const float wb = -MX_EXP(gl) * beta;
    float lw[16], a[16], b[16];
#pragma unroll
    for (int i = 0; i < 16; ++i) { const float kn = k[i] * rkn; lw[i] = gl; a[i] = kn; b[i] = wb * kn; k[i] = kn; q[i] = q[i] * rqn; v[i] = beta * v[i]; }
    {
        float zg[16], pr[16], ee[16];
        mx_unpack16(rg, zg); mx_load_parL(par + MX_P_GNW, g, pr);
#pragma unroll
        for (int i = 0; i < 16; ++i) { zg[i] = pr[i] * (zg[i] * mx_sigmoid(zg[i])); ee[i] = 0.f; }
        mx_store_t16(gslot + MX_GB_GT, lane, zg);
    }
    MX_SCHED();
    mx_prep_back(lw, a, b, k, q, v, slot, gamp, midbar, fin, lane);
}
struct MxOps { mx_bf16x8 wa0, wa1, rt0, rt1; mx_u32x2 arb, ark, vc; mx_f32x4 u0; mx_f32x4 gm0, gm1, gm2, gm3; mx_u32x2 bh0, bh1, bh2, bh3, kh0, kh1, kh2, kh3; };
MX_DEV MxOps mx_scan_load(const MX_L unsigned char* slot, const MX_L unsigned char* gamp, int it, int lane) {
    const int g = lane >> 4;
    MxOps o;
    o.wa0 = *(const MX_L mx_bf16x8*)(slot + (unsigned)(MX_HB_WA + lane * 16)); o.wa1 = *(const MX_L mx_bf16x8*)(slot + (unsigned)(MX_HB_WA + 1024 + lane * 16));
    o.rt0 = *(const MX_L mx_bf16x8*)(slot + (unsigned)(MX_HB_RT + lane * 16)); o.rt1 = *(const MX_L mx_bf16x8*)(slot + (unsigned)(MX_HB_RT + 1024 + lane * 16));
    o.arb = *(const MX_L mx_u32x2*)(slot + (unsigned)(MX_HB_ARB + lane * 8)); o.ark = *(const MX_L mx_u32x2*)(slot + (unsigned)(MX_HB_ARK + lane * 8));
    o.vc = *(const MX_L mx_u32x2*)(slot + (unsigned)(MX_HB_VC + it * 512 + lane * 8));
    { const mx_u32x2 u = *(const MX_L mx_u32x2*)(slot + (unsigned)(MX_HB_U0 + it * 512 + lane * 8)); o.u0.x = mx_lo(u.x); o.u0.y = mx_hi(u.x); o.u0.z = mx_lo(u.y); o.u0.w = mx_hi(u.y); }
#define MX_LDJ(jt) do { o.gm##jt = *(const MX_L mx_f32x4*)(gamp + (unsigned)((16 * jt + 4 * g) * 4)); \
        o.bh##jt = *(const MX_L mx_u32x2*)(slot + (unsigned)(MX_HB_BH + jt * 512 + lane * 8)); o.kh##jt = *(const MX_L mx_u32x2*)(slot + (unsigned)(MX_HB_KH + jt * 512 + lane * 8)); } while (0)
    MX_LDJ(0); MX_LDJ(1); MX_LDJ(2); MX_LDJ(3);
#undef MX_LDJ
    return o;
}
MX_DEV mx_f32x4 mx_scan_compute(mx_f32x4 (&S)[4], const MxOps& o, int lane) {
    const int tk = lane & 15, g = lane >> 4;
    const mx_f32x4 z4 = mx_zero4();
    const mx_bf16x8 sb0 = mx_frag8v(S[0], S[1]), sb1 = mx_frag8v(S[2], S[3]);
    const mx_f32x4 U = mx_mfma(o.wa1, sb1, mx_mfma(o.wa0, sb0, o.u0));
    const mx_u32x2 ub = mx_frag4(U), vb = mx_frag4p(o.vc);
    mx_f32x4 Y = mx_mfma(o.rt1, sb1, mx_mfma(o.rt0, sb0, z4));
    Y = mx_mfma(mx_frag4p(o.ark), vb, mx_mfma(mx_frag4p(o.arb), ub, Y));
    S[0] = mx_mfma(mx_frag4p(o.kh0), vb, mx_mfma(mx_frag4p(o.bh0), ub, S[0] * o.gm0)); S[1] = mx_mfma(mx_frag4p(o.kh1), vb, mx_mfma(mx_frag4p(o.bh1), ub, S[1] * o.gm1));
    S[2] = mx_mfma(mx_frag4p(o.kh2), vb, mx_mfma(mx_frag4p(o.bh2), ub, S[2] * o.gm2)); S[3] = mx_mfma(mx_frag4p(o.kh3), vb, mx_mfma(mx_frag4p(o.bh3), ub, S[3] * o.gm3));
    mx_u32x2 selI = {0u, 0u};
    if ((tk >> 2) == g) { const unsigned one = (tk & 1) ? 0x3F800000u : 0x00003F80u; if ((tk & 3) >> 1) selI.y = one; else selI.x = one; }
    mx_f32x4 Yh, Yl;
#pragma unroll
    for (int e = 0; e < 4; ++e) { Yh[e] = __builtin_bit_cast(float, mx_bf(Y[e]) << 16); Yl[e] = Y[e] - Yh[e]; }
    return mx_mfma(mx_frag4(Yl), selI, mx_mfma(mx_frag4(Yh), selI, z4));
}
MX_DEV void mx_sequence(int l, int type, int h, const MX_G unsigned short* zseq, MX_G unsigned short* yseq  , int nchunks, MX_G unsigned char* gb  , MX_L unsigned char* lds, int wave,
                        int role, MX_G unsigned long long* xs, MX_G unsigned* flag, MX_G unsigned* tmo, MX_G unsigned char* ys  , const MX_G unsigned char* lrw = nullptr  ) {
    const int lane0 = mx_lane();
    {
        const int tid = wave * 64 + lane0;
        MX_L float* par = (MX_L float*)(lds + MX_LDS_PAR);
        if (type == 0) {
            const MX_G float* wup = MXIN(I_WUP) + l * 64 * 256 + 64 * h; const MX_G float* aup = MXIN(I_AUP) + l * 64 * 256 + 64 * h; const MX_G float* gup = MXIN(I_GUP) + l * 128 * 256 + 64 * h;
#ifdef MX_LRW_DMA
            {
                const MX_G unsigned char* img = lrw + (size_t)(l * 4 + h) * 36864;
                for (int pc = wave; pc < 35; pc += 8) MX_LRW_DMA(img + pc * 1024 + lane0 * 16, lds + MX_LDS_WW + pc * 1024);
                MX_VMWAIT();
            }
#else
            {
                const int ch = tid & 63, k0 = tid >> 6, sl = mx_slot_of_ch(ch);
                float vw[8], va[8], vg[16];
#pragma unroll
                for (int i = 0; i < 8; ++i) { vw[i] = wup[(k0 + 8 * i) * 256 + ch]; va[i] = aup[(k0 + 8 * i) * 256 + ch]; }
#pragma unroll
                for (int i = 0; i < 16; ++i) vg[i] = gup[(k0 + 8 * i) * 256 + ch];
#pragma unroll
                for (int i = 0; i < 8; ++i) { *(MX_L unsigned short*)(lds + MX_LDS_WW + sl * MX_RS64 + (k0 + 8 * i) * 2) = (unsigned short)mx_bf(vw[i]); *(MX_L unsigned short*)(lds + MX_LDS_WA + sl * MX_RS64 + (k0 + 8 * i) * 2) = (unsigned short)mx_bf(va[i]); }
#pragma unroll
                for (int i = 0; i < 16; ++i) *(MX_L unsigned short*)(lds + MX_LDS_WG + sl * MX_RS128 + (k0 + 8 * i) * 2) = (unsigned short)mx_bf(vg[i]);
            }
#endif
            const MX_G float* mu = MXIN(I_MU) + l * 1024;
            if (tid < 256) par[tid] = mu[ZC_RW_DW + tid];
            else if (tid < 448) { const int a = (tid - 256) >> 6, c = (tid - 256) & 63; par[tid] = mu[(a == 0 ? ZC_RW_R : (a == 1 ? ZC_RW_K : ZC_RW_V)) + 64 * h + c]; }
            if (tid < 448) { const int a = tid >> 6, c = tid & 63;
                const MX_G float* src = a == 0 ? MXIN(I_W0) : a == 1 ? MXIN(I_A0) : a == 2 ? MXIN(I_KK) : a == 3 ? MXIN(I_KA) : a == 4 ? MXIN(I_RK) : a == 5 ? MXIN(I_LNXW) : MXIN(I_LNXB);
                par[MX_P_W0 + tid] = src[l * 256 + 64 * h + c]; }
        } else {
            const MX_G float* cw = MXIN(I_CONV) + l * 4 * 768;
            for (int idx = tid; idx < 768; idx += 512) { const int d = idx / 192, a = (idx % 192) >> 6, c = idx & 63; par[idx] = cw[d * 768 + a * 256 + 64 * h + c]; }
            if (tid < 64) par[MX_P_GNW + tid] = MXIN(I_GNW)[l * 64 + tid];
        }
    }
    mx_wgsync();
    mx_f32x4 S[4];
#pragma unroll
    for (int jt = 0; jt < 4; ++jt) S[jt] = mx_zero4();
    MX_L float* st = (MX_L float*)(lds + MX_LDS_ST);
    typedef float mx_f32x2 __attribute__((ext_vector_type(2)));
    const int ngroups = nchunks / 8;
    for (int itr = role - 2; itr < ngroups; itr += 2) {
        int lane = lane0; MX_LAUNDER_V(lane);
        const int tk = lane & 15, g = lane >> 4;
        const bool scan_now = itr >= 0, more = itr + 2 < ngroups;
        const int par_c = (itr >> 1) & 1, par_n = ((itr + 2) >> 1) & 1;
        if (wave < 4 && scan_now) {
            const MX_L unsigned char* gamc = lds + MX_LDS_GAM + par_c * 2048;
            MX_G unsigned char* ysc = ys + par_c * MX_YS_PAR; MX_LAUNDER_S(ysc);
            if (itr > 0) {
                const unsigned want = 4u * (unsigned)itr;
                for (unsigned spins = 0;;) {
                    if ((unsigned)MX_UNIFORM(MX_FLAG_LOAD(flag)) >= want) break;
                    MX_SLEEP();
                    if (++spins > (1u << 20)) { if (lane == 0) MX_FLAG_STORE(tmo, 1u); break; }
                }
#pragma unroll
                for (int jt = 0; jt < 4; ++jt) { const MX_G unsigned long long* p = xs + (unsigned)(((wave * 4 + jt) * 64 + lane) * 2);
                    const unsigned long long a = MX_SC1_LOAD64(p), b = MX_SC1_LOAD64(p + 1);
                    mx_u32x4 w; w.x = (unsigned)a; w.y = (unsigned)(a >> 32); w.z = (unsigned)b; w.w = (unsigned)(b >> 32); S[jt] = __builtin_bit_cast(mx_f32x4, w); }
            }
#pragma unroll
            for (int c = 0; c < 8; ++c) {
                const MxOps o = mx_scan_load(lds + MX_LDS_HB + c * MX_HB_SLOT, gamc + c * 256, wave, lane);
                const mx_f32x4 yk = mx_scan_compute(S, o, lane);
                *(MX_G mx_f32x4*)(ysc + (unsigned)(((c * 4 + wave) * 64 + lane) * 16)) = yk;
                MX_SCHED();
            }
            if (itr + 1 < ngroups) {
#pragma unroll
                for (int jt = 0; jt < 4; ++jt) { MX_G unsigned long long* p = xs + (unsigned)(((wave * 4 + jt) * 64 + lane) * 2);
                    const mx_u32x4 w = __builtin_bit_cast(mx_u32x4, S[jt]);
                    MX_SC1_STORE64(p, (unsigned long long)w.x | ((unsigned long long)w.y << 32)); MX_SC1_STORE64(p + 1, (unsigned long long)w.z | ((unsigned long long)w.w << 32)); }
            }
            MX_VMWAIT();
            if (itr + 1 < ngroups) { if (lane == 0) MX_FLAG_ADD(flag, 1u); }
            unsigned pfw = 0u;
            if (more) {
                const int pc = 8 * (itr + 2) + 4 + wave;
                const MX_G unsigned short* zb = zseq + (size_t)pc * (ZP / 64) * 1024 + (lane & 15) * 64;
                if (type == 0) { pfw = *(const MX_G unsigned*)(zb + (ZC_RW_DW / 64 + g) * 1024); if (g < 3) pfw ^= *(const MX_G unsigned*)(zb + ((g == 0 ? ZC_RW_R : (g == 1 ? ZC_RW_K : ZC_RW_V)) / 64 + h) * 1024); }
                else { pfw = *(const MX_G unsigned*)(zb + ((g == 0 ? ZC_GD_Q : (g == 1 ? ZC_GD_K : (g == 2 ? ZC_GD_V : ZC_GD_G))) / 64 + h) * 1024); if (lane < 8) pfw ^= *(const MX_G unsigned*)(zb + (ZC_GD_B / 64) * 1024); }
            }
            MX_LDSWAIT(); mx_wgsync();
            MX_CONSUME(pfw);
        }
        MX_SCHED();
        MxFin fin; fin.on = scan_now && wave >= 4; fin.type = type; fin.wv = wave - 4; fin.yb = yseq; fin.t0 = 16 * 8 * (itr < 0 ? 0 : itr); fin.col0 = type * 256 + 64 * h; fin.gbp = gb + par_c * (8 * MX_GB_SLOT); fin.ysp = ys + par_c * MX_YS_PAR;
        fin.pf = (const MX_G unsigned short*)nullptr; fin.pfh = h;
        if (more) {
            const int c = (wave < 4) ? wave + 4 : wave - 4;
            MX_G unsigned char* gbn = gb + par_n * (8 * MX_GB_SLOT) + c * MX_GB_SLOT; MX_LAUNDER_S(gbn);
            MX_L unsigned char* slot = lds + MX_LDS_HB + c * MX_HB_SLOT; MX_L unsigned char* gamn = lds + MX_LDS_GAM + par_n * 2048 + c * 256;
            if (type == 0) mx_prep_rwkv(l, h, zseq, 8 * (itr + 2) + c, slot, gbn, gamn, wave >= 4 && scan_now, fin, lds, lane); else mx_prep_gdn(l, h, zseq, 8 * (itr + 2) + c, slot, gbn, gamn, wave >= 4 && scan_now, fin, lds, lane);
        } else if (wave >= 4) { mx_wgsync(); if (fin.on) mx_finalize(fin, lane); }
        MX_VMWAIT(); MX_LDSWAIT(); mx_wgsync();
    }
}

MX_DEV void mx_attn_unit4(int kvh, int q0, const MX_G unsigned short* zseq  , MX_G unsigned short* yatt  ,
                          const MX_L float* btab_all  , float Mb, const float (&esink)[4]  , const float (&qkw)[16], MX_L unsigned char* vts  , int lane) {
    const int tk = lane & 15, g = lane >> 4;
    const mx_f32x4 z4 = mx_zero4();
    const MX_G unsigned short* qrow = zseq + mx_zoff(q0 + tk, ZC_AT_Q + 256 * kvh + 8 * g);
    mx_u32x4 qa = *(const MX_G mx_u32x4*)(qrow), qb = *(const MX_G mx_u32x4*)(qrow + 512);
    mx_u32x4 kA[9], kB[9], vA[9], vB[9];
#pragma unroll
    for (int kt = 0; kt < 9; ++kt) {
        const int key0 = q0 - 128 + 16 * kt;
        if (key0 >= 0) {
            const MX_G unsigned short* krow = zseq + mx_zoff(key0 + tk, ZC_AT_K + 64 * kvh + 8 * g); const MX_G unsigned short* vrow = zseq + mx_zoff(key0 + tk, ZC_AT_V + 64 * kvh + 8 * g);
            kA[kt] = *(const MX_G mx_u32x4*)(krow); kB[kt] = *(const MX_G mx_u32x4*)(krow + 512);
            vA[kt] = *(const MX_G mx_u32x4*)(vrow); vB[kt] = *(const MX_G mx_u32x4*)(vrow + 512);
        } else { const mx_u32x4 z_ = {0u, 0u, 0u, 0u}; kA[kt] = z_; kB[kt] = z_; vA[kt] = z_; vB[kt] = z_; }
    }
    MX_SCHED();
    mx_bf16x8 Sel[2];
#pragma unroll
    for (int p = 0; p < 2; ++p) { mx_u32x4 w = {0u, 0u, 0u, 0u};
        if ((tk >> 2) == g) { const unsigned one = (tk & 1) ? 0x3F800000u : 0x00003F80u; const int q = 2 * p + ((tk & 3) >> 1); w.x = (q == 0) ? one : 0u; w.y = (q == 1) ? one : 0u; w.z = (q == 2) ? one : 0u; w.w = (q == 3) ? one : 0u; }
        Sel[p] = __builtin_bit_cast(mx_bf16x8, w); }
    float rk[9];
#pragma unroll
    for (int kt = 0; kt < 9; ++kt) {
        float ssk = 0.f;
        { const unsigned kk[8] = {kA[kt].x, kA[kt].y, kA[kt].z, kA[kt].w, kB[kt].x, kB[kt].y, kB[kt].z, kB[kt].w};
#pragma unroll
          for (int i = 0; i < 8; ++i) { const float a = mx_lo(kk[i]), b = mx_hi(kk[i]); ssk += a * a + b * b; } }
        rk[kt] = MX_RSQ(mx_rowsum4(ssk) * (1.f / 64.f) + 1e-6f);
#pragma unroll
        for (int dt = 0; dt < 4; ++dt) *(MX_L mx_u32x2*)(vts + (unsigned)(((kt * 4 + dt) * 64 + lane) * 8)) = mx_pack4(mx_mfma(__builtin_bit_cast(mx_bf16x8, (dt >> 1) ? vB[kt] : vA[kt]), Sel[dt & 1], z4));
    }
    MX_LDSWAIT(); MX_SCHED();
    for (int hh = 0; hh < 4; ++hh) {
        const int h = 4 * kvh + hh;
        const mx_u32x4 cqa = qa, cqb = qb;
        if (hh < 3) { qa = *(const MX_G mx_u32x4*)(qrow + 1024 * (hh + 1)); qb = *(const MX_G mx_u32x4*)(qrow + 1024 * (hh + 1) + 512); }
        const MX_L float* btab = btab_all + 128 * h;
        mx_bf16x8 QF[2];
        {
            float q[16]; float ss = 0.f;
            q[0] = mx_lo(cqa.x); q[1] = mx_hi(cqa.x); q[2] = mx_lo(cqa.y); q[3] = mx_hi(cqa.y); q[4] = mx_lo(cqa.z); q[5] = mx_hi(cqa.z); q[6] = mx_lo(cqa.w); q[7] = mx_hi(cqa.w);
            q[8] = mx_lo(cqb.x); q[9] = mx_hi(cqb.x); q[10] = mx_lo(cqb.y); q[11] = mx_hi(cqb.y); q[12] = mx_lo(cqb.z); q[13] = mx_hi(cqb.z); q[14] = mx_lo(cqb.w); q[15] = mx_hi(cqb.w);
#pragma unroll
            for (int i = 0; i < 16; ++i) ss += q[i] * q[i];
            ss = mx_rowsum4(ss);
            const float rs = MX_RSQ(ss * (1.f / 64.f) + 1e-6f);
#pragma unroll
            for (int i = 0; i < 16; ++i) q[i] = q[i] * rs * qkw[i];
            QF[0] = mx_frag8(q, q + 4); QF[1] = mx_frag8(q + 8, q + 12);
        }
        mx_f32x4 O[4];
#pragma unroll
        for (int dt = 0; dt < 4; ++dt) O[dt] = z4;
        float lsum = 0.f;
#pragma unroll
        for (int kt = 0; kt < 9; ++kt) {
            const int key0 = q0 - 128 + 16 * kt;
            const mx_f32x4 S = mx_mfma(__builtin_bit_cast(mx_bf16x8, kB[kt]), QF[1], mx_mfma(__builtin_bit_cast(mx_bf16x8, kA[kt]), QF[0], z4));
            mx_f32x4 P;
#pragma unroll
            for (int e = 0; e < 4; ++e) {
                const float rke = mx_shfl16l(rk[kt], 4 * g + e, lane);
                const int dist = (q0 + tk) - (key0 + 4 * g + e); const bool valid = (dist >= 0) && (dist < 128) && (key0 >= 0);
                float ex = MX_EXP(S[e] * rke + btab[dist & 127] - Mb); MX_LAUNDER_V(ex);
                P[e] = valid ? ex : 0.f; lsum += P[e];
            }
            const mx_u32x2 pf = mx_frag4(P);
#pragma unroll
            for (int dt = 0; dt < 4; ++dt) O[dt] = mx_mfma(mx_frag4p(*(const MX_L mx_u32x2*)(vts + (unsigned)(((kt * 4 + dt) * 64 + lane) * 8))), pf, O[dt]);
        }
        lsum = mx_rowsum4(lsum);
        const float inv = MX_RCP(lsum + esink[hh]);
        const int ycol = 512 + 64 * h;
#pragma unroll
        for (int dp = 0; dp < 2; ++dp) { mx_u32x4 o; o.x = mx_pk2(O[2 * dp].x * inv, O[2 * dp].y * inv); o.y = mx_pk2(O[2 * dp].z * inv, O[2 * dp].w * inv); o.z = mx_pk2(O[2 * dp + 1].x * inv, O[2 * dp + 1].y * inv); o.w = mx_pk2(O[2 * dp + 1].z * inv, O[2 * dp + 1].w * inv);
            *(MX_G mx_u32x4*)(yatt + mx_yoff(q0 + tk, ycol + mx_ch_off(2 * dp, g))) = o; }
    }
}

__device__ __forceinline__ float wave_allmax(float v) {
    v = fmaxf(v, dppf(v, 0)); v = fmaxf(v, dppf(v, 1)); v = fmaxf(v, dppf(v, 2)); v = fmaxf(v, dppf(v, 3));
    const float a = __builtin_bit_cast(float, __builtin_amdgcn_readlane(__builtin_bit_cast(int, v), 0)), b = __builtin_bit_cast(float, __builtin_amdgcn_readlane(__builtin_bit_cast(int, v), 16));
    const float c = __builtin_bit_cast(float, __builtin_amdgcn_readlane(__builtin_bit_cast(int, v), 32)), d = __builtin_bit_cast(float, __builtin_amdgcn_readlane(__builtin_bit_cast(int, v), 48));
    return fmaxf(fmaxf(a, b), fmaxf(c, d));
}
__device__ __forceinline__ void mixer_phase(Frame& F, int l) {
    const int blk = blockIdx.x;
    {
        const int lane = ltid() & 63;
        const LAS float* btab_all = (const LAS float*)(F.lds + BIAS_OFF);
        float mb = 0.f;
#pragma unroll
        for (int i = 0; i < 16; ++i) mb = fmaxf(mb, fabsf(btab_all[lane + 64 * i]));
        const int cls = blk & 7, cidx = blk >> 3, seg = cidx & 7, b = 2 * cls + (cidx >> 4), kvh = (cidx >> 3) & 1;
        const MX_G float* qnw = MXIN(I_QNW) + l * 64; const MX_G float* knw = MXIN(I_KNW) + l * 64; const MX_G float* snk = MXIN(I_SINK) + l * 8 + 4 * kvh;
        float sk[4]; mx_f32x4 qkw4[4]; const float qn_l = qnw[lane], kn_l = knw[lane];
#pragma unroll
        for (int j = 0; j < 4; ++j) { const mx_f32x4 q4 = *(const MX_G mx_f32x4*)(qnw + 32 * (j >> 1) + 8 * (lane >> 4) + 4 * (j & 1)), k4 = *(const MX_G mx_f32x4*)(knw + 32 * (j >> 1) + 8 * (lane >> 4) + 4 * (j & 1));
            sk[j] = snk[j];
            qkw4[j] = q4 * k4; }
        const float Mb = 8.f * wave_allmax(fabsf(qn_l)) * wave_allmax(fabsf(kn_l)) + wave_allmax(mb);
        float esink[4];
#pragma unroll
        for (int hh = 0; hh < 4; ++hh) esink[hh] = __expf(sk[hh] - Mb);
        float qkw[16];
#pragma unroll
        for (int i = 0; i < 16; ++i) qkw[i] = 0.125f * qkw4[i >> 2][i & 3];
        const MX_G unsigned short* zseq = (const MX_G unsigned short*)(WSP(WS_Z) + (size_t)(b >> 1) * SLAB_BYTES + (size_t)(b & 1) * ((size_t)SEQ * ZP * 2));
        MX_G unsigned short* yatt = (MX_G unsigned short*)(WSP(WS_Z) + (size_t)(b >> 1) * SLAB_BYTES + SLAB_Y_OFF + (size_t)(b & 1) * ((size_t)SEQ * DM * 2));
        for (int i = 0; i < 2; ++i) {
            const int qt = 16 * seg + F.wave + 8 * i;
            int ln = lane; MX_LAUNDER_V(ln);
            mx_attn_unit4(kvh, 16 * qt, zseq, yatt, btab_all, Mb, esink, qkw, F.lds + RING_OFF + F.wave * 18432, ln);
        }
    }
    __syncthreads();
    {
        const int cls = blk & 7, cidx = blk >> 3, role = cidx >> 4, type = (cidx >> 3) & 1, b = 2 * cls + ((cidx >> 2) & 1), h = cidx & 3, seq = type * 64 + b * 4 + h;
        const MX_G unsigned short* zseq = (const MX_G unsigned short*)(WSP(WS_Z) + (size_t)(b >> 1) * SLAB_BYTES + (size_t)(b & 1) * ((size_t)SEQ * ZP * 2));
        MX_G unsigned short* yseq = (MX_G unsigned short*)(WSP(WS_Z) + (size_t)(b >> 1) * SLAB_BYTES + SLAB_Y_OFF + (size_t)(b & 1) * ((size_t)SEQ * DM * 2));
        MX_G unsigned* ctlw = (MX_G unsigned*)WSP(WS_CTL);
        mx_sequence(l, type, h, zseq, yseq, SEQ / 16, (MX_G unsigned char*)WSP(WS_HB) + (size_t)blk * (2 * 8 * MX_GB_SLOT), F.lds + RING_OFF, F.wave,
                    role, (MX_G unsigned long long*)WSP(WS_XS) + (size_t)seq * 2048, ctlw + CW_SEQ + (l * 128 + seq) * 64, ctlw + CW_TMO,
                    (MX_G unsigned char*)WSP(WS_HB) + (size_t)256 * (2 * 8 * MX_GB_SLOT) + (size_t)blk * (2 * MX_YS_PAR), (const MX_G unsigned char*)WSP(WS_LRW));
    }
}
constexpr int PH_PER_L = 5, NPH = 1 + DEPTH * PH_PER_L;
struct Args { const float* in[26]; float* out; unsigned char* ws; int ph_lo, ph_hi; };
__global__ void __launch_bounds__(NWAVES * 64, 2) fwd(Args args) {
    extern __shared__ __attribute__((aligned(16))) unsigned char lds[];
    Frame F;
    F.lds = (LAS unsigned char*)lds;
    const int tid0 = threadIdx.x; F.wave = __builtin_amdgcn_readfirstlane(tid0 >> 6);
    F.G = gridDim.x; { const int bx = blockIdx.x; F.vcu = (F.G % 8 == 0) ? (bx % 8) * (F.G / 8) + bx / 8 : bx; }
    F.ws = args.ws; F.out = args.out;
    for (int u = tid0; u < (BIAS_OFF - LDSCTL_OFF) / 4; u += NWAVES * 64) ((LAS unsigned*)(F.lds + LDSCTL_OFF))[u] = 0u;
    for (int u = tid0; u < 8 * 128; u += NWAVES * 64) {
        const int h = u >> 7, d = u & 127;
        int bucket;
        if (d < 16) bucket = d;
        else { int lg = 16 + (int)(logf((float)d / 16.f) / logf(8.f) * 16.f); bucket = lg < 31 ? lg : 31; }
        ((LAS float*)(F.lds + BIAS_OFF))[u] = INP(I_RELB)[bucket * 8 + h];
    }
    __syncthreads();
    const int lo = args.ph_lo, hi = args.ph_hi;
    const bool one = (hi - lo) > 1;
    XcdBarrier bar; bar.bar = (unsigned*)(F.ws + WS_CTL) + CW_BAR; bar.x = 0; bar.st = nullptr;
    if (one) bar = xcd_barrier_post((unsigned*)(F.ws + WS_CTL) + CW_BAR, (volatile LAS unsigned*)(F.lds + MISC_OFF) + 8, tid0 == 0);
    if (one && tid0 == 0) (void)__hip_atomic_fetch_or((GAS unsigned*)(F.ws + WS_CTL) + CW_CLS + 64 * ((int)blockIdx.x & 7), 1u << bar.x, __ATOMIC_RELAXED, __HIP_MEMORY_SCOPE_AGENT);
#define IN(k) (lo <= (k) && (k) < hi)
#define SEAM(k) do { if (IN(k) && IN((k) + 1)) { XcdBarrier b2_ = bar; asm volatile("" : "+s"(b2_.bar)); xcd_barrier(b2_, F.wave == 0 && hw_lane() == 0, ((volatile LAS unsigned*)(F.lds + MISC_OFF))[12] != 0u); } } while (0)

    #ifndef DIS_PRO
    if (IN(0)) { p0_prologue(F); SEAM(0);
        if (one) { if (F.wave == 0 && hw_lane() == 0) { unsigned ok = (F.G == 256) ? 1u : 0u;
                for (int x = 0; x < 8; ++x) { const unsigned m = __hip_atomic_load((GAS unsigned*)(F.ws + WS_CTL) + CW_CLS + 64 * x, __ATOMIC_RELAXED, __HIP_MEMORY_SCOPE_AGENT); ok &= (__builtin_popcount(m) == 1) ? 1u : 0u; }
                ((volatile LAS unsigned*)(F.lds + MISC_OFF))[12] = ok; }
            __syncthreads();
            if (((volatile LAS unsigned*)(F.lds + MISC_OFF))[12] != 0u && (blockIdx.x & 1u)) { __builtin_amdgcn_s_sleep(127); __builtin_amdgcn_s_sleep(127); } } }
#endif
    for (int l = 0; l < DEPTH; ++l) {
        const int pb = 1 + PH_PER_L * l;
        if (IN(pb + 0)) {
            pg8::Gemm g{FXN, ((bf16*)WSP(WS_WIN)) + (size_t)l * ZP * DM, M, ZP, DM}; pg8::StaticOrder S; S.init(M, ZP, F.G, (int)blockIdx.x);
            pg8::EpiBf16<0, true> E{FZ, ZP, (const float*)WSP(WS_RSS) + (size_t)(2 * l) * M * 16};
            pg8::gemm_phase<pg8::EpiBf16<0, true>, pg8::StaticOrder, true, true>(F.lds + RING_OFF, g, S, E, F.wave);
            SEAM(pb + 0);
        }
        if (IN(pb + 1)) { mixer_phase(F, l); SEAM(pb + 1); }
        if (IN(pb + 2)) {
            pg8::Gemm g{FY, ((bf16*)WSP(WS_WOUT)) + (size_t)l * DM * DM, M, DM, DM, SLAB_BYTES - (size_t)16 * 256 * DM * 2  }; pg8::StaticOrder S; S.init(M, DM, F.G, (int)blockIdx.x);
            pg8::EpiResBf16 E{FXN, DM, (float*)nullptr, (float*)WSP(WS_RSS) + (size_t)(2 * l + 1) * M * 16};
            pg8::gemm_phase<pg8::EpiResBf16, pg8::StaticOrder, true, true>(F.lds + RING_OFF, g, S, E, F.wave);
            SEAM(pb + 2);
        }
        if (IN(pb + 3)) {
            pg8::Gemm g{FXN, ((bf16*)WSP(WS_W1)) + (size_t)l * DFF * DM, M, DFF, DM}; pg8::StaticOrder S; S.init(M, DFF, F.G, (int)blockIdx.x);
            pg8::EpiBf16<2> E{FH, DFF, (const float*)WSP(WS_RSS) + (size_t)(2 * l + 1) * M * 16};
            pg8::gemm_phase<pg8::EpiBf16<2>, pg8::StaticOrder, true, true>(F.lds + RING_OFF, g, S, E, F.wave);
            SEAM(pb + 3);
        }
        if (IN(pb + 4)) {
            pg8::Gemm g{FH, ((bf16*)WSP(WS_W2)) + (size_t)l * DM * DFF, M, DM, DFF}; pg8::StaticOrder S; S.init(M, DM, F.G, (int)blockIdx.x);
            pg8::EpiResBf16 E{FXN, DM, l + 1 < DEPTH ? (float*)nullptr : F.out, l + 1 < DEPTH ? (float*)WSP(WS_RSS) + (size_t)(2 * l + 2) * M * 16 : (float*)nullptr};
            pg8::gemm_phase<pg8::EpiResBf16, pg8::StaticOrder, true, true>(F.lds + RING_OFF, g, S, E, F.wave);
            SEAM(pb + 4);
        }
    }
#undef IN
#undef SEAM
}

#ifndef MK_ONE_LAUNCH
#define MK_ONE_LAUNCH 1
#endif
extern "C" void kernel_launch(void* const* d_in, const int* in_sizes, int n_in, void* d_out, int out_size, void* d_ws, size_t ws_size, hipStream_t stream) {
    static int grid = 0;
    if (grid == 0) {
        if (n_in != 26 || in_sizes[0] != M * DM || out_size != M * DM || ws_size < WS_END) { fprintf(stderr, "kernel_launch: unexpected shapes (n_in %d, in0 %d, out %d, ws %zu, need %zu)\n", n_in, n_in > 0 ? in_sizes[0] : -1, out_size, ws_size, (size_t)WS_END); grid = -1; return; }
        int dev = 0, cus = 0, per_cu = 0;
        if (hipGetDevice(&dev) != hipSuccess || hipDeviceGetAttribute(&cus, hipDeviceAttributeMultiprocessorCount, dev) != hipSuccess) { grid = -1; return; }
        if (hipFuncSetAttribute((const void*)fwd, hipFuncAttributeMaxDynamicSharedMemorySize, LDS_BYTES) != hipSuccess) { fprintf(stderr, "kernel_launch: hipFuncSetAttribute failed\n"); grid = -1; return; }
        if (hipOccupancyMaxActiveBlocksPerMultiprocessor(&per_cu, (const void*)fwd, NWAVES * 64, LDS_BYTES) != hipSuccess || per_cu < 1) fprintf(stderr, "kernel_launch: occupancy query reports %d\n", per_cu);
        (void)hipGetLastError();
        grid = cus;
    }
    if (grid < 0) return;
    if (hipMemsetAsync((char*)d_ws + WS_CTL, 0, CTL_ZERO_BYTES, stream) != hipSuccess) return;
    Args a{};
    for (int i = 0; i < 26; ++i) a.in[i] = (const float*)d_in[i];
    a.out = (float*)d_out; a.ws = (unsigned char*)d_ws;
#if MK_ONE_LAUNCH
    a.ph_lo = 0; a.ph_hi = NPH;
    hipLaunchKernelGGL(fwd, dim3(grid), dim3(NWAVES * 64), LDS_BYTES, stream, a);
#else
    for (int ph = 0; ph < NPH; ++ph) {
        a.ph_lo = ph; a.ph_hi = ph + 1;
        hipLaunchKernelGGL(fwd, dim3(grid), dim3(NWAVES * 64), LDS_BYTES, stream, a);
    }
#endif
}
```
